# Optimizing an MI355X kernel written in HIP

```python
import math
import jax
import jax.numpy as jnp
from jax import lax
import numpy as np

D_MODEL = 2048
BATCH = 32
SEQ = 256
DEPTH = 2
DEC_BATCH = 2
DEC_SEQ = 1024
PAST_LEN = 512

GRID_W = 64
DK_GDN = 128
DV_GDN = 128
H_GDN = D_MODEL // (2 * DV_GDN)
GDN_W = H_GDN * DV_GDN
HEAD_DIM = 128
N_Q = D_MODEL // (2 * HEAD_DIM)
N_KV = N_Q // 4
ATTN_W = N_Q * HEAD_DIM
MIX_W = GDN_W + ATTN_W
CONV_K = 5
CHUNK = 64
Q_BLOCK = 128
D_FF = ((8 * D_MODEL + 767) // 768) * 256
ROPE_BASE = 10000.0
RMS_EPS = 1e-6
LN_EPS = 1e-5
DN_ALPHA = (2 * DEPTH) ** 0.25
DN_BETA = (8 * DEPTH) ** -0.25
QKV_W = 2 * H_GDN * DK_GDN + GDN_W
IN_W = QKV_W + GDN_W + 4 * H_GDN + ATTN_W + 2 * N_KV * HEAD_DIM

kernel_name = 'hybrid_gdn_gqa_diffusion_step'


def rms_norm(x, w):
    xf = x.astype(jnp.float32)
    y = xf * lax.rsqrt(jnp.mean(xf * xf, axis=-1, keepdims=True) + RMS_EPS)
    return (y * w.astype(jnp.float32)).astype(x.dtype)


def layer_norm(x, g, b):
    xf = x.astype(jnp.float32)
    mu = jnp.mean(xf, axis=-1, keepdims=True)
    var = jnp.mean(jnp.square(xf - mu), axis=-1, keepdims=True)
    y = (xf - mu) * lax.rsqrt(var + LN_EPS)
    return (y * g.astype(jnp.float32) + b.astype(jnp.float32)).astype(x.dtype)


def l2_normalize(x):
    return x * lax.rsqrt(jnp.sum(x * x, axis=-1, keepdims=True) + RMS_EPS)


def axial_rope_tables(n_tok):
    rows = n_tok // GRID_W
    row = jnp.repeat(jnp.arange(rows), GRID_W).astype(jnp.float32)
    col = jnp.tile(jnp.arange(GRID_W), rows).astype(jnp.float32)
    half = HEAD_DIM // 2
    inv_freq = ROPE_BASE ** (-jnp.arange(0, half, 2, dtype=jnp.float32) / half)
    ang_r = row[:, None] * inv_freq
    ang_c = col[:, None] * inv_freq
    return (jnp.cos(ang_r), jnp.sin(ang_r), jnp.cos(ang_c), jnp.sin(ang_c))


def _rotate(x, cos, sin):
    n = x.shape[-1] // 2
    x1 = x[..., :n].astype(jnp.float32)
    x2 = x[..., n:].astype(jnp.float32)
    c = cos[:, None, :]
    s = sin[:, None, :]
    return jnp.concatenate([x1 * c - x2 * s, x2 * c + x1 * s], axis=-1)


def apply_axial_rope(x, tabs):
    cos_r, sin_r, cos_c, sin_c = tabs
    half = HEAD_DIM // 2
    y = jnp.concatenate([_rotate(x[..., :half], cos_r, sin_r),
                         _rotate(x[..., half:], cos_c, sin_c)], axis=-1)
    return y.astype(x.dtype)


def short_conv(x, w):
    pad = CONV_K // 2
    t = x.shape[1]
    xp = jnp.pad(x, ((0, 0), (pad, pad), (0, 0)))
    return sum(xp[:, j:j + t] * w[j] for j in range(CONV_K))


def gated_delta_chunked(q, k, v, g, beta, s0):
    b_, t_, h_, _ = q.shape
    dv = v.shape[-1]
    n = t_ // CHUNK

    def chunks(a):
        a = a.reshape((b_, n, CHUNK, h_) + a.shape[3:])
        return jnp.moveaxis(a, (1, 3), (0, 2))

    qc, kc, vc, gc, bc = chunks(q), chunks(k), chunks(v), chunks(g), chunks(beta)
    gcum = jnp.cumsum(gc, axis=-1)
    idx = jnp.arange(CHUNK)
    tril = idx[:, None] >= idx[None, :]
    strict = idx[:, None] > idx[None, :]
    decay = jnp.exp(jnp.where(tril, gcum[..., :, None] - gcum[..., None, :], -jnp.inf))
    kb = kc * bc[..., None]
    lmat = jnp.where(strict, jnp.einsum('nbhid,nbhjd->nbhij', kb, kc) * decay, 0.0)
    amat = lmat + jnp.eye(CHUNK, dtype=jnp.float32)
    rhs = jnp.concatenate([vc * bc[..., None], kb * jnp.exp(gcum)[..., None]], axis=-1)
    sol = lax.linalg.triangular_solve(amat, rhs, left_side=True, lower=True, unit_diagonal=True)
    u, w = sol[..., :dv], sol[..., dv:]
    attn = jnp.einsum('nbhid,nbhjd->nbhij', qc, kc) * decay

    def step(s, inp):
        q_i, k_i, u_i, w_i, a_i, g_i = inp
        v_new = u_i - jnp.einsum('bhcd,bhde->bhce', w_i, s)
        o = (jnp.einsum('bhcd,bhde->bhce', q_i * jnp.exp(g_i)[..., None], s)
             + jnp.einsum('bhij,bhje->bhie', a_i, v_new))
        g_last = g_i[..., -1]
        s = (s * jnp.exp(g_last)[..., None, None]
             + jnp.einsum('bhcd,bhce->bhde', k_i * jnp.exp(g_last[..., None] - g_i)[..., None], v_new))
        return s, o

    s_fin, o = lax.scan(step, s0, (qc, kc, u, w, attn, gcum))
    o = jnp.moveaxis(o, (0, 2), (1, 3)).reshape(b_, t_, h_, dv)
    return o, s_fin


def gated_deltanet(qkv, z, b, a, conv_w, a_log, dt_bias, norm_w, s0):
    bsz, t_, _ = qkv.shape
    f32 = jnp.float32
    qkv = jax.nn.silu(short_conv(qkv, conv_w)).astype(f32)
    q, k, v = jnp.split(qkv, [H_GDN * DK_GDN, 2 * H_GDN * DK_GDN], axis=-1)
    q = l2_normalize(q.reshape(bsz, t_, H_GDN, DK_GDN)) * DK_GDN ** -0.5
    k = l2_normalize(k.reshape(bsz, t_, H_GDN, DK_GDN))
    v = v.reshape(bsz, t_, H_GDN, DV_GDN)
    beta = jax.nn.sigmoid(b.astype(f32)).reshape(bsz, t_, 2, H_GDN)
    g = -jnp.exp(a_log.astype(f32)) * jax.nn.softplus(
        a.astype(f32).reshape(bsz, t_, 2, H_GDN) + dt_bias.astype(f32))
    s0 = s0.astype(f32)
    o_f, s_f = gated_delta_chunked(q, k, v, g[:, :, 0], beta[:, :, 0], s0[:, 0])
    rev = lambda arr: jnp.flip(arr, axis=1)
    o_b, s_b = gated_delta_chunked(rev(q), rev(k), rev(v), rev(g[:, :, 1]), rev(beta[:, :, 1]), s0[:, 1])
    o = o_f + rev(o_b)
    o = rms_norm(o, norm_w) * jax.nn.silu(z.astype(f32).reshape(bsz, t_, H_GDN, DV_GDN))
    return o.reshape(bsz, t_, GDN_W).astype(z.dtype), jnp.stack([s_f, s_b], axis=1)


def block_attention(q, k, v):
    bsz, t_, _, _ = q.shape
    grp = N_Q // N_KV
    nb = t_ // Q_BLOCK
    qb = jnp.moveaxis(q.reshape(bsz, nb, Q_BLOCK, N_KV, grp, HEAD_DIM), 1, 0)
    scale = HEAD_DIM ** -0.5

    def one_block(q_blk):
        s = jnp.einsum('bqkgd,bskd->bkgqs', q_blk, k).astype(jnp.float32) * scale
        p = jax.nn.softmax(s, axis=-1)
        return jnp.einsum('bkgqs,bskd->bqkgd', p.astype(v.dtype), v)

    o = lax.map(one_block, qb)
    return jnp.moveaxis(o, 0, 1).reshape(bsz, t_, ATTN_W)


def mixer(h, lp, rope, ctx_k, ctx_v, s0):
    w_in, conv_w, a_log, dt_bias, gdn_norm_w, q_norm_w, k_norm_w, w_o = lp
    bsz, t_, _ = h.shape
    proj = h @ w_in
    i1 = QKV_W
    i2 = i1 + GDN_W
    i3 = i2 + 2 * H_GDN
    i4 = i3 + 2 * H_GDN
    i5 = i4 + ATTN_W
    i6 = i5 + N_KV * HEAD_DIM
    qkv, z, b, a, q, k, v = jnp.split(proj, [i1, i2, i3, i4, i5, i6], axis=-1)
    o_gdn, s_fin = gated_deltanet(qkv, z, b, a, conv_w, a_log, dt_bias, gdn_norm_w, s0)
    q = rms_norm(q.reshape(bsz, t_, N_Q, HEAD_DIM), q_norm_w)
    k = rms_norm(k.reshape(bsz, t_, N_KV, HEAD_DIM), k_norm_w)
    v = v.reshape(bsz, t_, N_KV, HEAD_DIM)
    if rope is None:
        o_att = block_attention(q, k, v)
    else:
        q_r = apply_axial_rope(q, rope)
        k_r = apply_axial_rope(k, rope)
        k_all = jnp.concatenate([k_r, ctx_k.astype(k.dtype)], axis=1)
        v_all = jnp.concatenate([v, ctx_v.astype(v.dtype)], axis=1)
        o_att = block_attention(q_r, k_all, v_all)
    out = jnp.concatenate([o_gdn, o_att], axis=-1) @ w_o
    return out, k, v, s_fin


def trunk_layer(x, cond, lp, rope, ctx_k, ctx_v, s0):
    (w_ada, b_ada, w_in, conv_w, a_log, dt_bias, gdn_norm_w, q_norm_w, k_norm_w, w_o,
     ln1_g, ln1_b, ln2_g, ln2_b, w_gate_up, w_down) = lp
    m = jax.nn.silu(cond) @ w_ada + b_ada
    if m.ndim == 2:
        m = m[:, None, :]
    sh1, sc1, g1, sh2, sc2, g2 = jnp.split(m, 6, axis=-1)
    h = x * (1.0 + sc1) + sh1
    mix, k, v, s_fin = mixer(h, (w_in, conv_w, a_log, dt_bias, gdn_norm_w, q_norm_w, k_norm_w, w_o),
                             rope, ctx_k, ctx_v, s0)
    x = layer_norm(DN_ALPHA * x + g1 * mix, ln1_g, ln1_b)
    h = x * (1.0 + sc2) + sh2
    gate, up = jnp.split(h @ w_gate_up, 2, axis=-1)
    ffn = (jax.nn.silu(gate) * up) @ w_down
    x = layer_norm(DN_ALPHA * x + g2 * ffn, ln2_g, ln2_b)
    return x, k, v, s_fin


def setup_inputs(seed: int = 0) -> dict:
    key = jax.random.key(seed)
    ks = jax.random.split(key, 24)
    f32 = jnp.float32

    def nrm(k, shape, s):
        return s * jax.random.normal(k, shape, f32)

    dt = jnp.exp(jax.random.uniform(ks[10], (DEPTH, 2, H_GDN), f32, math.log(1e-3), math.log(1e-1)))
    return {
        'x_prompt': nrm(ks[0], (BATCH, SEQ, D_MODEL), 1.0),
        'x_sample': nrm(ks[1], (DEC_BATCH, DEC_SEQ, D_MODEL), 1.0),
        'cache_k': nrm(ks[2], (DEC_BATCH, DEPTH, PAST_LEN, N_KV, HEAD_DIM), 1.0),
        'cache_v': nrm(ks[3], (DEC_BATCH, DEPTH, PAST_LEN, N_KV, HEAD_DIM), 1.0),
        'state_gdn': nrm(ks[4], (DEC_BATCH, DEPTH, 2, H_GDN, DK_GDN, DV_GDN), 0.1),
        'c': nrm(ks[5], (DEC_BATCH, D_MODEL), 1.0),
        'c_ctx': nrm(ks[6], (D_MODEL,), 1.0),
        'w_ada': nrm(ks[7], (DEPTH, D_MODEL, 6 * D_MODEL), 0.5 * D_MODEL ** -0.5),
        'b_ada': nrm(ks[8], (DEPTH, 6 * D_MODEL), 0.01),
        'w_in': nrm(ks[9], (DEPTH, D_MODEL, IN_W), D_MODEL ** -0.5),
        'conv_w': nrm(ks[11], (DEPTH, CONV_K, QKV_W), CONV_K ** -0.5),
        'a_log': jnp.log(jax.random.uniform(ks[12], (DEPTH, 2, H_GDN), f32, 1.0, 16.0)),
        'dt_bias': dt + jnp.log(-jnp.expm1(-dt)),
        'gdn_norm_w': 1.0 + nrm(ks[13], (DEPTH, DV_GDN), 0.1),
        'q_norm_w': 1.0 + nrm(ks[14], (DEPTH, HEAD_DIM), 0.1),
        'k_norm_w': 1.0 + nrm(ks[15], (DEPTH, HEAD_DIM), 0.1),
        'w_o': nrm(ks[16], (DEPTH, MIX_W, D_MODEL), DN_BETA * MIX_W ** -0.5),
        'ln1_g': 1.0 + nrm(ks[17], (DEPTH, D_MODEL), 0.1),
        'ln1_b': nrm(ks[18], (DEPTH, D_MODEL), 0.02),
        'ln2_g': 1.0 + nrm(ks[19], (DEPTH, D_MODEL), 0.1),
        'ln2_b': nrm(ks[20], (DEPTH, D_MODEL), 0.02),
        'w_gate_up': nrm(ks[21], (DEPTH, D_MODEL, 2 * D_FF), D_MODEL ** -0.5),
        'w_down': nrm(ks[22], (DEPTH, D_FF, D_MODEL), DN_BETA * D_FF ** -0.5),
    }


def reference(x_prompt, x_sample, cache_k, cache_v, state_gdn, c, c_ctx, w_ada, b_ada, w_in,
              conv_w, a_log, dt_bias, gdn_norm_w, q_norm_w, k_norm_w, w_o, ln1_g, ln1_b,
              ln2_g, ln2_b, w_gate_up, w_down):
    rope = axial_rope_tables(x_sample.shape[1])
    s_zero = jnp.zeros((x_prompt.shape[0], 2, H_GDN, DK_GDN, DV_GDN), jnp.float32)
    xp = x_prompt
    xs = x_sample
    ks_out, vs_out, ss_out = [], [], []
    for l in range(DEPTH):
        lp = (w_ada[l], b_ada[l], w_in[l], conv_w[l], a_log[l], dt_bias[l], gdn_norm_w[l],
              q_norm_w[l], k_norm_w[l], w_o[l], ln1_g[l], ln1_b[l], ln2_g[l], ln2_b[l],
              w_gate_up[l], w_down[l])
        xp, k_ctx, v_ctx, s_ctx = trunk_layer(xp, c_ctx, lp, None, None, None, s_zero)
        ks_out.append(k_ctx)
        vs_out.append(v_ctx)
        ss_out.append(s_ctx.astype(x_prompt.dtype))
        xs, _, _, _ = trunk_layer(xs, c, lp, rope, cache_k[:, l], cache_v[:, l], state_gdn[:, l])
    new_cache_k = jnp.stack(ks_out, axis=1)
    new_cache_v = jnp.stack(vs_out, axis=1)
    new_state_gdn = jnp.stack(ss_out, axis=1)
    return (xp, xs, new_cache_k, new_cache_v, new_state_gdn)
```

```cpp
#include <hip/hip_runtime.h>
#include <hip/hip_bf16.h>
#include <cstdio>
#include <cstdint>
#include <cmath>
#include <utility>
namespace pg8 {
#define PG8_LAS __attribute__((address_space(3)))
typedef unsigned short bf16_t;
typedef short bf16x8 __attribute__((ext_vector_type(8)));
typedef float f32x4 __attribute__((ext_vector_type(4)));
typedef unsigned u32x4 __attribute__((ext_vector_type(4)));
constexpr int BM = 256, BK = 64, HALF = 128, HTB = HALF * BK * 2  , STAGE_BYTES = 8 * HTB, NXCD = 8, WGM = 8;

__host__ __device__ __forceinline__ int lds_byte(int r, int c) { const int st = (r >> 4) * 2 + (c >> 5), rr = r & 15, cc = c & 31, ob = rr * 64 + cc * 2; return st * 1024 + (ob ^ (((ob >> 9) & 1) << 5)); }
__host__ __device__ __forceinline__ void stage_rc(int b, int& R, int& C) { const int st = b / 1024, sb = b % 1024, swz = sb ^ (((sb >> 9) & 1) << 5); R = (st >> 1) * 16 + swz / 64; C = (st & 1) * 32 + (swz % 64) / 2; }
__host__ __device__ __forceinline__ int perm32(int rho) { const int n = rho >> 4, i = rho & 15; return 8 * (i >> 2) + 4 * n + (i & 3); }

struct Unit { int pm, pn; };
struct Gemm { const bf16_t* A; const bf16_t* Bt; int M, N, K; };

struct StaticOrder {
    int nM, nN, nwg, G, c;
    __host__ __device__ void init(int M, int N, int G_, int c_) { nM = M / BM; nN = N / BM; nwg = nM * nN; G = G_; c = c_; }
    __host__ __device__ bool next(int i, Unit& u) const {
        const long L = (long)i * G + c; if (L >= nwg) return false;
        int wgid = (int)L; { const int q = nwg / NXCD, r = nwg % NXCD, xcd = wgid % NXCD, off = wgid / NXCD; wgid = (xcd < r ? xcd * (q + 1) : r * (q + 1) + (xcd - r) * q) + off; }
        const int nig = WGM * nN, gid = wgid / nig, fm = gid * WGM, gsz = (nM - fm) < WGM ? (nM - fm) : WGM;
        u.pm = fm + ((wgid % nig) % gsz); u.pn = (wgid % nig) / gsz; return true;
    }
    __device__ __forceinline__ void a_ready(const Unit&) const {}
    __device__ __forceinline__ void done(const Unit&) const {}
};


__device__ __forceinline__ unsigned cvt_pk_bf16(float lo, float hi) { unsigned r; asm volatile("v_cvt_pk_bf16_f32 %0, %1, %2" : "=v"(r) : "v"(lo), "v"(hi)); return r; }
__device__ __forceinline__ float silu_f(float x) { return x * __builtin_amdgcn_rcpf(1.0f + __builtin_amdgcn_exp2f(-1.4426950408889634f * x)); }

struct EpiBf16 {
    static constexpr bool PERM = true, AFTER_DRAIN = false;
    bf16_t* O; int ldc;
    __device__ __forceinline__ void operator()(const f32x4 (&acc)[2][2][4][2], const Unit& u, int wr, int wc, int fr, int fq) const {
        const int row0 = u.pm * BM + wr * 64 + fr; const int col0 = u.pn * BM + wc * 32 + 8 * fq;
#pragma unroll
        for (int ai = 0; ai < 2; ++ai)
#pragma unroll
            for (int m = 0; m < 4; ++m) { bf16_t* rowp = O + (size_t)(row0 + ai * HALF + m * 16) * ldc + col0;
#pragma unroll
                for (int bj = 0; bj < 2; ++bj) { const f32x4 v0 = acc[ai][bj][m][0], v1 = acc[ai][bj][m][1];
                    u32x4 w; w.x = cvt_pk_bf16(v0[0], v0[1]); w.y = cvt_pk_bf16(v0[2], v0[3]); w.z = cvt_pk_bf16(v1[0], v1[1]); w.w = cvt_pk_bf16(v1[2], v1[3]);
                    *(u32x4*)(rowp + bj * HALF) = w; } }
    }
};
struct EpiSwiGLU {
    static constexpr bool PERM = true, AFTER_DRAIN = false;
    bf16_t* O; int ldc;
    __device__ __forceinline__ void operator()(const f32x4 (&acc)[2][2][4][2], const Unit& u, int wr, int wc, int fr, int fq) const {
        const int row0 = u.pm * BM + wr * 64 + fr; const int col0 = u.pn * HALF + wc * 32 + 8 * fq;
#pragma unroll
        for (int ai = 0; ai < 2; ++ai)
#pragma unroll
            for (int m = 0; m < 4; ++m) { bf16_t* rowp = O + (size_t)(row0 + ai * HALF + m * 16) * ldc + col0;
                const f32x4 g0 = acc[ai][0][m][0], g1 = acc[ai][0][m][1], u0 = acc[ai][1][m][0], u1 = acc[ai][1][m][1];
                u32x4 w;
                w.x = cvt_pk_bf16(silu_f(g0[0]) * u0[0], silu_f(g0[1]) * u0[1]); w.y = cvt_pk_bf16(silu_f(g0[2]) * u0[2], silu_f(g0[3]) * u0[3]);
                w.z = cvt_pk_bf16(silu_f(g1[0]) * u1[0], silu_f(g1[1]) * u1[1]); w.w = cvt_pk_bf16(silu_f(g1[2]) * u1[2], silu_f(g1[3]) * u1[3]);
                *(u32x4*)rowp = w; }
    }
};
struct EpiResid {
    static constexpr bool PERM = false, AFTER_DRAIN = false;
    const float* xp; const float* xs; float* X; const float* gate; float alpha;
    __device__ __forceinline__ void operator()(const f32x4 (&acc)[2][2][4][2], const Unit& u, int wr, int wc, int fr, int fq) const {
        const int col0 = u.pn * BM + wc * 32 + 4 * fq; const int ci = u.pm < 32 ? 0 : 1 + ((u.pm - 32) >> 2);
        f32x4 gv[2][2];
#pragma unroll
        for (int bj = 0; bj < 2; ++bj)
#pragma unroll
            for (int n = 0; n < 2; ++n) gv[bj][n] = *(const f32x4*)(gate + (size_t)ci * 12288 + col0 + bj * HALF + n * 16);
#pragma unroll
        for (int ai = 0; ai < 2; ++ai)
#pragma unroll
            for (int m = 0; m < 4; ++m) { const int row = u.pm * BM + ai * HALF + wr * 64 + m * 16 + fr;
                const float* src = (row < 8192 ? xp + (size_t)row * 2048 : xs + (size_t)(row - 8192) * 2048) + col0; float* dst = X + (size_t)row * 2048 + col0;
#pragma unroll
                for (int bj = 0; bj < 2; ++bj)
#pragma unroll
                    for (int n = 0; n < 2; ++n) { const f32x4 xin = *(const f32x4*)(src + bj * HALF + n * 16);
                        *(f32x4*)(dst + bj * HALF + n * 16) = xin * alpha + gv[bj][n] * acc[ai][bj][m][n]; } }
    }
};

template <int KK, class Epi, class Sched, bool ALIGN_EPI = false, bool SP2 = false>
__device__ __forceinline__ void gemm_phase(PG8_LAS unsigned char* lds, const Gemm g, const Sched& S, const Epi& E) {
    int tid_ = threadIdx.x; asm volatile("" : "+v"(tid_)); const int tid = tid_, wid = __builtin_amdgcn_readfirstlane(tid >> 6), lane = tid & 63, wr = wid >> 2, wc = wid & 3, fr = lane & 15, fq = lane >> 4;
    constexpr int K = KK, nt = K / BK;
    unsigned voffA[2], voffB[2];
#pragma unroll
    for (int i = 0; i < 2; ++i) { int R, C; stage_rc(tid * 16 + i * 8192, R, C); const int Rb = Epi::PERM ? ((R & ~31) + perm32(R & 31)) : R;
        voffA[i] = (unsigned)(R * K + C) * 2u; voffB[i] = (unsigned)(Rb * K + C) * 2u; }
    const size_t kstep = (size_t)(BK * 2);
    const size_t hstep = (size_t)HALF * K * 2;
    const size_t tstep = 2 * hstep;
    const unsigned ldsw = (unsigned)wid * 1024u;
    const int aoff = lds_byte(wr * 64 + fr, fq * 8), boff = lds_byte(wc * 32 + fr, fq * 8);
#define PG8_SA(b, h) (((b) * 2 + (h)) * HTB)
#define PG8_SB(b, h) ((4 + (b) * 2 + (h)) * HTB)
#define PG8_STAGE(bufoff, gbase, voff) do { _Pragma("unroll") for (int _i = 0; _i < 2; ++_i) \
        __builtin_amdgcn_global_load_lds((const unsigned*)((const char*)(gbase) + (voff)[_i]), (PG8_LAS unsigned*)(lds + (bufoff) + ldsw + _i * 8192), 16, 0, 0); } while (0)
#define PG8_LDA(dst, b, h) do { _Pragma("unroll") for (int m = 0; m < 4; ++m) _Pragma("unroll") for (int k = 0; k < 2; ++k) dst[m][k] = *(const PG8_LAS bf16x8*)(lds + PG8_SA(b, h) + aoff + m * 2048 + k * 1024); } while (0)
#define PG8_LDB(dst, b, h) do { _Pragma("unroll") for (int n = 0; n < 2; ++n) _Pragma("unroll") for (int k = 0; k < 2; ++k) dst[n][k] = *(const PG8_LAS bf16x8*)(lds + PG8_SB(b, h) + boff + n * 2048 + k * 1024); } while (0)
#define PG8_MMA(ai, bj, At, Bt) do { __builtin_amdgcn_s_setprio(1); _Pragma("unroll") for (int m = 0; m < 4; ++m) _Pragma("unroll") for (int n = 0; n < 2; ++n) _Pragma("unroll") for (int k = 0; k < 2; ++k) \
        acc[ai][bj][m][n] = __builtin_amdgcn_mfma_f32_16x16x32_bf16(Bt[n][k], At[m][k], acc[ai][bj][m][n], 0, 0, 0); __builtin_amdgcn_s_setprio(0); } while (0)
#define PG8_WAIT_V(n) asm volatile("s_waitcnt vmcnt(" #n ")" ::: "memory")
#define PG8_WAIT_L(n) asm volatile("s_waitcnt lgkmcnt(" #n ")" ::: "memory")
#define PG8_BAR __builtin_amdgcn_s_barrier()
#define PG8_SCHED __builtin_amdgcn_sched_barrier(0)
    Unit cur, nxt; int ui = 0;
    if (!S.next(0, cur)) return;
    f32x4 acc[2][2][4][2];
#pragma unroll
    for (int a = 0; a < 2; ++a)
#pragma unroll
        for (int b = 0; b < 2; ++b)
#pragma unroll
            for (int m = 0; m < 4; ++m)
#pragma unroll
                for (int n = 0; n < 2; ++n) acc[a][b][m][n] = (f32x4){0.f, 0.f, 0.f, 0.f};
    bf16x8 At[4][2], B0[2][2], B1[2][2];
    const char* cA = (const char*)g.A + (size_t)cur.pm * tstep; const char* cB = (const char*)g.Bt + (size_t)cur.pn * tstep;
    S.a_ready(cur);
    if constexpr (SP2) {
        PG8_STAGE(PG8_SB(0, 0), cB, voffB); PG8_STAGE(PG8_SB(0, 1), cB + hstep, voffB); PG8_STAGE(PG8_SA(0, 0), cA, voffA); PG8_STAGE(PG8_SA(0, 1), cA + hstep, voffA);
        if (wr == 1) PG8_BAR;
        PG8_WAIT_V(2); PG8_BAR;
        PG8_STAGE(PG8_SB(1, 0), cB + kstep, voffB); PG8_STAGE(PG8_SA(1, 0), cA + kstep, voffA); PG8_STAGE(PG8_SB(1, 1), cB + hstep + kstep, voffB);
        PG8_WAIT_V(6); PG8_BAR;
    } else {
        PG8_STAGE(PG8_SB(0, 0), cB, voffB); PG8_STAGE(PG8_SA(0, 0), cA, voffA); PG8_STAGE(PG8_SB(0, 1), cB + hstep, voffB); PG8_STAGE(PG8_SA(0, 1), cA + hstep, voffA);
        if (wr == 1) PG8_BAR;
        PG8_WAIT_V(4); PG8_BAR;
        PG8_STAGE(PG8_SB(1, 0), cB + kstep, voffB); PG8_STAGE(PG8_SA(1, 0), cA + kstep, voffA); PG8_STAGE(PG8_SB(1, 1), cB + hstep + kstep, voffB);
        PG8_WAIT_V(6); PG8_BAR;
    }
    for (;;) {
        const bool has_next = S.next(ui + 1, nxt);
        const char* nA = has_next ? (const char*)g.A + (size_t)nxt.pm * tstep : cA; const char* nB = has_next ? (const char*)g.Bt + (size_t)nxt.pn * tstep : cB;
        for (int t = 0; t < nt; t += 2) {
            const bool last = (t == nt - 2);
            const char* a1 = cA + (size_t)(t + 1) * kstep;
            const char* a2 = last ? nA : cA + (size_t)(t + 2) * kstep; const char* b2 = last ? nB : cB + (size_t)(t + 2) * kstep;
            const char* a3 = a2 + kstep; const char* b3 = b2 + kstep;
            if (last && has_next) S.a_ready(nxt);
            if constexpr (SP2) {
            PG8_LDB(B0, 0, 0); PG8_LDB(B1, 0, 1); PG8_SCHED; PG8_LDA(At, 0, 0); PG8_STAGE(PG8_SA(1, 1), a1 + hstep, voffA);
            PG8_WAIT_V(8); PG8_WAIT_L(0); PG8_BAR; PG8_MMA(0, 0, At, B0); PG8_MMA(0, 1, At, B1); PG8_BAR; PG8_SCHED;
            PG8_LDA(At, 0, 1); PG8_STAGE(PG8_SB(0, 0), b2, voffB); PG8_STAGE(PG8_SB(0, 1), b2 + hstep, voffB); PG8_STAGE(PG8_SA(0, 0), a2, voffA);
            PG8_WAIT_V(8); PG8_WAIT_L(0); PG8_BAR; PG8_MMA(1, 0, At, B0); PG8_MMA(1, 1, At, B1); PG8_BAR; PG8_SCHED;
            PG8_LDB(B0, 1, 0); PG8_LDB(B1, 1, 1); PG8_SCHED; PG8_LDA(At, 1, 0); PG8_STAGE(PG8_SA(0, 1), a2 + hstep, voffA);
            PG8_WAIT_V(8); PG8_WAIT_L(0); PG8_BAR; PG8_MMA(0, 0, At, B0); PG8_MMA(0, 1, At, B1); PG8_BAR; PG8_SCHED;
            PG8_LDA(At, 1, 1); PG8_STAGE(PG8_SB(1, 0), b3, voffB); PG8_STAGE(PG8_SB(1, 1), b3 + hstep, voffB); PG8_STAGE(PG8_SA(1, 0), a3, voffA);
            PG8_WAIT_V(8); PG8_WAIT_L(0); PG8_BAR; PG8_MMA(1, 0, At, B0); PG8_MMA(1, 1, At, B1); PG8_BAR; PG8_SCHED;
            } else {
            PG8_LDB(B0, 0, 0); PG8_SCHED; PG8_LDA(At, 0, 0); PG8_STAGE(PG8_SA(1, 1), a1 + hstep, voffA);
            PG8_WAIT_L(8); PG8_BAR; PG8_WAIT_L(0); PG8_MMA(0, 0, At, B0); PG8_BAR; PG8_SCHED;
            PG8_LDB(B1, 0, 1); PG8_STAGE(PG8_SB(0, 0), b2, voffB);
            PG8_BAR; PG8_WAIT_L(0); PG8_MMA(0, 1, At, B1); PG8_BAR;
            PG8_LDA(At, 0, 1); PG8_STAGE(PG8_SA(0, 0), a2, voffA);
            PG8_BAR; PG8_WAIT_L(0); PG8_MMA(1, 0, At, B0); PG8_BAR; PG8_SCHED;
            PG8_STAGE(PG8_SB(0, 1), b2 + hstep, voffB);
            PG8_WAIT_V(6); PG8_BAR; PG8_MMA(1, 1, At, B1); PG8_BAR;
            PG8_LDB(B0, 1, 0); PG8_SCHED; PG8_LDA(At, 1, 0); PG8_STAGE(PG8_SA(0, 1), a2 + hstep, voffA);
            PG8_WAIT_L(8); PG8_BAR; PG8_WAIT_L(0); PG8_MMA(0, 0, At, B0); PG8_BAR; PG8_SCHED;
            PG8_LDB(B1, 1, 1); PG8_STAGE(PG8_SB(1, 0), b3, voffB);
            PG8_BAR; PG8_WAIT_L(0); PG8_MMA(0, 1, At, B1); PG8_BAR;
            PG8_LDA(At, 1, 1); PG8_STAGE(PG8_SA(1, 0), a3, voffA);
            PG8_BAR; PG8_WAIT_L(0); PG8_MMA(1, 0, At, B0); PG8_BAR; PG8_SCHED;
            PG8_STAGE(PG8_SB(1, 1), b3 + hstep, voffB);
            PG8_WAIT_V(6); PG8_BAR; PG8_MMA(1, 1, At, B1); PG8_BAR;
            }
        }
        if constexpr (ALIGN_EPI) { if (wr == 0) PG8_BAR; }
        if constexpr (!Epi::AFTER_DRAIN) { E(acc, cur, wr, wc, fr, fq); S.done(cur); }
        if (!has_next) break;
#pragma unroll
        for (int a = 0; a < 2; ++a)
#pragma unroll
            for (int b = 0; b < 2; ++b)
#pragma unroll
                for (int m = 0; m < 4; ++m)
#pragma unroll
                    for (int n = 0; n < 2; ++n) acc[a][b][m][n] = (f32x4){0.f, 0.f, 0.f, 0.f};
        cur = nxt; cA = nA; cB = nB; ++ui;
        if constexpr (ALIGN_EPI) { if (wr == 1) PG8_BAR; }
    }
    PG8_WAIT_V(0);
    if constexpr (!ALIGN_EPI) { if (wr == 0) PG8_BAR; }
    PG8_BAR;
    if constexpr (Epi::AFTER_DRAIN) { E.fused(acc, cur, wr, wc, fr, fq, lds, wid, lane); S.done(cur); }
#undef PG8_SA
#undef PG8_SB
#undef PG8_STAGE
#undef PG8_LDA
#undef PG8_LDB
#undef PG8_MMA
#undef PG8_WAIT_V
#undef PG8_WAIT_L
#undef PG8_BAR
#undef PG8_SCHED
}
}

namespace att {
using bf16 = __hip_bfloat16;
constexpr int   D = 128, NW = 8, QBLK = 32, KVBLK = 64;
constexpr float SCALE = 0.088388347648318440f;
constexpr float THR = 8.f;
constexpr int SDEPTH = 2;
constexpr int LDQ = 1024, LDK = 256, LDO = 2048;
using bf16x8 = __attribute__((ext_vector_type(8))) short;
using s16x4  = __attribute__((ext_vector_type(4))) short;
using f32x16 = __attribute__((ext_vector_type(16))) float;
using f32x8  = __attribute__((ext_vector_type(8))) float;
using u32x4  = __attribute__((ext_vector_type(4))) unsigned;
constexpr size_t SHM_V = KVBLK * D * 2, SHM_K = KVBLK * D * 2, SHM_ATTN = 2 * SHM_V + 2 * SHM_K + NW * 64 * 4;
#define KSWZ(row, colB) ((row) * 256 + ((colB) ^ (((row) & 7) << 4)))
#define SBAR() __builtin_amdgcn_sched_barrier(0)
__device__ __forceinline__ int crow(int r, int hi) { return (r & 3) + 8 * (r >> 2) + 4 * hi; }
__device__ __forceinline__ unsigned cvtpk(float lo, float hi) {
  unsigned r; asm volatile("v_cvt_pk_bf16_f32 %0, %1, %2" : "=v"(r) : "v"(lo), "v"(hi)); return r;
}
template <typename TIn> struct Stage;
template <> struct Stage<bf16>  { using T = bf16x8;
  __device__ static __forceinline__ T ld8(const bf16* p) { return *reinterpret_cast<const bf16x8*>(p); }
  __device__ static __forceinline__ bf16x8 tobf(T x) { return x; } };
template <> struct Stage<float> { using T = f32x8;
  __device__ static __forceinline__ T ld8(const float* p) { return *reinterpret_cast<const f32x8*>(p); }
  __device__ static __forceinline__ bf16x8 tobf(T x) {
    u32x4 w = {cvtpk(x[0], x[1]), cvtpk(x[2], x[3]), cvtpk(x[4], x[5]), cvtpk(x[6], x[7])}; return *reinterpret_cast<bf16x8*>(&w); } };

__device__ __forceinline__ void partialSM(f32x16& p0, f32x16& p1, float& m_reg, float& mn, float& alpha) {
  constexpr float C = SCALE * 1.4426950408889634f;
  float pmax = p0[0]; for (int r = 1; r < 16; ++r) pmax = fmaxf(pmax, p0[r]); for (int r = 0; r < 16; ++r) pmax = fmaxf(pmax, p1[r]);
  { auto rr = __builtin_amdgcn_permlane32_swap(__float_as_uint(pmax), __float_as_uint(pmax), false, false);
    pmax = fmaxf(__uint_as_float(rr[0]), __uint_as_float(rr[1])); }
  if (__builtin_expect(__all(pmax - m_reg <= THR / SCALE), 1)) { mn = m_reg; alpha = 1.f; }
  else { mn = fmaxf(m_reg, pmax); alpha = __builtin_amdgcn_exp2f((m_reg - mn) * C); m_reg = mn; }
  float mnC = -mn * C;
  for (int r = 0; r < 16; ++r) p0[r] = fmaf(p0[r], C, mnC); for (int r = 0; r < 16; ++r) p1[r] = fmaf(p1[r], C, mnC);
  for (int r = 0; r < 16; ++r) p0[r] = __builtin_amdgcn_exp2f(p0[r]);
}
__device__ __forceinline__ void finishSM(f32x16& p0, f32x16& p1, float alpha, float& l_reg, bf16x8& pa0, bf16x8& pa1, bf16x8& pa2, bf16x8& pa3) {
  for (int r = 0; r < 16; ++r) p1[r] = __builtin_amdgcn_exp2f(p1[r]);
  float ps = 0; for (int r = 0; r < 16; ++r) ps += p0[r]; for (int r = 0; r < 16; ++r) ps += p1[r];
  { auto rr = __builtin_amdgcn_permlane32_swap(__float_as_uint(ps), __float_as_uint(ps), false, false);
    ps = __uint_as_float(rr[0]) + __uint_as_float(rr[1]); }
  l_reg = l_reg * alpha + ps;
#define PK4(P, BASE, OUT) do { unsigned a0 = cvtpk(P[BASE + 0], P[BASE + 1]), a1 = cvtpk(P[BASE + 2], P[BASE + 3]);   \
    unsigned b0 = cvtpk(P[BASE + 4], P[BASE + 5]), b1 = cvtpk(P[BASE + 6], P[BASE + 7]);                              \
    auto r0 = __builtin_amdgcn_permlane32_swap(a0, b0, false, false); auto r1 = __builtin_amdgcn_permlane32_swap(a1, b1, false, false); \
    u32x4 w = {r0[0], r1[0], r0[1], r1[1]}; OUT = *reinterpret_cast<bf16x8*>(&w); } while (0)
  PK4(p0, 0, pa0); PK4(p0, 8, pa1); PK4(p1, 0, pa2); PK4(p1, 8, pa3);
#undef PK4
}
__device__ __forceinline__ void qkt(f32x16& p0, f32x16& p1, const bf16* Ks, const bf16x8* qr, int r32, int hi) {
  p0 = f32x16{}; p1 = f32x16{};
  for (int d0 = 0; d0 < 8; ++d0) { int cb = (d0 * 16 + hi * 8) * 2;
    bf16x8 b0 = *reinterpret_cast<const bf16x8*>((const char*)Ks + KSWZ(r32, cb));
    bf16x8 b1 = *reinterpret_cast<const bf16x8*>((const char*)Ks + KSWZ(32 + r32, cb));
    p0 = __builtin_amdgcn_mfma_f32_32x32x16_bf16(b0, qr[d0], p0, 0, 0, 0);
    p1 = __builtin_amdgcn_mfma_f32_32x32x16_bf16(b1, qr[d0], p1, 0, 0, 0); }
}
__device__ __forceinline__ int v_st(int k, int c) { const int kk = (k & ~0xC) | ((k & 4) << 1) | ((k & 8) >> 1); return ((kk >> 3) * 4 + (c >> 5)) * 512 + ((kk & 7) * 32 + (c & 31)) * 2; }
__device__ __forceinline__ int v_rd_base(int lane) { return ((lane & 3) << 3) | (((lane >> 2) & 3) << 6) | (((lane >> 4) & 1) << 5) | (((lane >> 5) & 1) << 8); }
constexpr int v_rd_off(int d0, int ks, int half) { return d0 * 512 + ks * 4096 + half * 2048; }
template <int OFF> __device__ __forceinline__ s16x4 tr_read(int vb) {
  s16x4 r; asm volatile("ds_read_b64_tr_b16 %0, %1 offset:%2" : "=&v"(r) : "v"(vb), "i"(OFF) : "memory"); return r;
}
template <int D0> __device__ __forceinline__ void pv_one(f32x16& od, int vb, bf16x8 pa0, bf16x8 pa1, bf16x8 pa2, bf16x8 pa3) {
  const s16x4 l0 = tr_read<v_rd_off(D0, 0, 0)>(vb), h0 = tr_read<v_rd_off(D0, 0, 1)>(vb), l1 = tr_read<v_rd_off(D0, 1, 0)>(vb), h1 = tr_read<v_rd_off(D0, 1, 1)>(vb);
  const s16x4 l2 = tr_read<v_rd_off(D0, 2, 0)>(vb), h2 = tr_read<v_rd_off(D0, 2, 1)>(vb), l3 = tr_read<v_rd_off(D0, 3, 0)>(vb), h3 = tr_read<v_rd_off(D0, 3, 1)>(vb);
  asm volatile("s_waitcnt lgkmcnt(0)" ::: "memory"); SBAR();
#define PK(L, H) (bf16x8){L[0], L[1], L[2], L[3], H[0], H[1], H[2], H[3]}
  od = __builtin_amdgcn_mfma_f32_32x32x16_bf16(pa0, PK(l0, h0), od, 0, 0, 0);
  od = __builtin_amdgcn_mfma_f32_32x32x16_bf16(pa1, PK(l1, h1), od, 0, 0, 0);
  od = __builtin_amdgcn_mfma_f32_32x32x16_bf16(pa2, PK(l2, h2), od, 0, 0, 0);
  od = __builtin_amdgcn_mfma_f32_32x32x16_bf16(pa3, PK(l3, h3), od, 0, 0, 0);
#undef PK
}
__device__ __forceinline__ void pv_d0(f32x16* o, int vb, bf16x8 pa0, bf16x8 pa1, bf16x8 pa2, bf16x8 pa3) {
  pv_one<0>(o[0], vb, pa0, pa1, pa2, pa3); pv_one<1>(o[1], vb, pa0, pa1, pa2, pa3); pv_one<2>(o[2], vb, pa0, pa1, pa2, pa3); pv_one<3>(o[3], vb, pa0, pa1, pa2, pa3);
}

template <typename TQ>
__device__ __forceinline__ void attn_dense_body(const TQ* __restrict__ Qb, const bf16* __restrict__ Kh, const bf16* __restrict__ Vh,
                                                bf16* __restrict__ Ob, int seq, char* lds) {
  using St = Stage<bf16>; using SQ = Stage<TQ>;
  int tid_ = threadIdx.x; asm volatile("" : "+v"(tid_)); const int tid = tid_, wid = tid >> 6, lane = tid & 63, r32 = lane & 31, hi = lane >> 5;
  bf16* V_lds = (bf16*)lds; bf16* K_lds = (bf16*)(lds + 2 * SHM_V);
  float* ws = (float*)(lds + 2 * SHM_V + 2 * SHM_K) + wid * 64; float* li_l = ws; float* al_l = ws + 32;
  float m_reg = -1e30f, l_reg = 0; f32x16 o[4] = {}; bf16x8 qr[8];
  const TQ* Qw = Qb + (long)(wid * QBLK + r32) * LDQ + hi * 8;
#pragma unroll
  for (int d0 = 0; d0 < 8; ++d0) qr[d0] = SQ::tobf(SQ::ld8(Qw + d0 * 16));
  const int sr = tid >> 4, sc = (tid & 15) * 8, vst0 = v_st(sr, sc), vst1 = v_st(32 + sr, sc);
  const int vb0 = (int)(uintptr_t)V_lds + v_rd_base(lane);
  struct { typename St::T vs0, vs1, ks0, ks1; } sr_[SDEPTH];
#define SLOAD(i, k0) do { sr_[i].vs0 = St::ld8(&Vh[(long)((k0) + sr) * LDK + sc]); sr_[i].vs1 = St::ld8(&Vh[(long)((k0) + 32 + sr) * LDK + sc]); \
    sr_[i].ks0 = St::ld8(&Kh[(long)((k0) + sr) * LDK + sc]); sr_[i].ks1 = St::ld8(&Kh[(long)((k0) + 32 + sr) * LDK + sc]); } while (0)
#define SWRITE(b, i) do { *(bf16x8*)((char*)V_lds + (b) * SHM_V + vst0) = St::tobf(sr_[i].vs0);          \
    *(bf16x8*)((char*)V_lds + (b) * SHM_V + vst1) = St::tobf(sr_[i].vs1); int kc = sc * 2;               \
    *(bf16x8*)((char*)K_lds + (b) * SHM_K + KSWZ(sr, kc)) = St::tobf(sr_[i].ks0);                       \
    *(bf16x8*)((char*)K_lds + (b) * SHM_K + KSWZ(32 + sr, kc)) = St::tobf(sr_[i].ks1); } while (0)
#define SWAIT() do { if constexpr (SDEPTH == 2) asm volatile("s_waitcnt vmcnt(4)" ::: "memory"); else asm volatile("s_waitcnt vmcnt(0)" ::: "memory"); } while (0)
#define RESC(a) do { if (__any((a) < 1.f)) { if (hi == 0) al_l[r32] = (a); asm volatile("s_waitcnt lgkmcnt(0)" ::: "memory"); \
    for (int d = 0; d < 4; ++d) for (int r = 0; r < 16; ++r) o[d][r] *= al_l[crow(r, hi)]; } } while (0)
  f32x16 pA0, pA1, pB0, pB1; float mnA, mnB, alA, alB; bf16x8 pa0, pa1, pa2, pa3; const int NT = seq / KVBLK;
  constexpr int SE = 0, SO = SDEPTH - 1;
  SLOAD(SE, 0); asm volatile("s_waitcnt vmcnt(0)" ::: "memory"); SWRITE(0, SE); __syncthreads();
  qkt(pA0, pA1, K_lds, qr, r32, hi); partialSM(pA0, pA1, m_reg, mnA, alA);
  SLOAD(SO, KVBLK); if constexpr (SDEPTH == 2) { if (2 < NT) SLOAD(SE, 2 * KVBLK); }
  SWAIT(); SWRITE(1, SO); __syncthreads();
  for (int j = 1; j + 1 < NT; j += 2) {
    SBAR(); qkt(pB0, pB1, (bf16*)((char*)K_lds + SHM_K), qr, r32, hi);
    finishSM(pA0, pA1, alA, l_reg, pa0, pa1, pa2, pa3); SBAR();
    SLOAD(SO, (j + SDEPTH) * KVBLK); SBAR();
    pv_d0(o, vb0, pa0, pa1, pa2, pa3); partialSM(pB0, pB1, m_reg, mnB, alB);
    __syncthreads(); SWAIT(); SWRITE(0, SE);
    RESC(alB); __syncthreads();
    SBAR(); qkt(pA0, pA1, K_lds, qr, r32, hi);
    finishSM(pB0, pB1, alB, l_reg, pa0, pa1, pa2, pa3); SBAR();
    if (SDEPTH == 1 || j + 3 < NT) SLOAD(SE, (j + 1 + SDEPTH) * KVBLK); SBAR();
    pv_d0(o, vb0 + (int)SHM_V, pa0, pa1, pa2, pa3); partialSM(pA0, pA1, m_reg, mnA, alA);
    __syncthreads(); SWAIT(); SWRITE(1, SO);
    RESC(alA); __syncthreads();
  }
  SBAR(); qkt(pB0, pB1, (bf16*)((char*)K_lds + SHM_K), qr, r32, hi);
  finishSM(pA0, pA1, alA, l_reg, pa0, pa1, pa2, pa3); SBAR();
  pv_d0(o, vb0, pa0, pa1, pa2, pa3); partialSM(pB0, pB1, m_reg, mnB, alB);
  __syncthreads(); RESC(alB);
  finishSM(pB0, pB1, alB, l_reg, pa0, pa1, pa2, pa3); SBAR();
  pv_d0(o, vb0 + (int)SHM_V, pa0, pa1, pa2, pa3);
  if (hi == 0) li_l[r32] = l_reg; asm volatile("s_waitcnt lgkmcnt(0)" ::: "memory");
  float rli[16];
#pragma unroll
  for (int r = 0; r < 16; ++r) rli[r] = __builtin_amdgcn_rcpf(li_l[crow(r, hi)]);
  bf16* Ow = Ob + (long)(wid * QBLK) * LDO;
#pragma unroll
  for (int r = 0; r < 16; ++r) { int orow = crow(r, hi);
    for (int d0 = 0; d0 < 4; ++d0) Ow[(long)orow * LDO + d0 * 32 + r32] = __float2bfloat16(o[d0][r] * rli[r]); }
#undef SLOAD
#undef SWRITE
#undef SWAIT
#undef RESC
}

}

#ifndef MK_PER_PHASE
#define MK_PER_PHASE 0
#endif
constexpr int NWAVES = 8;

constexpr int DM = 2048, NB_CTX = 32, SEQ = 256, DEPTH = 2, NB_LAT = 2, LSEQ = 1024, PAST = 512;
constexpr int M_CTX = NB_CTX * SEQ, M_LAT = NB_LAT * LSEQ, M = M_CTX + M_LAT;
constexpr int HG = 8, DKV = 128, GDN_W = 1024, NQ = 8, NKV = 2, HD = 128, ATT_W = 1024;
constexpr int QKV_W = 3072, IN_W = 5664, IN_WP = 5888, DFF = 5632, CONVK = 5;
constexpr int C_Z = 3072, C_B = 4096, C_A = 4112, C_AQ = 4128, C_AK = 5152, C_AV = 5408;
constexpr int KROWS = M_CTX + NB_LAT * (LSEQ + PAST);
constexpr float RMS_EPS = 1e-6f, LN_EPS = 1e-5f;
constexpr float DN_ALPHA = 1.4142135623730951f;
constexpr size_t OUT_YP = 0, OUT_YS = 16777216, OUT_CK = 20971520, OUT_CV = 25165824, OUT_ST = 29360128, OUT_TOTAL = 46137344;
enum { I_XP = 0, I_XS, I_CK, I_CV, I_ST, I_C, I_CCTX, I_WADA, I_BADA, I_WIN, I_CONVW, I_ALOG, I_DTB, I_GNW, I_QNW, I_KNW, I_WO, I_LN1G, I_LN1B, I_LN2G, I_LN2B, I_WGU, I_WD, N_IN };

constexpr size_t MiB = 1u << 20;
constexpr size_t WS_CTL = 0, CTL_ZERO_BYTES = 1 * MiB;
constexpr size_t WS_MOD = 1 * MiB;
constexpr size_t WS_WIN = 2 * MiB;
constexpr size_t WS_WO  = WS_WIN + (size_t)DEPTH * IN_WP * DM * 2;
constexpr size_t WS_WGU = WS_WO + (size_t)DEPTH * DM * DM * 2;
constexpr size_t WS_WD  = WS_WGU + (size_t)DEPTH * 2 * DFF * DM * 2;
constexpr size_t WS_H   = WS_WD + (size_t)DEPTH * DM * DFF * 2;
constexpr size_t WS_MIX = WS_H + (size_t)M * DM * 2;
constexpr size_t WS_PROJ = WS_MIX + (size_t)M * DM * 2;
constexpr size_t WS_QG  = WS_PROJ + (size_t)M * IN_WP * 2;
constexpr size_t WS_KG  = WS_QG + (size_t)M * GDN_W * 2;
constexpr size_t WS_VG  = WS_KG + (size_t)M * GDN_W * 2;
constexpr size_t WS_GG  = WS_VG + (size_t)M * GDN_W * 2;
constexpr size_t WS_BB  = WS_GG + (size_t)M * 16 * 4;
constexpr size_t WS_OF  = WS_BB + (size_t)M * 16 * 4;
constexpr size_t WS_OB  = WS_OF + (size_t)M * GDN_W * 4;
constexpr size_t WS_QA  = WS_OB + (size_t)M * GDN_W * 4;
constexpr size_t WS_KA  = WS_QA + (size_t)M * ATT_W * 2;
constexpr size_t WS_VA  = WS_KA + (size_t)KROWS * 256 * 2;
constexpr size_t WS_END = WS_VA + (size_t)KROWS * 256 * 2;
static_assert(WS_WIN % 256 == 0 && WS_WO % 256 == 0 && WS_WGU % 256 == 0 && WS_WD % 256 == 0 && WS_H % 256 == 0 && WS_MIX % 256 == 0 && WS_PROJ % 256 == 0 && WS_QG % 256 == 0 && WS_GG % 256 == 0 && WS_OF % 256 == 0 && WS_QA % 256 == 0 && WS_KA % 256 == 0 && WS_VA % 256 == 0, "ws alignment");
static_assert(WS_MOD + (size_t)DEPTH * 3 * 12288 * 4 <= WS_WIN, "mod table");
constexpr int CW_TMO = 0, CW_CODE = 1, CW_BAR = 4096;

constexpr int RING_OFF = 0, RING_BYTES = 131072;
constexpr int LDSCTL_OFF = RING_BYTES, MISC_OFF = LDSCTL_OFF + 320;
constexpr int LDS_BYTES = 147456;

#define GAS __attribute__((address_space(1)))
#define LAS __attribute__((address_space(3)))
typedef unsigned short bf16;
typedef unsigned v4u __attribute__((ext_vector_type(4)));
typedef unsigned v2u __attribute__((ext_vector_type(2)));
typedef float f32x4 __attribute__((ext_vector_type(4)));
typedef float f32x2 __attribute__((ext_vector_type(2)));
typedef GAS unsigned gu32;
#define RLX_AGENT __ATOMIC_RELAXED, __HIP_MEMORY_SCOPE_AGENT
#define LDS_WAIT() asm volatile("s_waitcnt lgkmcnt(0)" ::: "memory")
#define VM_WAIT() asm volatile("s_waitcnt vmcnt(0)" ::: "memory")
__device__ __forceinline__ unsigned f2bf(float f) { unsigned u = __builtin_bit_cast(unsigned, f); return (u + 0x7fffu + ((u >> 16) & 1u)) >> 16; }
__device__ __forceinline__ unsigned pk2(float lo, float hi) { return f2bf(lo) | (f2bf(hi) << 16); }
__device__ __forceinline__ float bf_lo(unsigned w) { return __builtin_bit_cast(float, w << 16); }
__device__ __forceinline__ float bf_hi(unsigned w) { return __builtin_bit_cast(float, w & 0xffff0000u); }
__device__ __forceinline__ float bf1(bf16 h) { return __builtin_bit_cast(float, (unsigned)h << 16); }
__device__ __forceinline__ float wave_sum(float v) {
#pragma unroll
    for (int o = 1; o < 64; o <<= 1) v += __shfl_xor(v, o);
    return v;
}
__device__ __forceinline__ float silu(float x) { return x / (1.0f + __expf(-x)); }
#define XB_TMO      128
#define XB_XCNT(j)  (256  + 64 * (j))
#define XB_XSUB(j)  (1280 + 64 * (j))
#define XB_XGEN(j)  (2304 + 64 * (j))
#define XB_TOP      3328
#define XB_TOPGEN   3392
#define XCD_BAR_WORDS 3456
#define XB_SPIN_CAP (1u << 18)

__device__ __forceinline__ unsigned xb_ld(unsigned* p)              { return __hip_atomic_load(p, __ATOMIC_RELAXED, __HIP_MEMORY_SCOPE_AGENT); }
__device__ __forceinline__ unsigned xb_add(unsigned* p, unsigned v) { return __hip_atomic_fetch_add(p, v, __ATOMIC_RELAXED, __HIP_MEMORY_SCOPE_AGENT); }
__device__ __forceinline__ unsigned xb_xcc_id() { return (unsigned)__builtin_amdgcn_s_getreg((3 << 11) | 20) & 0xFu; }
#define XB_SPIN(cond, bar) do { unsigned _sp = 0; while (cond) { __builtin_amdgcn_s_sleep(1); \
    if ((++_sp & 255u) == 0u) { if (xb_ld(&(bar)[XB_TMO])) break; if (_sp > XB_SPIN_CAP) { atomicAdd(&(bar)[XB_TMO], 1u); break; } } } } while (0)

struct XcdBarrier {
    unsigned* bar; unsigned x;
    volatile LAS unsigned* st;
};

__device__ __forceinline__ XcdBarrier xcd_barrier_post(unsigned* bar, volatile LAS unsigned* st) {
    XcdBarrier b; b.bar = bar; b.x = xb_xcc_id(); b.st = st;
    if (threadIdx.x == 0) (void)xb_add(&bar[XB_XCNT(b.x)], 1u);
    return b;
}
__device__ __forceinline__ void xcd_barrier_complete(unsigned* bar, unsigned x, unsigned& nloc, unsigned& nx) {
    const unsigned G = gridDim.x * gridDim.y * gridDim.z;
    unsigned sum, cnt, mine, sp = 0u;
    for (;;) {
        sum = 0u; cnt = 0u; mine = 0u;
#pragma unroll
        for (unsigned j = 0; j < 16; ++j) { const unsigned c = xb_ld(&bar[XB_XCNT(j)]); sum += c; cnt += (c > 0u) ? 1u : 0u; mine = (j == x) ? c : mine; }
        if (sum == G) break;
        __builtin_amdgcn_s_sleep(1);
        if ((++sp & 255u) == 0u) { if (xb_ld(&bar[XB_TMO])) break; if (sp > XB_SPIN_CAP) { atomicAdd(&bar[XB_TMO], 1u); break; } }
    }
    nloc = mine > 0u ? mine : 1u; nx = cnt > 0u ? cnt : 1u;
}

__device__ __forceinline__ void xcd_barrier(const XcdBarrier& b) {
    asm volatile("s_waitcnt vmcnt(0)" ::: "memory");
    __syncthreads();
    if (threadIdx.x == 0) {
        unsigned* bar = b.bar;
        __builtin_amdgcn_s_waitcnt(0);
        unsigned nloc = b.st[0], nx = b.st[1];
        if (nloc == 0u) { xcd_barrier_complete(bar, b.x, nloc, nx); b.st[0] = nloc; b.st[1] = nx; }
        const unsigned old = xb_add(&bar[XB_XSUB(b.x)], 1u);
        const unsigned gen = old / nloc;
        if (old + 1u == (gen + 1u) * nloc) {
            __builtin_amdgcn_fence(__ATOMIC_RELEASE, "agent");
            asm volatile("s_waitcnt vmcnt(0)" ::: "memory");
            const unsigned og = xb_add(&bar[XB_TOP], 1u);
            const unsigned tg = og / nx;
            if (og + 1u == (tg + 1u) * nx) xb_add(&bar[XB_TOPGEN], 1u);
            else XB_SPIN(xb_ld(&bar[XB_TOPGEN]) == tg, bar);
            __builtin_amdgcn_fence(__ATOMIC_ACQUIRE, "agent");
            xb_add(&bar[XB_XGEN(b.x)], 1u);
            asm volatile("s_waitcnt vmcnt(0)" ::: "memory");
        } else {
            XB_SPIN(xb_ld(&bar[XB_XGEN(b.x)]) == gen, bar);
            __builtin_amdgcn_fence(__ATOMIC_ACQUIRE, "agent");
            asm volatile("s_waitcnt vmcnt(0)" ::: "memory");
        }
    }
    __syncthreads();
}

struct Args { const float* in[N_IN]; float* out; unsigned char* ws; int ph_lo, ph_hi; };
static_assert(sizeof(Args) == 8 * (N_IN + 2) + 8, "Args has no padding");
#define CAS __attribute__((address_space(4)))
#define ARGS_T const CAS Args
__device__ __forceinline__ ARGS_T* fresh_args() { const CAS char* p = (const CAS char*)__builtin_amdgcn_kernarg_segment_ptr(); asm volatile("" : "+s"(p)); return (ARGS_T*)p; }
__device__ __forceinline__ int fresh_tid() { int t = threadIdx.x; asm volatile("" : "+v"(t)); return t; }
__device__ __forceinline__ int fresh_bx() { int b = blockIdx.x; asm volatile("" : "+s"(b)); return b; }

struct Frame {
    LAS unsigned char* lds;
    volatile LAS unsigned* MISC;
    gu32* ctl;
    int tid, lane, wave;
    int vcu, G, bx;
    float* out;
    unsigned char* ws;
};
#define WSP(T, off) ((T*)(F.ws + (off)))

__device__ __forceinline__ void p0_transpose_item(const float* W, int K, int N, bf16* WT, int k0, int n0, int drow0, LAS float* scr, int lane) {
#pragma unroll 8
    for (int i = 0; i < 32; ++i) { const int kk = 2 * i + (lane >> 5); scr[kk * 33 + (lane & 31)] = W[(size_t)(k0 + kk) * N + n0 + (lane & 31)]; }
    LDS_WAIT(); asm volatile("" ::: "memory");
    const int c = lane & 7;
#pragma unroll
    for (int j = 0; j < 4; ++j) { const int n = (lane >> 3) + 8 * j; const LAS float* s = scr + (8 * c) * 33 + n;
        v4u o; o.x = pk2(s[0 * 33], s[1 * 33]); o.y = pk2(s[2 * 33], s[3 * 33]); o.z = pk2(s[4 * 33], s[5 * 33]); o.w = pk2(s[6 * 33], s[7 * 33]);
        *(GAS v4u*)(WT + (size_t)(drow0 + n) * K + k0 + 8 * c) = o; }
    LDS_WAIT(); asm volatile("" ::: "memory");
}
__device__ __forceinline__ void p0a_phase(ARGS_T& A, Frame& F) {
    LAS float* sl = (LAS float*)(F.lds);
    LAS float* red = (LAS float*)(F.lds + 32768);
    for (int i = F.tid; i < 3 * DM; i += NWAVES * 64) { const int ci = i / DM, k = i % DM; const float c = ci == 0 ? A.in[I_CCTX][k] : A.in[I_C][(ci - 1) * DM + k]; sl[i] = silu(c); }
    __syncthreads();
    for (int grp = F.bx; grp < 256; grp += F.G) {
        const int l = grp >> 7, n0 = (grp & 127) * 96;
        const int cg = F.tid % 24, kg = F.tid / 24;
        float a[3][4];
#pragma unroll
        for (int ci = 0; ci < 3; ++ci)
#pragma unroll
            for (int j = 0; j < 4; ++j) a[ci][j] = 0.f;
        if (kg < 21) {
            const float* wp = A.in[I_WADA] + (size_t)l * DM * 12288 + n0 + 4 * cg;
#pragma unroll 4
            for (int k = kg; k < DM; k += 21) { const f32x4 w = *(const f32x4*)(wp + (size_t)k * 12288); const float s0 = sl[k], s1 = sl[DM + k], s2 = sl[2 * DM + k];
#pragma unroll
                for (int j = 0; j < 4; ++j) { a[0][j] += s0 * w[j]; a[1][j] += s1 * w[j]; a[2][j] += s2 * w[j]; } }
#pragma unroll
            for (int ci = 0; ci < 3; ++ci)
#pragma unroll
                for (int j = 0; j < 4; ++j) red[(kg * 24 + cg) * 12 + ci * 4 + j] = a[ci][j];
        }
        __syncthreads();
        if (F.tid < 288) { const int c2 = F.tid / 12, j = F.tid % 12, ci = j >> 2, cc = j & 3; float s = 0.f;
            for (int q = 0; q < 21; ++q) s += red[(q * 24 + c2) * 12 + j];
            const int n = n0 + 4 * c2 + cc;
            WSP(float, WS_MOD)[((size_t)l * 3 + ci) * 12288 + n] = s + A.in[I_BADA][(size_t)l * 12288 + n]; }
        __syncthreads();
    }
    LAS float* scr = (LAS float*)(F.lds + RING_OFF + F.wave * 16384);
    const int gw = F.vcu * NWAVES + F.wave, NGW = F.G * NWAVES;
    constexpr int I_IN = (DM / 64) * (IN_W / 32), I_O = (DM / 64) * (DM / 32), I_GU = (DM / 64) * (2 * DFF / 32), I_D = (DFF / 64) * (DM / 32), I_LAYER = I_IN + I_O + I_GU + I_D;
    for (int it = gw; it < DEPTH * I_LAYER; it += NGW) {
        const int l = it / I_LAYER; int r = it % I_LAYER;
        if (r < I_IN) { const int nblk = IN_W / 32, kb = r / nblk, nb = r % nblk;
            p0_transpose_item(A.in[I_WIN] + (size_t)l * DM * IN_W, DM, IN_W, WSP(bf16, WS_WIN) + (size_t)l * IN_WP * DM, 64 * kb, 32 * nb, 32 * nb, scr, F.lane); continue; } r -= I_IN;
        if (r < I_O) { const int nblk = DM / 32, kb = r / nblk, nb = r % nblk;
            p0_transpose_item(A.in[I_WO] + (size_t)l * DM * DM, DM, DM, WSP(bf16, WS_WO) + (size_t)l * DM * DM, 64 * kb, 32 * nb, 32 * nb, scr, F.lane); continue; } r -= I_O;
        if (r < I_GU) { const int nblk = 2 * DFF / 32, kb = r / nblk, nb = r % nblk, n0 = 32 * nb, s = n0 / DFF, j = n0 % DFF, p = j / 128, rr = j % 128;
            p0_transpose_item(A.in[I_WGU] + (size_t)l * DM * 2 * DFF, DM, 2 * DFF, WSP(bf16, WS_WGU) + (size_t)l * 2 * DFF * DM, 64 * kb, n0, 256 * p + 128 * s + rr, scr, F.lane); continue; } r -= I_GU;
        { const int nblk = DM / 32, kb = r / nblk, nb = r % nblk;
            p0_transpose_item(A.in[I_WD] + (size_t)l * DFF * DM, DFF, DM, WSP(bf16, WS_WD) + (size_t)l * DM * DFF, 64 * kb, 32 * nb, 32 * nb, scr, F.lane); }
    }
    { const int gt = F.vcu * NWAVES * 64 + F.tid, NGT = F.G * NWAVES * 64; constexpr int PADV = (IN_WP - IN_W) * DM * 2 / 16;
        for (int i = gt; i < DEPTH * PADV; i += NGT) { const int l = i / PADV, r = i % PADV; ((GAS v4u*)(WSP(bf16, WS_WIN) + (size_t)l * IN_WP * DM + (size_t)IN_W * DM))[r] = (v4u){0u, 0u, 0u, 0u}; } }
}

__device__ __forceinline__ int cond_of_row(int row) { return row < M_CTX ? 0 : 1 + ((row - M_CTX) >> 10); }
__device__ __forceinline__ void p0b_phase(ARGS_T& A, Frame& F) {
    const int gw = F.vcu * NWAVES + F.wave, NGW = F.G * NWAVES;
    for (int row = gw; row < M; row += NGW) {
        const float* xr = row < M_CTX ? A.in[I_XP] + (size_t)row * DM : A.in[I_XS] + (size_t)(row - M_CTX) * DM;
        const float* mod = WSP(float, WS_MOD) + (size_t)cond_of_row(row) * 12288;
        GAS v2u* o8 = (GAS v2u*)(WSP(bf16, WS_H) + (size_t)row * DM) + F.lane;
#pragma unroll
        for (int j = 0; j < 8; ++j) { const int c = 4 * F.lane + 256 * j; const f32x4 x = *(const f32x4*)(xr + c), sh = *(const f32x4*)(mod + c), sc = *(const f32x4*)(mod + DM + c);
            const f32x4 h = x * (sc + 1.0f) + sh; o8[64 * j] = (v2u){pk2(h[0], h[1]), pk2(h[2], h[3])}; }
    }
}
__device__ __forceinline__ void ln_phase(ARGS_T& A, Frame& F, const float* lg, const float* lb, const float* modsh, const float* modsc, bool write_h) {
    const int gw = F.vcu * NWAVES + F.wave, NGW = F.G * NWAVES;
    float* X = F.out;
    for (int row = gw; row < M; row += NGW) {
        float* xr = X + (size_t)row * DM;
        f32x4 v[8]; float s = 0.f;
#pragma unroll
        for (int j = 0; j < 8; ++j) { v[j] = *(const f32x4*)(xr + 4 * F.lane + 256 * j); s += (v[j][0] + v[j][1]) + (v[j][2] + v[j][3]); }
        const float mean = wave_sum(s) * (1.f / DM); float s2 = 0.f;
#pragma unroll
        for (int j = 0; j < 8; ++j) { v[j] = v[j] - mean; s2 += (v[j][0] * v[j][0] + v[j][1] * v[j][1]) + (v[j][2] * v[j][2] + v[j][3] * v[j][3]); }
        const float rstd = 1.f / sqrtf(wave_sum(s2) * (1.f / DM) + LN_EPS);
        const int ci = cond_of_row(row);
        GAS v2u* o8 = (GAS v2u*)(WSP(bf16, WS_H) + (size_t)row * DM) + F.lane;
#pragma unroll
        for (int j = 0; j < 8; ++j) { const int c = 4 * F.lane + 256 * j; const f32x4 g = *(const f32x4*)(lg + c), b = *(const f32x4*)(lb + c);
            const f32x4 y = v[j] * rstd * g + b; *(f32x4*)(xr + c) = y;
            if (write_h) { const f32x4 sh = *(const f32x4*)(modsh + (size_t)ci * 12288 + c), sc = *(const f32x4*)(modsc + (size_t)ci * 12288 + c);
                const f32x4 h = y * (sc + 1.0f) + sh; o8[64 * j] = (v2u){pk2(h[0], h[1]), pk2(h[2], h[3])}; } }
    }
}

__device__ __forceinline__ void prep_phase(ARGS_T& A, Frame& F, int l) {
    LAS float* cw = (LAS float*)(F.lds);
    { const float* cwg = A.in[I_CONVW] + (size_t)l * CONVK * QKV_W;
      for (int i = F.tid; i < CONVK * QKV_W / 4; i += NWAVES * 64) ((LAS f32x4*)cw)[i] = ((const f32x4*)cwg)[i]; }
    __syncthreads();
    const int gw = F.vcu * NWAVES + F.wave, NGW = F.G * NWAVES, lane = F.lane;
    const bf16* PROJ = WSP(bf16, WS_PROJ);
    for (int item = gw; item < M + NB_LAT * PAST; item += NGW) {
        if (item >= M) {
            const int r = item - M, b = r / PAST, j = r % PAST; const size_t src = ((size_t)(b * DEPTH + l) * PAST + j) * 256 + 4 * lane; const size_t krow = (size_t)M_CTX + (size_t)b * (LSEQ + PAST) + LSEQ + j;
            const f32x4 kv = *(const f32x4*)(A.in[I_CK] + src), vv = *(const f32x4*)(A.in[I_CV] + src);
            *(GAS v2u*)(WSP(bf16, WS_KA) + krow * 256 + 4 * lane) = (v2u){pk2(kv[0], kv[1]), pk2(kv[2], kv[3])};
            *(GAS v2u*)(WSP(bf16, WS_VA) + krow * 256 + 4 * lane) = (v2u){pk2(vv[0], vv[1]), pk2(vv[2], vv[3])};
            continue; }
        const int row = item; const bool lat = row >= M_CTX;
        int seq0, t, T, bidx;
        if (!lat) { seq0 = row & ~(SEQ - 1); t = row & (SEQ - 1); T = SEQ; bidx = row >> 8; } else { const int r = row - M_CTX; seq0 = M_CTX + (r & ~(LSEQ - 1)); t = r & (LSEQ - 1); T = LSEQ; bidx = r >> 10; }
        const bf16* prow = PROJ + (size_t)row * IN_WP;
        float a0[24], a1[24];
#pragma unroll
        for (int i = 0; i < 24; ++i) { a0[i] = 0.f; a1[i] = 0.f; }
#pragma unroll
        for (int j = 0; j < CONVK; ++j) { const int tt = t + j - 2;
            if (tt >= 0 && tt < T) { const bf16* pr = PROJ + (size_t)(seq0 + tt) * IN_WP + 2 * lane;
#pragma unroll
                for (int i = 0; i < 24; ++i) { const unsigned w = *(const unsigned*)(pr + 128 * i); const f32x2 cv = *(const LAS f32x2*)(cw + j * QKV_W + 128 * i + 2 * lane);
                    a0[i] += cv[0] * bf_lo(w); a1[i] += cv[1] * bf_hi(w); } } }
#pragma unroll
        for (int i = 0; i < 24; ++i) { float y0 = silu(a0[i]), y1 = silu(a1[i]);
            if (i < 16) { const float ss = wave_sum(y0 * y0 + y1 * y1); float sc = 1.f / sqrtf(ss + RMS_EPS); if (i < 8) sc *= 0.08838834764831845f; y0 *= sc; y1 *= sc; }
            bf16* dst = (i < 8 ? WSP(bf16, WS_QG) : i < 16 ? WSP(bf16, WS_KG) : WSP(bf16, WS_VG)) + (size_t)row * GDN_W + 128 * (i & 7) + 2 * lane;
            *(GAS unsigned*)dst = pk2(y0, y1); }
        if (lane < 16) { const float bv = bf1(prow[C_B + lane]), av = bf1(prow[C_A + lane]) + A.in[I_DTB][l * 16 + lane];
            const float sp = fmaxf(av, 0.f) + log1pf(expf(-fabsf(av)));
            WSP(float, WS_GG)[(size_t)row * 16 + lane] = -expf(A.in[I_ALOG][l * 16 + lane]) * sp;
            WSP(float, WS_BB)[(size_t)row * 16 + lane] = 1.f / (1.f + expf(-bv)); }
        float rc0 = 1.f, rs0 = 0.f, rc1 = 1.f, rs1 = 0.f;
        if (lat) { const float pos = (float)(lane < 32 ? (t >> 6) : (t & 63)); const int i0 = 2 * (lane & 15);
            const float f0 = powf(10000.f, -(float)(2 * i0) / 64.f), f1 = powf(10000.f, -(float)(2 * i0 + 2) / 64.f);
            sincosf(pos * f0, &rs0, &rc0); sincosf(pos * f1, &rs1, &rc1); }
        const float sgn = (lane & 16) ? 1.f : -1.f;
        const f32x2 qw = *(const f32x2*)(A.in[I_QNW] + l * HD + 2 * lane), kw = *(const f32x2*)(A.in[I_KNW] + l * HD + 2 * lane);
#pragma unroll
        for (int h = 0; h < NQ + NKV; ++h) { const bool isq = h < NQ; const int col = isq ? C_AQ + 128 * h : C_AK + 128 * (h - NQ);
            const unsigned w = *(const unsigned*)(prow + col + 2 * lane); float x0 = bf_lo(w), x1 = bf_hi(w);
            const float ms = wave_sum(x0 * x0 + x1 * x1) * (1.f / HD); const float r = 1.f / sqrtf(ms + RMS_EPS);
            x0 = x0 * r * (isq ? qw[0] : kw[0]); x1 = x1 * r * (isq ? qw[1] : kw[1]);
            if (!isq && !lat) { *(f32x2*)(F.out + OUT_CK + ((size_t)(bidx * DEPTH + l) * SEQ + t) * 256 + 128 * (h - NQ) + 2 * lane) = (f32x2){x0, x1}; }
            if (lat) { const float o0 = __shfl_xor(x0, 16), o1 = __shfl_xor(x1, 16); x0 = x0 * rc0 + sgn * o0 * rs0; x1 = x1 * rc1 + sgn * o1 * rs1; }
            if (isq) *(GAS unsigned*)(WSP(bf16, WS_QA) + (size_t)row * ATT_W + 128 * h + 2 * lane) = pk2(x0, x1);
            else { const size_t krow = lat ? (size_t)M_CTX + (size_t)bidx * (LSEQ + PAST) + t : (size_t)row;
                   *(GAS unsigned*)(WSP(bf16, WS_KA) + krow * 256 + 128 * (h - NQ) + 2 * lane) = pk2(x0, x1); } }
#pragma unroll
        for (int h = 0; h < NKV; ++h) { const unsigned w = *(const unsigned*)(prow + C_AV + 128 * h + 2 * lane);
            const size_t krow = lat ? (size_t)M_CTX + (size_t)bidx * (LSEQ + PAST) + t : (size_t)row;
            *(GAS unsigned*)(WSP(bf16, WS_VA) + krow * 256 + 128 * h + 2 * lane) = w;
            if (!lat) *(f32x2*)(F.out + OUT_CV + ((size_t)(bidx * DEPTH + l) * SEQ + t) * 256 + 128 * h + 2 * lane) = (f32x2){bf_lo(w), bf_hi(w)}; }
    }
}

constexpr int GDN_ITEMS_CTX = NB_CTX * HG * 2 / 4, GDN_ITEMS = GDN_ITEMS_CTX + NB_LAT * HG * 2 / 4;
__device__ __forceinline__ void gdn_rec_item(ARGS_T& A, Frame& F, int l, int it) {
    const bool lat = it >= GDN_ITEMS_CTX; const int cbase = lat ? (it - GDN_ITEMS_CTX) * 4 : it * 4;
    const int slot = F.tid >> 7, e = F.tid & 127, c = cbase + slot, b = c >> 4, h = (c >> 1) & 7, dir = c & 1;
    const int T = lat ? LSEQ : SEQ, row0 = lat ? M_CTX + b * LSEQ : b * SEQ;
    float S[128];
    if (lat) { const float* s0 = A.in[I_ST] + ((((size_t)b * DEPTH + l) * 2 + dir) * HG + h) * (size_t)(DKV * DKV) + e;
#pragma unroll
        for (int d = 0; d < 128; ++d) S[d] = s0[(size_t)d * DKV]; }
    else {
#pragma unroll
        for (int d = 0; d < 128; ++d) S[d] = 0.f; }
    constexpr int NBS = 16, SLOTF = NBS * 384 + 64;
    LAS float* kq = (LAS float*)(F.lds) + slot * SLOTF;
    const bf16 *KG = WSP(bf16, WS_KG), *QG = WSP(bf16, WS_QG), *VG = WSP(bf16, WS_VG);
    float* OD = dir ? WSP(float, WS_OB) : WSP(float, WS_OF);
    for (int i0 = 0; i0 < T; i0 += NBS) {
        __syncthreads();
#pragma unroll 4
        for (int j = 0; j < NBS; ++j) { const int t = dir ? T - 1 - (i0 + j) : i0 + j; const size_t off = (size_t)(row0 + t) * GDN_W + h * 128 + e;
            kq[j * 384 + e] = bf1(KG[off]); kq[j * 384 + 128 + e] = bf1(QG[off]); kq[j * 384 + 256 + e] = bf1(VG[off]); }
        if (e < NBS) { const int t = dir ? T - 1 - (i0 + e) : i0 + e; const size_t off = (size_t)(row0 + t) * 16 + dir * 8 + h;
            kq[NBS * 384 + e] = WSP(float, WS_GG)[off]; kq[NBS * 384 + 16 + e] = WSP(float, WS_BB)[off]; }
        __syncthreads();
        for (int j = 0; j < NBS; ++j) {
            const LAS float* kp = kq + j * 384; const float decay = __expf(kq[NBS * 384 + j]), beta = kq[NBS * 384 + 16 + j], v = kp[256 + e];
            float kv0 = 0.f, kv1 = 0.f;
#pragma unroll
            for (int dc = 0; dc < 128; dc += 16) {
#pragma unroll
                for (int d = dc; d < dc + 16; d += 4) { const f32x4 k4 = *(const LAS f32x4*)(kp + d); kv0 += k4[0] * S[d] + k4[2] * S[d + 2]; kv1 += k4[1] * S[d + 1] + k4[3] * S[d + 3]; }
                __builtin_amdgcn_sched_barrier(0); }
            const float delta = beta * (v - decay * (kv0 + kv1));
            float o0 = 0.f, o1 = 0.f;
#pragma unroll
            for (int dc = 0; dc < 128; dc += 8) {
#pragma unroll
                for (int d = dc; d < dc + 8; d += 4) { const f32x4 k4 = *(const LAS f32x4*)(kp + d), q4 = *(const LAS f32x4*)(kp + 128 + d);
                    S[d] = decay * S[d] + k4[0] * delta; S[d + 1] = decay * S[d + 1] + k4[1] * delta; S[d + 2] = decay * S[d + 2] + k4[2] * delta; S[d + 3] = decay * S[d + 3] + k4[3] * delta;
                    o0 += q4[0] * S[d] + q4[2] * S[d + 2]; o1 += q4[1] * S[d + 1] + q4[3] * S[d + 3]; }
                __builtin_amdgcn_sched_barrier(0); }
            const int t = dir ? T - 1 - (i0 + j) : i0 + j;
            OD[(size_t)(row0 + t) * GDN_W + h * 128 + e] = o0 + o1;
        }
    }
    if (!lat) { float* so = F.out + OUT_ST + ((((size_t)b * DEPTH + l) * 2 + dir) * HG + h) * (size_t)(DKV * DKV) + e;
#pragma unroll
        for (int d = 0; d < 128; ++d) so[(size_t)d * DKV] = S[d]; }
    __syncthreads();
}
constexpr int ATT_UNITS_LAT = NB_LAT * NQ * (LSEQ / 256), ATT_UNITS = ATT_UNITS_LAT + NB_CTX * NQ;
__device__ __forceinline__ void attn_unit(Frame& F, int u, char* lds) {
    const att::bf16* QA = (const att::bf16*)WSP(bf16, WS_QA); const att::bf16* KA = (const att::bf16*)WSP(bf16, WS_KA); const att::bf16* VA = (const att::bf16*)WSP(bf16, WS_VA);
    att::bf16* MIX = (att::bf16*)WSP(bf16, WS_MIX);
    int qrow0, krow0, h, seq;
    if (u < ATT_UNITS_LAT) { const int b = u / (NQ * 4), r = u % (NQ * 4); h = r >> 2; const int qb = r & 3; qrow0 = M_CTX + b * LSEQ + qb * 256; krow0 = M_CTX + b * (LSEQ + PAST); seq = LSEQ + PAST; }
    else { const int v = u - ATT_UNITS_LAT, b = v >> 3; h = v & 7; qrow0 = b * SEQ; krow0 = b * SEQ; seq = SEQ; }
    const int kvh = h >> 2;
    att::attn_dense_body<att::bf16>(QA + (size_t)qrow0 * ATT_W + h * HD, KA + (size_t)krow0 * 256 + kvh * HD, VA + (size_t)krow0 * 256 + kvh * HD, MIX + (size_t)qrow0 * DM + GDN_W + h * HD, seq, lds);
    __syncthreads();
}
__device__ __forceinline__ void combine_phase(ARGS_T& A, Frame& F, int l) {
    const int gw = F.vcu * NWAVES + F.wave, NGW = F.G * NWAVES, lane = F.lane;
    const f32x2 nw = *(const f32x2*)(A.in[I_GNW] + l * DKV + 2 * lane);
    for (int row = gw; row < M; row += NGW) {
        const float* of = WSP(float, WS_OF) + (size_t)row * GDN_W + 2 * lane; const float* ob = WSP(float, WS_OB) + (size_t)row * GDN_W + 2 * lane;
        const bf16* z = WSP(bf16, WS_PROJ) + (size_t)row * IN_WP + C_Z + 2 * lane; bf16* mx = WSP(bf16, WS_MIX) + (size_t)row * DM + 2 * lane;
#pragma unroll
        for (int h = 0; h < HG; ++h) { const f32x2 a = *(const f32x2*)(of + 128 * h), b = *(const f32x2*)(ob + 128 * h); const float o0 = a[0] + b[0], o1 = a[1] + b[1];
            const float r = 1.f / sqrtf(wave_sum(o0 * o0 + o1 * o1) * (1.f / DKV) + RMS_EPS); const unsigned zw = *(const unsigned*)(z + 128 * h);
            *(GAS unsigned*)(mx + 128 * h) = pk2(o0 * r * nw[0] * silu(bf_lo(zw)), o1 * r * nw[1] * silu(bf_hi(zw))); }
    }
}

constexpr int PH_PER_LAYER = 10, N_PHASES = 2 + DEPTH * PH_PER_LAYER;
extern __shared__ __attribute__((aligned(16))) unsigned char lds[];
__device__ __forceinline__ void frame_init(Frame& F, ARGS_T& A) {
    F.lds = (LAS unsigned char*)lds; F.MISC = (volatile LAS unsigned*)(F.lds + MISC_OFF);
    F.tid = fresh_tid(); F.lane = F.tid & 63; F.wave = __builtin_amdgcn_readfirstlane(F.tid >> 6);
    F.G = gridDim.x; F.bx = fresh_bx(); F.vcu = (F.G % 8 == 0) ? (F.bx % 8) * (F.G / 8) + F.bx / 8 : F.bx;
    F.out = A.out; F.ws = A.ws; F.ctl = (gu32*)(A.ws + WS_CTL);
}
template <int LO, int HI>
__global__ void __launch_bounds__(NWAVES * 64, 2) trunk_fwd(Args args_unused) {
    { const int t0 = fresh_tid(); for (int u = t0; u < (LDS_BYTES - LDSCTL_OFF) / 4; u += NWAVES * 64) ((LAS unsigned*)((LAS unsigned char*)lds + LDSCTL_OFF))[u] = 0u; }
    __syncthreads();
    if (HI - LO > 1) { ARGS_T& A = *fresh_args(); (void)xcd_barrier_post((unsigned*)(A.ws + WS_CTL) + CW_BAR, (volatile LAS unsigned*)((LAS unsigned char*)lds + MISC_OFF) + 8); }
#define IN(k) (LO <= (k) && (k) < HI)
#define SEAM(k) do { if (IN(k) && IN((k) + 1)) { ARGS_T& A_ = *fresh_args(); XcdBarrier bar_; bar_.bar = (unsigned*)(A_.ws + WS_CTL) + CW_BAR; bar_.x = xb_xcc_id(); bar_.st = (volatile LAS unsigned*)((LAS unsigned char*)lds + MISC_OFF) + 8; xcd_barrier(bar_); } } while (0)
#define PHASE_BEGIN ARGS_T& A = *fresh_args(); Frame F; frame_init(F, A);

    if (IN(0)) { PHASE_BEGIN p0a_phase(A, F); } SEAM(0);
    if (IN(1)) { PHASE_BEGIN p0b_phase(A, F); } SEAM(1);
#pragma unroll
    for (int l = 0; l < DEPTH; ++l) {
        const int pb = 2 + l * PH_PER_LAYER;
        constexpr size_t MODL = 3 * 12288;
        if (IN(pb + 0)) { PHASE_BEGIN pg8::Gemm g{WSP(bf16, WS_H), WSP(bf16, WS_WIN) + (size_t)l * IN_WP * DM, M, IN_WP, DM}; pg8::StaticOrder S; S.init(M, IN_WP, F.G, F.bx);
            pg8::EpiBf16 E{WSP(bf16, WS_PROJ), IN_WP};
            pg8::gemm_phase<DM, pg8::EpiBf16, pg8::StaticOrder, true, true>(F.lds + RING_OFF, g, S, E); }
        SEAM(pb + 0);
        if (IN(pb + 1)) { PHASE_BEGIN prep_phase(A, F, l); } SEAM(pb + 1);
        if (IN(pb + 2)) { PHASE_BEGIN for (int it = F.bx; it < GDN_ITEMS; it += F.G) gdn_rec_item(A, F, l, it < 8 ? GDN_ITEMS_CTX + it : it - 8); }
        SEAM(pb + 2);
        if (IN(pb + 3)) { PHASE_BEGIN for (int it = F.bx; it < ATT_UNITS; it += F.G) attn_unit(F, it, (char*)lds + RING_OFF); }
        SEAM(pb + 3);
        if (IN(pb + 4)) { PHASE_BEGIN combine_phase(A, F, l); } SEAM(pb + 4);
        if (IN(pb + 5)) { PHASE_BEGIN pg8::Gemm g{WSP(bf16, WS_MIX), WSP(bf16, WS_WO) + (size_t)l * DM * DM, M, DM, DM}; pg8::StaticOrder S; S.init(M, DM, F.G, F.bx);
            const float* mod = WSP(float, WS_MOD) + (size_t)l * MODL;
            pg8::EpiResid E{l == 0 ? A.in[I_XP] : F.out, l == 0 ? A.in[I_XS] : F.out + (size_t)M_CTX * DM, F.out, mod + 2 * DM, DN_ALPHA};
            pg8::gemm_phase<DM, pg8::EpiResid, pg8::StaticOrder, true, true>(F.lds + RING_OFF, g, S, E); }
        SEAM(pb + 5);
        if (IN(pb + 6)) { PHASE_BEGIN const float* mod = WSP(float, WS_MOD) + (size_t)l * MODL; ln_phase(A, F, A.in[I_LN1G] + l * DM, A.in[I_LN1B] + l * DM, mod + 3 * DM, mod + 4 * DM, true); } SEAM(pb + 6);
        if (IN(pb + 7)) { PHASE_BEGIN pg8::Gemm g{WSP(bf16, WS_H), WSP(bf16, WS_WGU) + (size_t)l * 2 * DFF * DM, M, 2 * DFF, DM}; pg8::StaticOrder S; S.init(M, 2 * DFF, F.G, F.bx);
            pg8::EpiSwiGLU E{WSP(bf16, WS_PROJ), DFF};
            pg8::gemm_phase<DM, pg8::EpiSwiGLU, pg8::StaticOrder, true, true>(F.lds + RING_OFF, g, S, E); }
        SEAM(pb + 7);
        if (IN(pb + 8)) { PHASE_BEGIN pg8::Gemm g{WSP(bf16, WS_PROJ), WSP(bf16, WS_WD) + (size_t)l * DM * DFF, M, DM, DFF}; pg8::StaticOrder S; S.init(M, DM, F.G, F.bx);
            const float* mod = WSP(float, WS_MOD) + (size_t)l * MODL;
            pg8::EpiResid E{F.out, F.out + (size_t)M_CTX * DM, F.out, mod + 5 * DM, DN_ALPHA};
            pg8::gemm_phase<DFF, pg8::EpiResid, pg8::StaticOrder, true, true>(F.lds + RING_OFF, g, S, E); }
        SEAM(pb + 8);
        if (IN(pb + 9)) { PHASE_BEGIN const float* modn = WSP(float, WS_MOD) + (size_t)(l + 1) * MODL; ln_phase(A, F, A.in[I_LN2G] + l * DM, A.in[I_LN2B] + l * DM, modn, modn + DM, l + 1 < DEPTH); }
        if (l + 1 < DEPTH) SEAM(pb + 9);
    }
#undef IN
#undef SEAM
#undef PHASE_BEGIN
}

typedef void (*kfn_t)(Args);
template <int... P> static void fill_fns(kfn_t* f, std::integer_sequence<int, P...>) { ((f[P] = trunk_fwd<P, P + 1>), ...); }
extern "C" void kernel_launch(void* const* d_in, const int* in_sizes, int n_in, void* d_out, int out_size, void* d_ws, size_t ws_size, hipStream_t stream) {
    static int grid = 0; static kfn_t fns[N_PHASES + 1];
    if (grid == 0) {
        if (n_in != N_IN || in_sizes[I_XP] != M_CTX * DM || in_sizes[I_XS] != M_LAT * DM || (size_t)out_size != OUT_TOTAL || ws_size < WS_END) {
            fprintf(stderr, "kernel_launch: shape mismatch n_in %d out %d ws %zu (need %zu)\n", n_in, out_size, ws_size, (size_t)WS_END); grid = -1; return; }
        int dev = 0, cus = 0;
        if (hipGetDevice(&dev) != hipSuccess || hipDeviceGetAttribute(&cus, hipDeviceAttributeMultiprocessorCount, dev) != hipSuccess) { grid = -1; return; }
#if MK_PER_PHASE
        fill_fns(fns, std::make_integer_sequence<int, N_PHASES>{});
        for (int p = 0; p < N_PHASES; ++p)
            if (hipFuncSetAttribute((const void*)fns[p], hipFuncAttributeMaxDynamicSharedMemorySize, LDS_BYTES) != hipSuccess) { fprintf(stderr, "kernel_launch: hipFuncSetAttribute failed (phase %d)\n", p); grid = -1; return; }
#else
        fns[N_PHASES] = trunk_fwd<0, N_PHASES>;
        if (hipFuncSetAttribute((const void*)fns[N_PHASES], hipFuncAttributeMaxDynamicSharedMemorySize, LDS_BYTES) != hipSuccess) { fprintf(stderr, "kernel_launch: hipFuncSetAttribute failed\n"); grid = -1; return; }
#endif
        (void)hipGetLastError();
        grid = cus;
    }
    if (grid < 0) return;
    if (hipMemsetAsync((char*)d_ws + WS_CTL, 0, CTL_ZERO_BYTES, stream) != hipSuccess) { fprintf(stderr, "kernel_launch: hipMemsetAsync failed\n"); return; }
    Args a{};
    for (int i = 0; i < N_IN; ++i) a.in[i] = (const float*)d_in[i];
    a.out = (float*)d_out; a.ws = (unsigned char*)d_ws;
#if MK_PER_PHASE
    for (int p = 0; p < N_PHASES; ++p) {
        hipLaunchKernelGGL(fns[p], dim3(grid), dim3(NWAVES * 64), LDS_BYTES, stream, a);
        const hipError_t le = hipPeekAtLastError(); if (le != hipSuccess) { fprintf(stderr, "kernel_launch: launch %d failed: %s\n", p, hipGetErrorName(le)); break; } }
#else
    hipLaunchKernelGGL(fns[N_PHASES], dim3(grid), dim3(NWAVES * 64), LDS_BYTES, stream, a);
    { const hipError_t le = hipPeekAtLastError(); if (le != hipSuccess) fprintf(stderr, "kernel_launch: launch failed: %s\n", hipGetErrorName(le)); }
#endif
}
```

```cpp
#include <hip/hip_runtime.h>
#include <hip/hip_bf16.h>
#include <cstdio>
#include <cstdint>
#include <cmath>
#include <utility>
namespace pg8 {
#define PG8_LAS __attribute__((address_space(3)))
typedef unsigned short bf16_t;
typedef short bf16x8 __attribute__((ext_vector_type(8)));
typedef float f32x4 __attribute__((ext_vector_type(4)));
typedef unsigned u32x4 __attribute__((ext_vector_type(4)));
constexpr int BM = 256, BK = 64, HALF = 128, HTB = HALF * BK * 2  , STAGE_BYTES = 8 * HTB, NXCD = 8, WGM = 8;

__host__ __device__ __forceinline__ int lds_byte(int r, int c) { const int st = (r >> 4) * 2 + (c >> 5), rr = r & 15, cc = c & 31, ob = rr * 64 + cc * 2; return st * 1024 + (ob ^ (((ob >> 9) & 1) << 5)); }
__host__ __device__ __forceinline__ void stage_rc(int b, int& R, int& C) { const int st = b / 1024, sb = b % 1024, swz = sb ^ (((sb >> 9) & 1) << 5); R = (st >> 1) * 16 + swz / 64; C = (st & 1) * 32 + (swz % 64) / 2; }
__host__ __device__ __forceinline__ int perm32(int rho) { const int n = rho >> 4, i = rho & 15; return 8 * (i >> 2) + 4 * n + (i & 3); }

struct Unit { int pm, pn; };
struct Gemm { const bf16_t* A; const bf16_t* Bt; int M, N, K; };

struct StaticOrder {
    int nM, nN, nwg, G, c;
    __host__ __device__ void init(int M, int N, int G_, int c_) { nM = M / BM; nN = N / BM; nwg = nM * nN; G = G_; c = c_; }
    __host__ __device__ bool next(int i, Unit& u) const {
        const long L = (long)i * G + c; if (L >= nwg) return false;
        int wgid = (int)L; { const int q = nwg / NXCD, r = nwg % NXCD, xcd = wgid % NXCD, off = wgid / NXCD; wgid = (xcd < r ? xcd * (q + 1) : r * (q + 1) + (xcd - r) * q) + off; }
        const int nig = WGM * nN, gid = wgid / nig, fm = gid * WGM, gsz = (nM - fm) < WGM ? (nM - fm) : WGM;
        u.pm = fm + ((wgid % nig) % gsz); u.pn = (wgid % nig) / gsz; return true;
    }
    __device__ __forceinline__ void a_ready(const Unit&) const {}
    __device__ __forceinline__ void done(const Unit&) const {}
};


__device__ __forceinline__ unsigned cvt_pk_bf16(float lo, float hi) { unsigned r; asm volatile("v_cvt_pk_bf16_f32 %0, %1, %2" : "=v"(r) : "v"(lo), "v"(hi)); return r; }
__device__ __forceinline__ float silu_f(float x) { return x * __builtin_amdgcn_rcpf(1.0f + __builtin_amdgcn_exp2f(-1.4426950408889634f * x)); }

struct EpiBf16 {
    static constexpr bool PERM = true, AFTER_DRAIN = false;
    bf16_t* O; int ldc;
    __device__ __forceinline__ void operator()(const f32x4 (&acc)[2][2][4][2], const Unit& u, int wr, int wc, int fr, int fq) const {
        const int row0 = u.pm * BM + wr * 64 + fr; const int col0 = u.pn * BM + wc * 32 + 8 * fq;
#pragma unroll
        for (int ai = 0; ai < 2; ++ai)
#pragma unroll
            for (int m = 0; m < 4; ++m) { bf16_t* rowp = O + (size_t)(row0 + ai * HALF + m * 16) * ldc + col0;
#pragma unroll
                for (int bj = 0; bj < 2; ++bj) { const f32x4 v0 = acc[ai][bj][m][0], v1 = acc[ai][bj][m][1];
                    u32x4 w; w.x = cvt_pk_bf16(v0[0], v0[1]); w.y = cvt_pk_bf16(v0[2], v0[3]); w.z = cvt_pk_bf16(v1[0], v1[1]); w.w = cvt_pk_bf16(v1[2], v1[3]);
                    *(u32x4*)(rowp + bj * HALF) = w; } }
    }
};
struct EpiSwiGLU {
    static constexpr bool PERM = true, AFTER_DRAIN = false;
    bf16_t* O; int ldc;
    __device__ __forceinline__ void operator()(const f32x4 (&acc)[2][2][4][2], const Unit& u, int wr, int wc, int fr, int fq) const {
        const int row0 = u.pm * BM + wr * 64 + fr; const int col0 = u.pn * HALF + wc * 32 + 8 * fq;
#pragma unroll
        for (int ai = 0; ai < 2; ++ai)
#pragma unroll
            for (int m = 0; m < 4; ++m) { bf16_t* rowp = O + (size_t)(row0 + ai * HALF + m * 16) * ldc + col0;
                const f32x4 g0 = acc[ai][0][m][0], g1 = acc[ai][0][m][1], u0 = acc[ai][1][m][0], u1 = acc[ai][1][m][1];
                u32x4 w;
                w.x = cvt_pk_bf16(silu_f(g0[0]) * u0[0], silu_f(g0[1]) * u0[1]); w.y = cvt_pk_bf16(silu_f(g0[2]) * u0[2], silu_f(g0[3]) * u0[3]);
                w.z = cvt_pk_bf16(silu_f(g1[0]) * u1[0], silu_f(g1[1]) * u1[1]); w.w = cvt_pk_bf16(silu_f(g1[2]) * u1[2], silu_f(g1[3]) * u1[3]);
                *(u32x4*)rowp = w; }
    }
};
struct EpiResid {
    static constexpr bool PERM = false, AFTER_DRAIN = false;
    const float* xp; const float* xs; float* X; const float* gate; float alpha;
    __device__ __forceinline__ void operator()(const f32x4 (&acc)[2][2][4][2], const Unit& u, int wr, int wc, int fr, int fq) const {
        const int col0 = u.pn * BM + wc * 32 + 4 * fq; const int ci = u.pm < 32 ? 0 : 1 + ((u.pm - 32) >> 2);
        f32x4 gv[2][2];
#pragma unroll
        for (int bj = 0; bj < 2; ++bj)
#pragma unroll
            for (int n = 0; n < 2; ++n) gv[bj][n] = *(const f32x4*)(gate + (size_t)ci * 12288 + col0 + bj * HALF + n * 16);
#pragma unroll
        for (int ai = 0; ai < 2; ++ai)
#pragma unroll
            for (int m = 0; m < 4; ++m) { const int row = u.pm * BM + ai * HALF + wr * 64 + m * 16 + fr;
                const float* src = (row < 8192 ? xp + (size_t)row * 2048 : xs + (size_t)(row - 8192) * 2048) + col0; float* dst = X + (size_t)row * 2048 + col0;
#pragma unroll
                for (int bj = 0; bj < 2; ++bj)
#pragma unroll
                    for (int n = 0; n < 2; ++n) { const f32x4 xin = *(const f32x4*)(src + bj * HALF + n * 16);
                        *(f32x4*)(dst + bj * HALF + n * 16) = xin * alpha + gv[bj][n] * acc[ai][bj][m][n]; } }
    }
};

template <int KK, class Epi, class Sched, bool ALIGN_EPI = false, bool SP2 = false>
__device__ __forceinline__ void gemm_phase(PG8_LAS unsigned char* lds, const Gemm g, const Sched& S, const Epi& E) {
    int tid_ = threadIdx.x; asm volatile("" : "+v"(tid_)); const int tid = tid_, wid = __builtin_amdgcn_readfirstlane(tid >> 6), lane = tid & 63, wr = wid >> 2, wc = wid & 3, fr = lane & 15, fq = lane >> 4;
    constexpr int K = KK, nt = K / BK;
    unsigned voffA[2], voffB[2];
#pragma unroll
    for (int i = 0; i < 2; ++i) { int R, C; stage_rc(tid * 16 + i * 8192, R, C); const int Rb = Epi::PERM ? ((R & ~31) + perm32(R & 31)) : R;
        voffA[i] = (unsigned)(R * K + C) * 2u; voffB[i] = (unsigned)(Rb * K + C) * 2u; }
    const size_t kstep = (size_t)(BK * 2);
    const size_t hstep = (size_t)HALF * K * 2;
    const size_t tstep = 2 * hstep;
    const unsigned ldsw = (unsigned)wid * 1024u;
    const int aoff = lds_byte(wr * 64 + fr, fq * 8), boff = lds_byte(wc * 32 + fr, fq * 8);
#define PG8_SA(b, h) (((b) * 2 + (h)) * HTB)
#define PG8_SB(b, h) ((4 + (b) * 2 + (h)) * HTB)
#define PG8_STAGE(bufoff, gbase, voff) do { _Pragma("unroll") for (int _i = 0; _i < 2; ++_i) \
        __builtin_amdgcn_global_load_lds((const unsigned*)((const char*)(gbase) + (voff)[_i]), (PG8_LAS unsigned*)(lds + (bufoff) + ldsw + _i * 8192), 16, 0, 0); } while (0)
#define PG8_LDA(dst, b, h) do { _Pragma("unroll") for (int m = 0; m < 4; ++m) _Pragma("unroll") for (int k = 0; k < 2; ++k) dst[m][k] = *(const PG8_LAS bf16x8*)(lds + PG8_SA(b, h) + aoff + m * 2048 + k * 1024); } while (0)
#define PG8_LDB(dst, b, h) do { _Pragma("unroll") for (int n = 0; n < 2; ++n) _Pragma("unroll") for (int k = 0; k < 2; ++k) dst[n][k] = *(const PG8_LAS bf16x8*)(lds + PG8_SB(b, h) + boff + n * 2048 + k * 1024); } while (0)
#define PG8_MMA(ai, bj, At, Bt) do { __builtin_amdgcn_s_setprio(1); _Pragma("unroll") for (int m = 0; m < 4; ++m) _Pragma("unroll") for (int n = 0; n < 2; ++n) _Pragma("unroll") for (int k = 0; k < 2; ++k) \
        acc[ai][bj][m][n] = __builtin_amdgcn_mfma_f32_16x16x32_bf16(Bt[n][k], At[m][k], acc[ai][bj][m][n], 0, 0, 0); __builtin_amdgcn_s_setprio(0); } while (0)
#define PG8_WAIT_V(n) asm volatile("s_waitcnt vmcnt(" #n ")" ::: "memory")
#define PG8_WAIT_L(n) asm volatile("s_waitcnt lgkmcnt(" #n ")" ::: "memory")
#define PG8_BAR __builtin_amdgcn_s_barrier()
#define PG8_SCHED __builtin_amdgcn_sched_barrier(0)
    Unit cur, nxt; int ui = 0;
    if (!S.next(0, cur)) return;
    f32x4 acc[2][2][4][2];
#pragma unroll
    for (int a = 0; a < 2; ++a)
#pragma unroll
        for (int b = 0; b < 2; ++b)
#pragma unroll
            for (int m = 0; m < 4; ++m)
#pragma unroll
                for (int n = 0; n < 2; ++n) acc[a][b][m][n] = (f32x4){0.f, 0.f, 0.f, 0.f};
    bf16x8 At[4][2], B0[2][2], B1[2][2];
    const char* cA = (const char*)g.A + (size_t)cur.pm * tstep; const char* cB = (const char*)g.Bt + (size_t)cur.pn * tstep;
    S.a_ready(cur);
    if constexpr (SP2) {
        PG8_STAGE(PG8_SB(0, 0), cB, voffB); PG8_STAGE(PG8_SB(0, 1), cB + hstep, voffB); PG8_STAGE(PG8_SA(0, 0), cA, voffA); PG8_STAGE(PG8_SA(0, 1), cA + hstep, voffA);
        if (wr == 1) PG8_BAR;
        PG8_WAIT_V(2); PG8_BAR;
        PG8_STAGE(PG8_SB(1, 0), cB + kstep, voffB); PG8_STAGE(PG8_SA(1, 0), cA + kstep, voffA); PG8_STAGE(PG8_SB(1, 1), cB + hstep + kstep, voffB);
        PG8_WAIT_V(6); PG8_BAR;
    } else {
        PG8_STAGE(PG8_SB(0, 0), cB, voffB); PG8_STAGE(PG8_SA(0, 0), cA, voffA); PG8_STAGE(PG8_SB(0, 1), cB + hstep, voffB); PG8_STAGE(PG8_SA(0, 1), cA + hstep, voffA);
        if (wr == 1) PG8_BAR;
        PG8_WAIT_V(4); PG8_BAR;
        PG8_STAGE(PG8_SB(1, 0), cB + kstep, voffB); PG8_STAGE(PG8_SA(1, 0), cA + kstep, voffA); PG8_STAGE(PG8_SB(1, 1), cB + hstep + kstep, voffB);
        PG8_WAIT_V(6); PG8_BAR;
    }
    for (;;) {
        const bool has_next = S.next(ui + 1, nxt);
        const char* nA = has_next ? (const char*)g.A + (size_t)nxt.pm * tstep : cA; const char* nB = has_next ? (const char*)g.Bt + (size_t)nxt.pn * tstep : cB;
        for (int t = 0; t < nt; t += 2) {
            const bool last = (t == nt - 2);
            const char* a1 = cA + (size_t)(t + 1) * kstep;
            const char* a2 = last ? nA : cA + (size_t)(t + 2) * kstep; const char* b2 = last ? nB : cB + (size_t)(t + 2) * kstep;
            const char* a3 = a2 + kstep; const char* b3 = b2 + kstep;
            if (last && has_next) S.a_ready(nxt);
            if constexpr (SP2) {
            PG8_LDB(B0, 0, 0); PG8_LDB(B1, 0, 1); PG8_SCHED; PG8_LDA(At, 0, 0); PG8_STAGE(PG8_SA(1, 1), a1 + hstep, voffA);
            PG8_WAIT_V(8); PG8_WAIT_L(0); PG8_BAR; PG8_MMA(0, 0, At, B0); PG8_MMA(0, 1, At, B1); PG8_BAR; PG8_SCHED;
            PG8_LDA(At, 0, 1); PG8_STAGE(PG8_SB(0, 0), b2, voffB); PG8_STAGE(PG8_SB(0, 1), b2 + hstep, voffB); PG8_STAGE(PG8_SA(0, 0), a2, voffA);
            PG8_WAIT_V(8); PG8_WAIT_L(0); PG8_BAR; PG8_MMA(1, 0, At, B0); PG8_MMA(1, 1, At, B1); PG8_BAR; PG8_SCHED;
            PG8_LDB(B0, 1, 0); PG8_LDB(B1, 1, 1); PG8_SCHED; PG8_LDA(At, 1, 0); PG8_STAGE(PG8_SA(0, 1), a2 + hstep, voffA);
            PG8_WAIT_V(8); PG8_WAIT_L(0); PG8_BAR; PG8_MMA(0, 0, At, B0); PG8_MMA(0, 1, At, B1); PG8_BAR; PG8_SCHED;
            PG8_LDA(At, 1, 1); PG8_STAGE(PG8_SB(1, 0), b3, voffB); PG8_STAGE(PG8_SB(1, 1), b3 + hstep, voffB); PG8_STAGE(PG8_SA(1, 0), a3, voffA);
            PG8_WAIT_V(8); PG8_WAIT_L(0); PG8_BAR; PG8_MMA(1, 0, At, B0); PG8_MMA(1, 1, At, B1); PG8_BAR; PG8_SCHED;
            } else {
            PG8_LDB(B0, 0, 0); PG8_SCHED; PG8_LDA(At, 0, 0); PG8_STAGE(PG8_SA(1, 1), a1 + hstep, voffA);
            PG8_WAIT_L(8); PG8_BAR; PG8_WAIT_L(0); PG8_MMA(0, 0, At, B0); PG8_BAR; PG8_SCHED;
            PG8_LDB(B1, 0, 1); PG8_STAGE(PG8_SB(0, 0), b2, voffB);
            PG8_BAR; PG8_WAIT_L(0); PG8_MMA(0, 1, At, B1); PG8_BAR;
            PG8_LDA(At, 0, 1); PG8_STAGE(PG8_SA(0, 0), a2, voffA);
            PG8_BAR; PG8_WAIT_L(0); PG8_MMA(1, 0, At, B0); PG8_BAR; PG8_SCHED;
            PG8_STAGE(PG8_SB(0, 1), b2 + hstep, voffB);
            PG8_WAIT_V(6); PG8_BAR; PG8_MMA(1, 1, At, B1); PG8_BAR;
            PG8_LDB(B0, 1, 0); PG8_SCHED; PG8_LDA(At, 1, 0); PG8_STAGE(PG8_SA(0, 1), a2 + hstep, voffA);
            PG8_WAIT_L(8); PG8_BAR; PG8_WAIT_L(0); PG8_MMA(0, 0, At, B0); PG8_BAR; PG8_SCHED;
            PG8_LDB(B1, 1, 1); PG8_STAGE(PG8_SB(1, 0), b3, voffB);
            PG8_BAR; PG8_WAIT_L(0); PG8_MMA(0, 1, At, B1); PG8_BAR;
            PG8_LDA(At, 1, 1); PG8_STAGE(PG8_SA(1, 0), a3, voffA);
            PG8_BAR; PG8_WAIT_L(0); PG8_MMA(1, 0, At, B0); PG8_BAR; PG8_SCHED;
            PG8_STAGE(PG8_SB(1, 1), b3 + hstep, voffB);
            PG8_WAIT_V(6); PG8_BAR; PG8_MMA(1, 1, At, B1); PG8_BAR;
            }
        }
        if constexpr (ALIGN_EPI) { if (wr == 0) PG8_BAR; }
        if constexpr (!Epi::AFTER_DRAIN) { E(acc, cur, wr, wc, fr, fq); S.done(cur); }
        if (!has_next) break;
#pragma unroll
        for (int a = 0; a < 2; ++a)
#pragma unroll
            for (int b = 0; b < 2; ++b)
#pragma unroll
                for (int m = 0; m < 4; ++m)
#pragma unroll
                    for (int n = 0; n < 2; ++n) acc[a][b][m][n] = (f32x4){0.f, 0.f, 0.f, 0.f};
        cur = nxt; cA = nA; cB = nB; ++ui;
        if constexpr (ALIGN_EPI) { if (wr == 1) PG8_BAR; }
    }
    PG8_WAIT_V(0);
    if constexpr (!ALIGN_EPI) { if (wr == 0) PG8_BAR; }
    PG8_BAR;
    if constexpr (Epi::AFTER_DRAIN) { E.fused(acc, cur, wr, wc, fr, fq, lds, wid, lane); S.done(cur); }
#undef PG8_SA
#undef PG8_SB
#undef PG8_STAGE
#undef PG8_LDA
#undef PG8_LDB
#undef PG8_MMA
#undef PG8_WAIT_V
#undef PG8_WAIT_L
#undef PG8_BAR
#undef PG8_SCHED
}
}

namespace att {
using bf16 = __hip_bfloat16;
constexpr int   D = 128, NW = 8, QBLK = 32, KVBLK = 64;
constexpr float SCALE = 0.088388347648318440f;
constexpr float THR = 8.f;
constexpr int SDEPTH = 2;
constexpr int LDQ = 1024, LDK = 256, LDO = 2048;
using bf16x8 = __attribute__((ext_vector_type(8))) short;
using s16x4  = __attribute__((ext_vector_type(4))) short;
using f32x16 = __attribute__((ext_vector_type(16))) float;
using f32x8  = __attribute__((ext_vector_type(8))) float;
using u32x4  = __attribute__((ext_vector_type(4))) unsigned;
constexpr size_t SHM_V = KVBLK * D * 2, SHM_K = KVBLK * D * 2, SHM_ATTN = 2 * SHM_V + 2 * SHM_K + NW * 64 * 4;
#define KSWZ(row, colB) ((row) * 256 + ((colB) ^ (((row) & 7) << 4)))
#define SBAR() __builtin_amdgcn_sched_barrier(0)
__device__ __forceinline__ int crow(int r, int hi) { return (r & 3) + 8 * (r >> 2) + 4 * hi; }
__device__ __forceinline__ unsigned cvtpk(float lo, float hi) {
  unsigned r; asm volatile("v_cvt_pk_bf16_f32 %0, %1, %2" : "=v"(r) : "v"(lo), "v"(hi)); return r;
}
template <typename TIn> struct Stage;
template <> struct Stage<bf16>  { using T = bf16x8;
  __device__ static __forceinline__ T ld8(const bf16* p) { return *reinterpret_cast<const bf16x8*>(p); }
  __device__ static __forceinline__ bf16x8 tobf(T x) { return x; } };
template <> struct Stage<float> { using T = f32x8;
  __device__ static __forceinline__ T ld8(const float* p) { return *reinterpret_cast<const f32x8*>(p); }
  __device__ static __forceinline__ bf16x8 tobf(T x) {
    u32x4 w = {cvtpk(x[0], x[1]), cvtpk(x[2], x[3]), cvtpk(x[4], x[5]), cvtpk(x[6], x[7])}; return *reinterpret_cast<bf16x8*>(&w); } };

__device__ __forceinline__ void partialSM(f32x16& p0, f32x16& p1, float& m_reg, float& mn, float& alpha) {
  constexpr float C = SCALE * 1.4426950408889634f;
  float pmax = p0[0]; for (int r = 1; r < 16; ++r) pmax = fmaxf(pmax, p0[r]); for (int r = 0; r < 16; ++r) pmax = fmaxf(pmax, p1[r]);
  { auto rr = __builtin_amdgcn_permlane32_swap(__float_as_uint(pmax), __float_as_uint(pmax), false, false);
    pmax = fmaxf(__uint_as_float(rr[0]), __uint_as_float(rr[1])); }
  if (__builtin_expect(__all(pmax - m_reg <= THR / SCALE), 1)) { mn = m_reg; alpha = 1.f; }
  else { mn = fmaxf(m_reg, pmax); alpha = __builtin_amdgcn_exp2f((m_reg - mn) * C); m_reg = mn; }
  float mnC = -mn * C;
  for (int r = 0; r < 16; ++r) p0[r] = fmaf(p0[r], C, mnC); for (int r = 0; r < 16; ++r) p1[r] = fmaf(p1[r], C, mnC);
  for (int r = 0; r < 16; ++r) p0[r] = __builtin_amdgcn_exp2f(p0[r]);
}
__device__ __forceinline__ void finishSM(f32x16& p0, f32x16& p1, float alpha, float& l_reg, bf16x8& pa0, bf16x8& pa1, bf16x8& pa2, bf16x8& pa3) {
  for (int r = 0; r < 16; ++r) p1[r] = __builtin_amdgcn_exp2f(p1[r]);
  float ps = 0; for (int r = 0; r < 16; ++r) ps += p0[r]; for (int r = 0; r < 16; ++r) ps += p1[r];
  { auto rr = __builtin_amdgcn_permlane32_swap(__float_as_uint(ps), __float_as_uint(ps), false, false);
    ps = __uint_as_float(rr[0]) + __uint_as_float(rr[1]); }
  l_reg = l_reg * alpha + ps;
#define PK4(P, BASE, OUT) do { unsigned a0 = cvtpk(P[BASE + 0], P[BASE + 1]), a1 = cvtpk(P[BASE + 2], P[BASE + 3]);   \
    unsigned b0 = cvtpk(P[BASE + 4], P[BASE + 5]), b1 = cvtpk(P[BASE + 6], P[BASE + 7]);                              \
    auto r0 = __builtin_amdgcn_permlane32_swap(a0, b0, false, false); auto r1 = __builtin_amdgcn_permlane32_swap(a1, b1, false, false); \
    u32x4 w = {r0[0], r1[0], r0[1], r1[1]}; OUT = *reinterpret_cast<bf16x8*>(&w); } while (0)
  PK4(p0, 0, pa0); PK4(p0, 8, pa1); PK4(p1, 0, pa2); PK4(p1, 8, pa3);
#undef PK4
}
__device__ __forceinline__ void qkt(f32x16& p0, f32x16& p1, const bf16* Ks, const bf16x8* qr, int r32, int hi) {
  p0 = f32x16{}; p1 = f32x16{};
  for (int d0 = 0; d0 < 8; ++d0) { int cb = (d0 * 16 + hi * 8) * 2;
    bf16x8 b0 = *reinterpret_cast<const bf16x8*>((const char*)Ks + KSWZ(r32, cb));
    bf16x8 b1 = *reinterpret_cast<const bf16x8*>((const char*)Ks + KSWZ(32 + r32, cb));
    p0 = __builtin_amdgcn_mfma_f32_32x32x16_bf16(b0, qr[d0], p0, 0, 0, 0);
    p1 = __builtin_amdgcn_mfma_f32_32x32x16_bf16(b1, qr[d0], p1, 0, 0, 0); }
}
__device__ __forceinline__ int v_st(int k, int c) { const int kk = (k & ~0xC) | ((k & 4) << 1) | ((k & 8) >> 1); return ((kk >> 3) * 4 + (c >> 5)) * 512 + ((kk & 7) * 32 + (c & 31)) * 2; }
__device__ __forceinline__ int v_rd_base(int lane) { return ((lane & 3) << 3) | (((lane >> 2) & 3) << 6) | (((lane >> 4) & 1) << 5) | (((lane >> 5) & 1) << 8); }
constexpr int v_rd_off(int d0, int ks, int half) { return d0 * 512 + ks * 4096 + half * 2048; }
template <int OFF> __device__ __forceinline__ s16x4 tr_read(int vb) {
  s16x4 r; asm volatile("ds_read_b64_tr_b16 %0, %1 offset:%2" : "=&v"(r) : "v"(vb), "i"(OFF) : "memory"); return r;
}
template <int D0> __device__ __forceinline__ void pv_one(f32x16& od, int vb, bf16x8 pa0, bf16x8 pa1, bf16x8 pa2, bf16x8 pa3) {
  const s16x4 l0 = tr_read<v_rd_off(D0, 0, 0)>(vb), h0 = tr_read<v_rd_off(D0, 0, 1)>(vb), l1 = tr_read<v_rd_off(D0, 1, 0)>(vb), h1 = tr_read<v_rd_off(D0, 1, 1)>(vb);
  const s16x4 l2 = tr_read<v_rd_off(D0, 2, 0)>(vb), h2 = tr_read<v_rd_off(D0, 2, 1)>(vb), l3 = tr_read<v_rd_off(D0, 3, 0)>(vb), h3 = tr_read<v_rd_off(D0, 3, 1)>(vb);
  asm volatile("s_waitcnt lgkmcnt(0)" ::: "memory"); SBAR();
#define PK(L, H) (bf16x8){L[0], L[1], L[2], L[3], H[0], H[1], H[2], H[3]}
  od = __builtin_amdgcn_mfma_f32_32x32x16_bf16(pa0, PK(l0, h0), od, 0, 0, 0);
  od = __builtin_amdgcn_mfma_f32_32x32x16_bf16(pa1, PK(l1, h1), od, 0, 0, 0);
  od = __builtin_amdgcn_mfma_f32_32x32x16_bf16(pa2, PK(l2, h2), od, 0, 0, 0);
  od = __builtin_amdgcn_mfma_f32_32x32x16_bf16(pa3, PK(l3, h3), od, 0, 0, 0);
#undef PK
}
__device__ __forceinline__ void pv_d0(f32x16* o, int vb, bf16x8 pa0, bf16x8 pa1, bf16x8 pa2, bf16x8 pa3) {
  pv_one<0>(o[0], vb, pa0, pa1, pa2, pa3); pv_one<1>(o[1], vb, pa0, pa1, pa2, pa3); pv_one<2>(o[2], vb, pa0, pa1, pa2, pa3); pv_one<3>(o[3], vb, pa0, pa1, pa2, pa3);
}

template <typename TQ>
__device__ __forceinline__ void attn_dense_body(const TQ* __restrict__ Qb, const bf16* __restrict__ Kh, const bf16* __restrict__ Vh,
                                                bf16* __restrict__ Ob, int seq, char* lds) {
  using St = Stage<bf16>; using SQ = Stage<TQ>;
  int tid_ = threadIdx.x; asm volatile("" : "+v"(tid_)); const int tid = tid_, wid = tid >> 6, lane = tid & 63, r32 = lane & 31, hi = lane >> 5;
  bf16* V_lds = (bf16*)lds; bf16* K_lds = (bf16*)(lds + 2 * SHM_V);
  float* ws = (float*)(lds + 2 * SHM_V + 2 * SHM_K) + wid * 64; float* li_l = ws; float* al_l = ws + 32;
  float m_reg = -1e30f, l_reg = 0; f32x16 o[4] = {}; bf16x8 qr[8];
  const TQ* Qw = Qb + (long)(wid * QBLK + r32) * LDQ + hi * 8;
#pragma unroll
  for (int d0 = 0; d0 < 8; ++d0) qr[d0] = SQ::tobf(SQ::ld8(Qw + d0 * 16));
  const int sr = tid >> 4, sc = (tid & 15) * 8, vst0 = v_st(sr, sc), vst1 = v_st(32 + sr, sc);
  const int vb0 = (int)(uintptr_t)V_lds + v_rd_base(lane);
  struct { typename St::T vs0, vs1, ks0, ks1; } sr_[SDEPTH];
#define SLOAD(i, k0) do { sr_[i].vs0 = St::ld8(&Vh[(long)((k0) + sr) * LDK + sc]); sr_[i].vs1 = St::ld8(&Vh[(long)((k0) + 32 + sr) * LDK + sc]); \
    sr_[i].ks0 = St::ld8(&Kh[(long)((k0) + sr) * LDK + sc]); sr_[i].ks1 = St::ld8(&Kh[(long)((k0) + 32 + sr) * LDK + sc]); } while (0)
#define SWRITE(b, i) do { *(bf16x8*)((char*)V_lds + (b) * SHM_V + vst0) = St::tobf(sr_[i].vs0);          \
    *(bf16x8*)((char*)V_lds + (b) * SHM_V + vst1) = St::tobf(sr_[i].vs1); int kc = sc * 2;               \
    *(bf16x8*)((char*)K_lds + (b) * SHM_K + KSWZ(sr, kc)) = St::tobf(sr_[i].ks0);                       \
    *(bf16x8*)((char*)K_lds + (b) * SHM_K + KSWZ(32 + sr, kc)) = St::tobf(sr_[i].ks1); } while (0)
#define SWAIT() do { if constexpr (SDEPTH == 2) asm volatile("s_waitcnt vmcnt(4)" ::: "memory"); else asm volatile("s_waitcnt vmcnt(0)" ::: "memory"); } while (0)
#define RESC(a) do { if (__any((a) < 1.f)) { if (hi == 0) al_l[r32] = (a); asm volatile("s_waitcnt lgkmcnt(0)" ::: "memory"); \
    for (int d = 0; d < 4; ++d) for (int r = 0; r < 16; ++r) o[d][r] *= al_l[crow(r, hi)]; } } while (0)
  f32x16 pA0, pA1, pB0, pB1; float mnA, mnB, alA, alB; bf16x8 pa0, pa1, pa2, pa3; const int NT = seq / KVBLK;
  constexpr int SE = 0, SO = SDEPTH - 1;
  SLOAD(SE, 0); asm volatile("s_waitcnt vmcnt(0)" ::: "memory"); SWRITE(0, SE); __syncthreads();
  qkt(pA0, pA1, K_lds, qr, r32, hi); partialSM(pA0, pA1, m_reg, mnA, alA);
  SLOAD(SO, KVBLK); if constexpr (SDEPTH == 2) { if (2 < NT) SLOAD(SE, 2 * KVBLK); }
  SWAIT(); SWRITE(1, SO); __syncthreads();
  for (int j = 1; j + 1 < NT; j += 2) {
    SBAR(); qkt(pB0, pB1, (bf16*)((char*)K_lds + SHM_K), qr, r32, hi);
    finishSM(pA0, pA1, alA, l_reg, pa0, pa1, pa2, pa3); SBAR();
    SLOAD(SO, (j + SDEPTH) * KVBLK); SBAR();
    pv_d0(o, vb0, pa0, pa1, pa2, pa3); partialSM(pB0, pB1, m_reg, mnB, alB);
    __syncthreads(); SWAIT(); SWRITE(0, SE);
    RESC(alB); __syncthreads();
    SBAR(); qkt(pA0, pA1, K_lds, qr, r32, hi);
    finishSM(pB0, pB1, alB, l_reg, pa0, pa1, pa2, pa3); SBAR();
    if (SDEPTH == 1 || j + 3 < NT) SLOAD(SE, (j + 1 + SDEPTH) * KVBLK); SBAR();
    pv_d0(o, vb0 + (int)SHM_V, pa0, pa1, pa2, pa3); partialSM(pA0, pA1, m_reg, mnA, alA);
    __syncthreads(); SWAIT(); SWRITE(1, SO);
    RESC(alA); __syncthreads();
  }
  SBAR(); qkt(pB0, pB1, (bf16*)((char*)K_lds + SHM_K), qr, r32, hi);
  finishSM(pA0, pA1, alA, l_reg, pa0, pa1, pa2, pa3); SBAR();
  pv_d0(o, vb0, pa0, pa1, pa2, pa3); partialSM(pB0, pB1, m_reg, mnB, alB);
  __syncthreads(); RESC(alB);
  finishSM(pB0, pB1, alB, l_reg, pa0, pa1, pa2, pa3); SBAR();
  pv_d0(o, vb0 + (int)SHM_V, pa0, pa1, pa2, pa3);
  if (hi == 0) li_l[r32] = l_reg; asm volatile("s_waitcnt lgkmcnt(0)" ::: "memory");
  float rli[16];
#pragma unroll
  for (int r = 0; r < 16; ++r) rli[r] = __builtin_amdgcn_rcpf(li_l[crow(r, hi)]);
  bf16* Ow = Ob + (long)(wid * QBLK) * LDO;
#pragma unroll
  for (int r = 0; r < 16; ++r) { int orow = crow(r, hi);
    for (int d0 = 0; d0 < 4; ++d0) Ow[(long)orow * LDO + d0 * 32 + r32] = __float2bfloat16(o[d0][r] * rli[r]); }
#undef SLOAD
#undef SWRITE
#undef SWAIT
#undef RESC
}

}

#ifndef MK_PER_PHASE
#define MK_PER_PHASE 0
#endif
#ifndef MK_GDN_REC
#define MK_GDN_REC 0
#endif
constexpr int NWAVES = 8;

constexpr int DM = 2048, NB_CTX = 32, SEQ = 256, DEPTH = 2, NB_LAT = 2, LSEQ = 1024, PAST = 512;
constexpr int M_CTX = NB_CTX * SEQ, M_LAT = NB_LAT * LSEQ, M = M_CTX + M_LAT;
constexpr int HG = 8, DKV = 128, GDN_W = 1024, NQ = 8, NKV = 2, HD = 128, ATT_W = 1024;
constexpr int QKV_W = 3072, IN_W = 5664, IN_WP = 5888, DFF = 5632, CONVK = 5;
constexpr int C_Z = 3072, C_B = 4096, C_A = 4112, C_AQ = 4128, C_AK = 5152, C_AV = 5408;
constexpr int KROWS = M_CTX + NB_LAT * (LSEQ + PAST);
constexpr float RMS_EPS = 1e-6f, LN_EPS = 1e-5f;
constexpr float DN_ALPHA = 1.4142135623730951f;
constexpr size_t OUT_YP = 0, OUT_YS = 16777216, OUT_CK = 20971520, OUT_CV = 25165824, OUT_ST = 29360128, OUT_TOTAL = 46137344;
enum { I_XP = 0, I_XS, I_CK, I_CV, I_ST, I_C, I_CCTX, I_WADA, I_BADA, I_WIN, I_CONVW, I_ALOG, I_DTB, I_GNW, I_QNW, I_KNW, I_WO, I_LN1G, I_LN1B, I_LN2G, I_LN2B, I_WGU, I_WD, N_IN };

constexpr size_t MiB = 1u << 20;
constexpr size_t WS_CTL = 0, CTL_ZERO_BYTES = 1 * MiB;
constexpr size_t WS_MOD = 1 * MiB;
constexpr size_t WS_WIN = 2 * MiB;
constexpr size_t WS_WO  = WS_WIN + (size_t)DEPTH * IN_WP * DM * 2;
constexpr size_t WS_WGU = WS_WO + (size_t)DEPTH * DM * DM * 2;
constexpr size_t WS_WD  = WS_WGU + (size_t)DEPTH * 2 * DFF * DM * 2;
constexpr size_t WS_H   = WS_WD + (size_t)DEPTH * DM * DFF * 2;
constexpr size_t WS_MIX = WS_H + (size_t)M * DM * 2;
constexpr size_t WS_PROJ = WS_MIX + (size_t)M * DM * 2;
constexpr size_t WS_QG  = WS_PROJ + (size_t)M * IN_WP * 2;
constexpr size_t WS_KG  = WS_QG + (size_t)M * GDN_W * 2;
constexpr size_t WS_VG  = WS_KG + (size_t)M * GDN_W * 2;
constexpr size_t WS_GG  = WS_VG + (size_t)M * GDN_W * 2;
constexpr size_t WS_BB  = WS_GG + (size_t)M * 16 * 4;
constexpr size_t WS_OF  = WS_BB + (size_t)M * 16 * 4;
constexpr size_t WS_OB  = WS_OF + (size_t)M * GDN_W * 4;
constexpr size_t WS_QA  = WS_OB + (size_t)M * GDN_W * 4;
constexpr size_t WS_KA  = WS_QA + (size_t)M * ATT_W * 2;
constexpr size_t WS_VA  = WS_KA + (size_t)KROWS * 256 * 2;
constexpr size_t WS_END = WS_VA + (size_t)KROWS * 256 * 2;
static_assert(WS_WIN % 256 == 0 && WS_WO % 256 == 0 && WS_WGU % 256 == 0 && WS_WD % 256 == 0 && WS_H % 256 == 0 && WS_MIX % 256 == 0 && WS_PROJ % 256 == 0 && WS_QG % 256 == 0 && WS_GG % 256 == 0 && WS_OF % 256 == 0 && WS_QA % 256 == 0 && WS_KA % 256 == 0 && WS_VA % 256 == 0, "ws alignment");
static_assert(WS_MOD + (size_t)DEPTH * 3 * 12288 * 4 <= WS_WIN, "mod table");
constexpr int CW_TMO = 0, CW_CODE = 1, CW_BAR = 4096;

constexpr int RING_OFF = 0, RING_BYTES = 131072;
constexpr int LDS_BYTES = 163840;
constexpr int LDSCTL_OFF = LDS_BYTES - 512, MISC_OFF = LDSCTL_OFF + 320;

#define GAS __attribute__((address_space(1)))
#define LAS __attribute__((address_space(3)))
typedef unsigned short bf16;
typedef unsigned v4u __attribute__((ext_vector_type(4)));
typedef unsigned v2u __attribute__((ext_vector_type(2)));
typedef float f32x4 __attribute__((ext_vector_type(4)));
typedef float f32x2 __attribute__((ext_vector_type(2)));
typedef GAS unsigned gu32;
#define RLX_AGENT __ATOMIC_RELAXED, __HIP_MEMORY_SCOPE_AGENT
#define LDS_WAIT() asm volatile("s_waitcnt lgkmcnt(0)" ::: "memory")
#define VM_WAIT() asm volatile("s_waitcnt vmcnt(0)" ::: "memory")
__device__ __forceinline__ unsigned f2bf(float f) { unsigned u = __builtin_bit_cast(unsigned, f); return (u + 0x7fffu + ((u >> 16) & 1u)) >> 16; }
__device__ __forceinline__ unsigned pk2(float lo, float hi) { return f2bf(lo) | (f2bf(hi) << 16); }
__device__ __forceinline__ float bf_lo(unsigned w) { return __builtin_bit_cast(float, w << 16); }
__device__ __forceinline__ float bf_hi(unsigned w) { return __builtin_bit_cast(float, w & 0xffff0000u); }
__device__ __forceinline__ float bf1(bf16 h) { return __builtin_bit_cast(float, (unsigned)h << 16); }
__device__ __forceinline__ float wave_sum(float v) {
#pragma unroll
    for (int o = 1; o < 64; o <<= 1) v += __shfl_xor(v, o);
    return v;
}
__device__ __forceinline__ float silu(float x) { return x / (1.0f + __expf(-x)); }
#define XB_TMO      128
#define XB_XCNT(j)  (256  + 64 * (j))
#define XB_XSUB(j)  (1280 + 64 * (j))
#define XB_XGEN(j)  (2304 + 64 * (j))
#define XB_TOP      3328
#define XB_TOPGEN   3392
#define XCD_BAR_WORDS 3456
#define XB_SPIN_CAP (1u << 18)

__device__ __forceinline__ unsigned xb_ld(unsigned* p)              { return __hip_atomic_load(p, __ATOMIC_RELAXED, __HIP_MEMORY_SCOPE_AGENT); }
__device__ __forceinline__ unsigned xb_add(unsigned* p, unsigned v) { return __hip_atomic_fetch_add(p, v, __ATOMIC_RELAXED, __HIP_MEMORY_SCOPE_AGENT); }
__device__ __forceinline__ unsigned xb_xcc_id() { return (unsigned)__builtin_amdgcn_s_getreg((3 << 11) | 20) & 0xFu; }
#define XB_SPIN(cond, bar) do { unsigned _sp = 0; while (cond) { __builtin_amdgcn_s_sleep(1); \
    if ((++_sp & 255u) == 0u) { if (xb_ld(&(bar)[XB_TMO])) break; if (_sp > XB_SPIN_CAP) { atomicAdd(&(bar)[XB_TMO], 1u); break; } } } } while (0)

struct XcdBarrier {
    unsigned* bar; unsigned x;
    volatile LAS unsigned* st;
};

__device__ __forceinline__ XcdBarrier xcd_barrier_post(unsigned* bar, volatile LAS unsigned* st) {
    XcdBarrier b; b.bar = bar; b.x = xb_xcc_id(); b.st = st;
    if (threadIdx.x == 0) (void)xb_add(&bar[XB_XCNT(b.x)], 1u);
    return b;
}
__device__ __forceinline__ void xcd_barrier_complete(unsigned* bar, unsigned x, unsigned& nloc, unsigned& nx) {
    const unsigned G = gridDim.x * gridDim.y * gridDim.z;
    unsigned sum, cnt, mine, sp = 0u;
    for (;;) {
        sum = 0u; cnt = 0u; mine = 0u;
#pragma unroll
        for (unsigned j = 0; j < 16; ++j) { const unsigned c = xb_ld(&bar[XB_XCNT(j)]); sum += c; cnt += (c > 0u) ? 1u : 0u; mine = (j == x) ? c : mine; }
        if (sum == G) break;
        __builtin_amdgcn_s_sleep(1);
        if ((++sp & 255u) == 0u) { if (xb_ld(&bar[XB_TMO])) break; if (sp > XB_SPIN_CAP) { atomicAdd(&bar[XB_TMO], 1u); break; } }
    }
    nloc = mine > 0u ? mine : 1u; nx = cnt > 0u ? cnt : 1u;
}

__device__ __forceinline__ void xcd_barrier(const XcdBarrier& b) {
    asm volatile("s_waitcnt vmcnt(0)" ::: "memory");
    __syncthreads();
    if (threadIdx.x == 0) {
        unsigned* bar = b.bar;
        __builtin_amdgcn_s_waitcnt(0);
        unsigned nloc = b.st[0], nx = b.st[1];
        if (nloc == 0u) { xcd_barrier_complete(bar, b.x, nloc, nx); b.st[0] = nloc; b.st[1] = nx; }
        const unsigned old = xb_add(&bar[XB_XSUB(b.x)], 1u);
        const unsigned gen = old / nloc;
        if (old + 1u == (gen + 1u) * nloc) {
            __builtin_amdgcn_fence(__ATOMIC_RELEASE, "agent");
            asm volatile("s_waitcnt vmcnt(0)" ::: "memory");
            const unsigned og = xb_add(&bar[XB_TOP], 1u);
            const unsigned tg = og / nx;
            if (og + 1u == (tg + 1u) * nx) xb_add(&bar[XB_TOPGEN], 1u);
            else XB_SPIN(xb_ld(&bar[XB_TOPGEN]) == tg, bar);
            __builtin_amdgcn_fence(__ATOMIC_ACQUIRE, "agent");
            xb_add(&bar[XB_XGEN(b.x)], 1u);
            asm volatile("s_waitcnt vmcnt(0)" ::: "memory");
        } else {
            XB_SPIN(xb_ld(&bar[XB_XGEN(b.x)]) == gen, bar);
            __builtin_amdgcn_fence(__ATOMIC_ACQUIRE, "agent");
            asm volatile("s_waitcnt vmcnt(0)" ::: "memory");
        }
    }
    __syncthreads();
}

struct Args { const float* in[N_IN]; float* out; unsigned char* ws; int ph_lo, ph_hi; };
static_assert(sizeof(Args) == 8 * (N_IN + 2) + 8, "Args has no padding");
#define CAS __attribute__((address_space(4)))
#define ARGS_T const CAS Args
__device__ __forceinline__ ARGS_T* fresh_args() { const CAS char* p = (const CAS char*)__builtin_amdgcn_kernarg_segment_ptr(); asm volatile("" : "+s"(p)); return (ARGS_T*)p; }
__device__ __forceinline__ int fresh_tid() { int t = threadIdx.x; asm volatile("" : "+v"(t)); return t; }
__device__ __forceinline__ int fresh_bx() { int b = blockIdx.x; asm volatile("" : "+s"(b)); return b; }

struct Frame {
    LAS unsigned char* lds;
    volatile LAS unsigned* MISC;
    gu32* ctl;
    int tid, lane, wave;
    int vcu, G, bx;
    float* out;
    unsigned char* ws;
};
#define WSP(T, off) ((T*)(F.ws + (off)))

__device__ __forceinline__ void p0_transpose_item(const float* W, int K, int N, bf16* WT, int k0, int n0, int drow0, LAS float* scr, int lane) {
#pragma unroll 8
    for (int i = 0; i < 32; ++i) { const int kk = 2 * i + (lane >> 5); scr[kk * 33 + (lane & 31)] = W[(size_t)(k0 + kk) * N + n0 + (lane & 31)]; }
    LDS_WAIT(); asm volatile("" ::: "memory");
    const int c = lane & 7;
#pragma unroll
    for (int j = 0; j < 4; ++j) { const int n = (lane >> 3) + 8 * j; const LAS float* s = scr + (8 * c) * 33 + n;
        v4u o; o.x = pk2(s[0 * 33], s[1 * 33]); o.y = pk2(s[2 * 33], s[3 * 33]); o.z = pk2(s[4 * 33], s[5 * 33]); o.w = pk2(s[6 * 33], s[7 * 33]);
        *(GAS v4u*)(WT + (size_t)(drow0 + n) * K + k0 + 8 * c) = o; }
    LDS_WAIT(); asm volatile("" ::: "memory");
}
__device__ __forceinline__ void p0a_phase(ARGS_T& A, Frame& F) {
    LAS float* sl = (LAS float*)(F.lds);
    LAS float* red = (LAS float*)(F.lds + 32768);
    for (int i = F.tid; i < 3 * DM; i += NWAVES * 64) { const int ci = i / DM, k = i % DM; const float c = ci == 0 ? A.in[I_CCTX][k] : A.in[I_C][(ci - 1) * DM + k]; sl[i] = silu(c); }
    __syncthreads();
    for (int grp = F.bx; grp < 256; grp += F.G) {
        const int l = grp >> 7, n0 = (grp & 127) * 96;
        const int cg = F.tid % 24, kg = F.tid / 24;
        float a[3][4];
#pragma unroll
        for (int ci = 0; ci < 3; ++ci)
#pragma unroll
            for (int j = 0; j < 4; ++j) a[ci][j] = 0.f;
        if (kg < 21) {
            const float* wp = A.in[I_WADA] + (size_t)l * DM * 12288 + n0 + 4 * cg;
#pragma unroll 4
            for (int k = kg; k < DM; k += 21) { const f32x4 w = *(const f32x4*)(wp + (size_t)k * 12288); const float s0 = sl[k], s1 = sl[DM + k], s2 = sl[2 * DM + k];
#pragma unroll
                for (int j = 0; j < 4; ++j) { a[0][j] += s0 * w[j]; a[1][j] += s1 * w[j]; a[2][j] += s2 * w[j]; } }
#pragma unroll
            for (int ci = 0; ci < 3; ++ci)
#pragma unroll
                for (int j = 0; j < 4; ++j) red[(kg * 24 + cg) * 12 + ci * 4 + j] = a[ci][j];
        }
        __syncthreads();
        if (F.tid < 288) { const int c2 = F.tid / 12, j = F.tid % 12, ci = j >> 2, cc = j & 3; float s = 0.f;
            for (int q = 0; q < 21; ++q) s += red[(q * 24 + c2) * 12 + j];
            const int n = n0 + 4 * c2 + cc;
            WSP(float, WS_MOD)[((size_t)l * 3 + ci) * 12288 + n] = s + A.in[I_BADA][(size_t)l * 12288 + n]; }
        __syncthreads();
    }
    LAS float* scr = (LAS float*)(F.lds + RING_OFF + F.wave * 16384);
    const int gw = F.vcu * NWAVES + F.wave, NGW = F.G * NWAVES;
    constexpr int I_IN = (DM / 64) * (IN_W / 32), I_O = (DM / 64) * (DM / 32), I_GU = (DM / 64) * (2 * DFF / 32), I_D = (DFF / 64) * (DM / 32), I_LAYER = I_IN + I_O + I_GU + I_D;
    for (int it = gw; it < DEPTH * I_LAYER; it += NGW) {
        const int l = it / I_LAYER; int r = it % I_LAYER;
        if (r < I_IN) { const int nblk = IN_W / 32, kb = r / nblk, nb = r % nblk;
            p0_transpose_item(A.in[I_WIN] + (size_t)l * DM * IN_W, DM, IN_W, WSP(bf16, WS_WIN) + (size_t)l * IN_WP * DM, 64 * kb, 32 * nb, 32 * nb, scr, F.lane); continue; } r -= I_IN;
        if (r < I_O) { const int nblk = DM / 32, kb = r / nblk, nb = r % nblk;
            p0_transpose_item(A.in[I_WO] + (size_t)l * DM * DM, DM, DM, WSP(bf16, WS_WO) + (size_t)l * DM * DM, 64 * kb, 32 * nb, 32 * nb, scr, F.lane); continue; } r -= I_O;
        if (r < I_GU) { const int nblk = 2 * DFF / 32, kb = r / nblk, nb = r % nblk, n0 = 32 * nb, s = n0 / DFF, j = n0 % DFF, p = j / 128, rr = j % 128;
            p0_transpose_item(A.in[I_WGU] + (size_t)l * DM * 2 * DFF, DM, 2 * DFF, WSP(bf16, WS_WGU) + (size_t)l * 2 * DFF * DM, 64 * kb, n0, 256 * p + 128 * s + rr, scr, F.lane); continue; } r -= I_GU;
        { const int nblk = DM / 32, kb = r / nblk, nb = r % nblk;
            p0_transpose_item(A.in[I_WD] + (size_t)l * DFF * DM, DFF, DM, WSP(bf16, WS_WD) + (size_t)l * DM * DFF, 64 * kb, 32 * nb, 32 * nb, scr, F.lane); }
    }
    { const int gt = F.vcu * NWAVES * 64 + F.tid, NGT = F.G * NWAVES * 64; constexpr int PADV = (IN_WP - IN_W) * DM * 2 / 16;
        for (int i = gt; i < DEPTH * PADV; i += NGT) { const int l = i / PADV, r = i % PADV; ((GAS v4u*)(WSP(bf16, WS_WIN) + (size_t)l * IN_WP * DM + (size_t)IN_W * DM))[r] = (v4u){0u, 0u, 0u, 0u}; } }
}

__device__ __forceinline__ int cond_of_row(int row) { return row < M_CTX ? 0 : 1 + ((row - M_CTX) >> 10); }
__device__ __forceinline__ void p0b_phase(ARGS_T& A, Frame& F) {
    const int gw = F.vcu * NWAVES + F.wave, NGW = F.G * NWAVES;
    for (int row = gw; row < M; row += NGW) {
        const float* xr = row < M_CTX ? A.in[I_XP] + (size_t)row * DM : A.in[I_XS] + (size_t)(row - M_CTX) * DM;
        const float* mod = WSP(float, WS_MOD) + (size_t)cond_of_row(row) * 12288;
        GAS v2u* o8 = (GAS v2u*)(WSP(bf16, WS_H) + (size_t)row * DM) + F.lane;
#pragma unroll
        for (int j = 0; j < 8; ++j) { const int c = 4 * F.lane + 256 * j; const f32x4 x = *(const f32x4*)(xr + c), sh = *(const f32x4*)(mod + c), sc = *(const f32x4*)(mod + DM + c);
            const f32x4 h = x * (sc + 1.0f) + sh; o8[64 * j] = (v2u){pk2(h[0], h[1]), pk2(h[2], h[3])}; }
    }
}
__device__ __forceinline__ void ln_phase(ARGS_T& A, Frame& F, const float* lg, const float* lb, const float* modsh, const float* modsc, bool write_h) {
    const int gw = F.vcu * NWAVES + F.wave, NGW = F.G * NWAVES;
    float* X = F.out;
    for (int row = gw; row < M; row += NGW) {
        float* xr = X + (size_t)row * DM;
        f32x4 v[8]; float s = 0.f;
#pragma unroll
        for (int j = 0; j < 8; ++j) { v[j] = *(const f32x4*)(xr + 4 * F.lane + 256 * j); s += (v[j][0] + v[j][1]) + (v[j][2] + v[j][3]); }
        const float mean = wave_sum(s) * (1.f / DM); float s2 = 0.f;
#pragma unroll
        for (int j = 0; j < 8; ++j) { v[j] = v[j] - mean; s2 += (v[j][0] * v[j][0] + v[j][1] * v[j][1]) + (v[j][2] * v[j][2] + v[j][3] * v[j][3]); }
        const float rstd = 1.f / sqrtf(wave_sum(s2) * (1.f / DM) + LN_EPS);
        const int ci = cond_of_row(row);
        GAS v2u* o8 = (GAS v2u*)(WSP(bf16, WS_H) + (size_t)row * DM) + F.lane;
#pragma unroll
        for (int j = 0; j < 8; ++j) { const int c = 4 * F.lane + 256 * j; const f32x4 g = *(const f32x4*)(lg + c), b = *(const f32x4*)(lb + c);
            const f32x4 y = v[j] * rstd * g + b; *(f32x4*)(xr + c) = y;
            if (write_h) { const f32x4 sh = *(const f32x4*)(modsh + (size_t)ci * 12288 + c), sc = *(const f32x4*)(modsc + (size_t)ci * 12288 + c);
                const f32x4 h = y * (sc + 1.0f) + sh; o8[64 * j] = (v2u){pk2(h[0], h[1]), pk2(h[2], h[3])}; } }
    }
}

__device__ __forceinline__ void prep_phase(ARGS_T& A, Frame& F, int l) {
    LAS float* cw = (LAS float*)(F.lds);
    { const float* cwg = A.in[I_CONVW] + (size_t)l * CONVK * QKV_W;
      for (int i = F.tid; i < CONVK * QKV_W / 4; i += NWAVES * 64) ((LAS f32x4*)cw)[i] = ((const f32x4*)cwg)[i]; }
    __syncthreads();
    const int gw = F.vcu * NWAVES + F.wave, NGW = F.G * NWAVES, lane = F.lane;
    const bf16* PROJ = WSP(bf16, WS_PROJ);
    for (int item = gw; item < M + NB_LAT * PAST; item += NGW) {
        if (item >= M) {
            const int r = item - M, b = r / PAST, j = r % PAST; const size_t src = ((size_t)(b * DEPTH + l) * PAST + j) * 256 + 4 * lane; const size_t krow = (size_t)M_CTX + (size_t)b * (LSEQ + PAST) + LSEQ + j;
            const f32x4 kv = *(const f32x4*)(A.in[I_CK] + src), vv = *(const f32x4*)(A.in[I_CV] + src);
            *(GAS v2u*)(WSP(bf16, WS_KA) + krow * 256 + 4 * lane) = (v2u){pk2(kv[0], kv[1]), pk2(kv[2], kv[3])};
            *(GAS v2u*)(WSP(bf16, WS_VA) + krow * 256 + 4 * lane) = (v2u){pk2(vv[0], vv[1]), pk2(vv[2], vv[3])};
            continue; }
        const int row = item; const bool lat = row >= M_CTX;
        int seq0, t, T, bidx;
        if (!lat) { seq0 = row & ~(SEQ - 1); t = row & (SEQ - 1); T = SEQ; bidx = row >> 8; } else { const int r = row - M_CTX; seq0 = M_CTX + (r & ~(LSEQ - 1)); t = r & (LSEQ - 1); T = LSEQ; bidx = r >> 10; }
        const bf16* prow = PROJ + (size_t)row * IN_WP;
        float a0[24], a1[24];
#pragma unroll
        for (int i = 0; i < 24; ++i) { a0[i] = 0.f; a1[i] = 0.f; }
#pragma unroll
        for (int j = 0; j < CONVK; ++j) { const int tt = t + j - 2;
            if (tt >= 0 && tt < T) { const bf16* pr = PROJ + (size_t)(seq0 + tt) * IN_WP + 2 * lane;
#pragma unroll
                for (int i = 0; i < 24; ++i) { const unsigned w = *(const unsigned*)(pr + 128 * i); const f32x2 cv = *(const LAS f32x2*)(cw + j * QKV_W + 128 * i + 2 * lane);
                    a0[i] += cv[0] * bf_lo(w); a1[i] += cv[1] * bf_hi(w); } } }
#pragma unroll
        for (int i = 0; i < 24; ++i) { float y0 = silu(a0[i]), y1 = silu(a1[i]);
            if (i < 16) { const float ss = wave_sum(y0 * y0 + y1 * y1); float sc = 1.f / sqrtf(ss + RMS_EPS); if (i < 8) sc *= 0.08838834764831845f; y0 *= sc; y1 *= sc; }
            bf16* dst = (i < 8 ? WSP(bf16, WS_QG) : i < 16 ? WSP(bf16, WS_KG) : WSP(bf16, WS_VG)) + (size_t)row * GDN_W + 128 * (i & 7) + 2 * lane;
            *(GAS unsigned*)dst = pk2(y0, y1); }
        if (lane < 16) { const float bv = bf1(prow[C_B + lane]), av = bf1(prow[C_A + lane]) + A.in[I_DTB][l * 16 + lane];
            const float sp = fmaxf(av, 0.f) + log1pf(expf(-fabsf(av)));
            WSP(float, WS_GG)[(size_t)row * 16 + lane] = -expf(A.in[I_ALOG][l * 16 + lane]) * sp;
            WSP(float, WS_BB)[(size_t)row * 16 + lane] = 1.f / (1.f + expf(-bv)); }
        float rc0 = 1.f, rs0 = 0.f, rc1 = 1.f, rs1 = 0.f;
        if (lat) { const float pos = (float)(lane < 32 ? (t >> 6) : (t & 63)); const int i0 = 2 * (lane & 15);
            const float f0 = powf(10000.f, -(float)(2 * i0) / 64.f), f1 = powf(10000.f, -(float)(2 * i0 + 2) / 64.f);
            sincosf(pos * f0, &rs0, &rc0); sincosf(pos * f1, &rs1, &rc1); }
        const float sgn = (lane & 16) ? 1.f : -1.f;
        const f32x2 qw = *(const f32x2*)(A.in[I_QNW] + l * HD + 2 * lane), kw = *(const f32x2*)(A.in[I_KNW] + l * HD + 2 * lane);
#pragma unroll
        for (int h = 0; h < NQ + NKV; ++h) { const bool isq = h < NQ; const int col = isq ? C_AQ + 128 * h : C_AK + 128 * (h - NQ);
            const unsigned w = *(const unsigned*)(prow + col + 2 * lane); float x0 = bf_lo(w), x1 = bf_hi(w);
            const float ms = wave_sum(x0 * x0 + x1 * x1) * (1.f / HD); const float r = 1.f / sqrtf(ms + RMS_EPS);
            x0 = x0 * r * (isq ? qw[0] : kw[0]); x1 = x1 * r * (isq ? qw[1] : kw[1]);
            if (!isq && !lat) { *(f32x2*)(F.out + OUT_CK + ((size_t)(bidx * DEPTH + l) * SEQ + t) * 256 + 128 * (h - NQ) + 2 * lane) = (f32x2){x0, x1}; }
            if (lat) { const float o0 = __shfl_xor(x0, 16), o1 = __shfl_xor(x1, 16); x0 = x0 * rc0 + sgn * o0 * rs0; x1 = x1 * rc1 + sgn * o1 * rs1; }
            if (isq) *(GAS unsigned*)(WSP(bf16, WS_QA) + (size_t)row * ATT_W + 128 * h + 2 * lane) = pk2(x0, x1);
            else { const size_t krow = lat ? (size_t)M_CTX + (size_t)bidx * (LSEQ + PAST) + t : (size_t)row;
                   *(GAS unsigned*)(WSP(bf16, WS_KA) + krow * 256 + 128 * (h - NQ) + 2 * lane) = pk2(x0, x1); } }
#pragma unroll
        for (int h = 0; h < NKV; ++h) { const unsigned w = *(const unsigned*)(prow + C_AV + 128 * h + 2 * lane);
            const size_t krow = lat ? (size_t)M_CTX + (size_t)bidx * (LSEQ + PAST) + t : (size_t)row;
            *(GAS unsigned*)(WSP(bf16, WS_VA) + krow * 256 + 128 * h + 2 * lane) = w;
            if (!lat) *(f32x2*)(F.out + OUT_CV + ((size_t)(bidx * DEPTH + l) * SEQ + t) * 256 + 128 * h + 2 * lane) = (f32x2){bf_lo(w), bf_hi(w)}; }
    }
}

constexpr int GDN_ITEMS_CTX = NB_CTX * HG * 2 / 4, GDN_ITEMS = GDN_ITEMS_CTX + NB_LAT * HG * 2 / 4;
__device__ __forceinline__ void gdn_rec_item(ARGS_T& A, Frame& F, int l, int it) {
    const bool lat = it >= GDN_ITEMS_CTX; const int cbase = lat ? (it - GDN_ITEMS_CTX) * 4 : it * 4;
    const int slot = F.tid >> 7, e = F.tid & 127, c = cbase + slot, b = c >> 4, h = (c >> 1) & 7, dir = c & 1;
    const int T = lat ? LSEQ : SEQ, row0 = lat ? M_CTX + b * LSEQ : b * SEQ;
    float S[128];
    if (lat) { const float* s0 = A.in[I_ST] + ((((size_t)b * DEPTH + l) * 2 + dir) * HG + h) * (size_t)(DKV * DKV) + e;
#pragma unroll
        for (int d = 0; d < 128; ++d) S[d] = s0[(size_t)d * DKV]; }
    else {
#pragma unroll
        for (int d = 0; d < 128; ++d) S[d] = 0.f; }
    constexpr int NBS = 16, SLOTF = NBS * 384 + 64;
    LAS float* kq = (LAS float*)(F.lds) + slot * SLOTF;
    const bf16 *KG = WSP(bf16, WS_KG), *QG = WSP(bf16, WS_QG), *VG = WSP(bf16, WS_VG);
    float* OD = dir ? WSP(float, WS_OB) : WSP(float, WS_OF);
    for (int i0 = 0; i0 < T; i0 += NBS) {
        __syncthreads();
#pragma unroll 4
        for (int j = 0; j < NBS; ++j) { const int t = dir ? T - 1 - (i0 + j) : i0 + j; const size_t off = (size_t)(row0 + t) * GDN_W + h * 128 + e;
            kq[j * 384 + e] = bf1(KG[off]); kq[j * 384 + 128 + e] = bf1(QG[off]); kq[j * 384 + 256 + e] = bf1(VG[off]); }
        if (e < NBS) { const int t = dir ? T - 1 - (i0 + e) : i0 + e; const size_t off = (size_t)(row0 + t) * 16 + dir * 8 + h;
            kq[NBS * 384 + e] = WSP(float, WS_GG)[off]; kq[NBS * 384 + 16 + e] = WSP(float, WS_BB)[off]; }
        __syncthreads();
        for (int j = 0; j < NBS; ++j) {
            const LAS float* kp = kq + j * 384; const float decay = __expf(kq[NBS * 384 + j]), beta = kq[NBS * 384 + 16 + j], v = kp[256 + e];
            float kv0 = 0.f, kv1 = 0.f;
#pragma unroll
            for (int dc = 0; dc < 128; dc += 16) {
#pragma unroll
                for (int d = dc; d < dc + 16; d += 4) { const f32x4 k4 = *(const LAS f32x4*)(kp + d); kv0 += k4[0] * S[d] + k4[2] * S[d + 2]; kv1 += k4[1] * S[d + 1] + k4[3] * S[d + 3]; }
                __builtin_amdgcn_sched_barrier(0); }
            const float delta = beta * (v - decay * (kv0 + kv1));
            float o0 = 0.f, o1 = 0.f;
#pragma unroll
            for (int dc = 0; dc < 128; dc += 8) {
#pragma unroll
                for (int d = dc; d < dc + 8; d += 4) { const f32x4 k4 = *(const LAS f32x4*)(kp + d), q4 = *(const LAS f32x4*)(kp + 128 + d);
                    S[d] = decay * S[d] + k4[0] * delta; S[d + 1] = decay * S[d + 1] + k4[1] * delta; S[d + 2] = decay * S[d + 2] + k4[2] * delta; S[d + 3] = decay * S[d + 3] + k4[3] * delta;
                    o0 += q4[0] * S[d] + q4[2] * S[d + 2]; o1 += q4[1] * S[d + 1] + q4[3] * S[d + 3]; }
                __builtin_amdgcn_sched_barrier(0); }
            const int t = dir ? T - 1 - (i0 + j) : i0 + j;
            OD[(size_t)(row0 + t) * GDN_W + h * 128 + e] = o0 + o1;
        }
    }
    if (!lat) { float* so = F.out + OUT_ST + ((((size_t)b * DEPTH + l) * 2 + dir) * HG + h) * (size_t)(DKV * DKV) + e;
#pragma unroll
        for (int d = 0; d < 128; ++d) so[(size_t)d * DKV] = S[d]; }
    __syncthreads();
}
constexpr int ATT_UNITS_LAT = NB_LAT * NQ * (LSEQ / 256), ATT_UNITS = ATT_UNITS_LAT + NB_CTX * NQ;
__device__ __forceinline__ void attn_unit(Frame& F, int u, char* lds) {
    const att::bf16* QA = (const att::bf16*)WSP(bf16, WS_QA); const att::bf16* KA = (const att::bf16*)WSP(bf16, WS_KA); const att::bf16* VA = (const att::bf16*)WSP(bf16, WS_VA);
    att::bf16* MIX = (att::bf16*)WSP(bf16, WS_MIX);
    int qrow0, krow0, h, seq;
    if (u < ATT_UNITS_LAT) { const int b = u / (NQ * 4), r = u % (NQ * 4); h = r >> 2; const int qb = r & 3; qrow0 = M_CTX + b * LSEQ + qb * 256; krow0 = M_CTX + b * (LSEQ + PAST); seq = LSEQ + PAST; }
    else { const int v = u - ATT_UNITS_LAT, b = v >> 3; h = v & 7; qrow0 = b * SEQ; krow0 = b * SEQ; seq = SEQ; }
    const int kvh = h >> 2;
    att::attn_dense_body<att::bf16>(QA + (size_t)qrow0 * ATT_W + h * HD, KA + (size_t)krow0 * 256 + kvh * HD, VA + (size_t)krow0 * 256 + kvh * HD, MIX + (size_t)qrow0 * DM + GDN_W + h * HD, seq, lds);
    __syncthreads();
}
__device__ __forceinline__ void combine_phase(ARGS_T& A, Frame& F, int l) {
    const int gw = F.vcu * NWAVES + F.wave, NGW = F.G * NWAVES, lane = F.lane;
    const f32x2 nw = *(const f32x2*)(A.in[I_GNW] + l * DKV + 2 * lane);
    for (int row = gw; row < M; row += NGW) {
        const float* of = WSP(float, WS_OF) + (size_t)row * GDN_W + 2 * lane; const float* ob = WSP(float, WS_OB) + (size_t)row * GDN_W + 2 * lane;
        const bf16* z = WSP(bf16, WS_PROJ) + (size_t)row * IN_WP + C_Z + 2 * lane; bf16* mx = WSP(bf16, WS_MIX) + (size_t)row * DM + 2 * lane;
#pragma unroll
        for (int h = 0; h < HG; ++h) { const f32x2 a = *(const f32x2*)(of + 128 * h), b = *(const f32x2*)(ob + 128 * h); const float o0 = a[0] + b[0], o1 = a[1] + b[1];
            const float r = 1.f / sqrtf(wave_sum(o0 * o0 + o1 * o1) * (1.f / DKV) + RMS_EPS); const unsigned zw = *(const unsigned*)(z + 128 * h);
            *(GAS unsigned*)(mx + 128 * h) = pk2(o0 * r * nw[0] * silu(bf_lo(zw)), o1 * r * nw[1] * silu(bf_hi(zw))); }
    }
}

namespace gdn {
typedef short bf16x8 __attribute__((ext_vector_type(8)));
typedef short s16x4 __attribute__((ext_vector_type(4)));
typedef float f32x16 __attribute__((ext_vector_type(16)));
constexpr int O_QR = 0, O_KR = 17408, O_KT = 34816, O_VT = 53248, O_ST = 71680, O_LR = 106496, O_LT = 115712, O_PR = 124928, O_AT = 134144, O_VEC = 143360, O_VTMP = 145408, O_END = 162816;
constexpr int O_WR = O_KR, O_VNT = O_VT, O_VST = O_LR;
constexpr int SW = 272, SN = 144;
constexpr int V_GC = 0, V_BE = 256, V_EGC = 512, V_BW = 768, V_SF = 1024, V_EG63 = 1280;
constexpr int NCHAIN_LAT = NB_LAT * HG * 2, NCHAIN = NCHAIN_LAT + NB_CTX * HG * 2;
static_assert(O_END + 512 <= LDS_BYTES && O_END <= LDSCTL_OFF, "gdn LDS map");

__device__ __forceinline__ int crow(int r, int hi) { return (r & 3) + 8 * (r >> 2) + 4 * hi; }
__device__ __forceinline__ unsigned cvt2(float lo, float hi) { return pg8::cvt_pk_bf16(lo, hi); }
template <int KS> __device__ __forceinline__ void mma(f32x16& acc, LAS const unsigned char* A, int sa, LAS const unsigned char* B, int sb, int lane) {
    LAS const unsigned char* pa = A + (lane & 31) * sa + (lane >> 5) * 16; LAS const unsigned char* pb = B + (lane & 31) * sb + (lane >> 5) * 16;
#pragma unroll
    for (int ks = 0; ks < KS; ++ks) { const bf16x8 a = *(LAS const bf16x8*)(pa + ks * 32), b = *(LAS const bf16x8*)(pb + ks * 32); acc = __builtin_amdgcn_mfma_f32_32x32x16_bf16(a, b, acc, 0, 0, 0);
        if ((ks & 3) == 3) __builtin_amdgcn_sched_barrier(0); }
}
template <int KS> __device__ __forceinline__ void ldfrag(bf16x8 (&f)[KS], LAS const unsigned char* A, int sa, int lane) {
    LAS const unsigned char* pa = A + (lane & 31) * sa + (lane >> 5) * 16;
#pragma unroll
    for (int ks = 0; ks < KS; ++ks) f[ks] = *(LAS const bf16x8*)(pa + ks * 32);
}
__device__ __forceinline__ void st_T(LAS unsigned char* dst, int sd, const f32x16& v, int lane) {
    LAS unsigned char* p = dst + (lane & 31) * sd + (lane >> 5) * 8;
#pragma unroll
    for (int rg = 0; rg < 4; ++rg) *(LAS v2u*)(p + rg * 16) = (v2u){cvt2(v[4 * rg], v[4 * rg + 1]), cvt2(v[4 * rg + 2], v[4 * rg + 3])};
}
__device__ __forceinline__ void st_R(LAS unsigned char* dst, int sd, const f32x16& v, int lane) {
    const int hi = lane >> 5; LAS unsigned char* p = dst + (lane & 31) * 2;
#pragma unroll
    for (int r = 0; r < 16; r += 2) { const unsigned w = cvt2(v[r], v[r + 1]);
        *(LAS unsigned short*)(p + crow(r, hi) * sd) = (unsigned short)(w & 0xffffu); *(LAS unsigned short*)(p + crow(r + 1, hi) * sd) = (unsigned short)(w >> 16); }
}
__device__ __forceinline__ void ldrow16(float (&o)[16], LAS const unsigned char* vec, int m0, int hi) {
#pragma unroll
    for (int rg = 0; rg < 4; ++rg) { const f32x4 t = *(LAS const f32x4*)(vec + 4 * (m0 + 8 * rg + 4 * hi)); o[4 * rg] = t[0]; o[4 * rg + 1] = t[1]; o[4 * rg + 2] = t[2]; o[4 * rg + 3] = t[3]; }
}

__device__ __forceinline__ void chain(ARGS_T& A, Frame& F, int l, int cid) {
    const bool lat = cid < NCHAIN_LAT; const int c2 = lat ? cid : cid - NCHAIN_LAT; const int b = c2 >> 4, h = (c2 >> 1) & 7, dir = c2 & 1;
    const int T = lat ? LSEQ : SEQ, NC = T / 64, row0 = lat ? M_CTX + b * LSEQ : b * SEQ;
    LAS unsigned char* L = F.lds; LAS unsigned char* VEC = L + O_VEC;
    const int tid0 = F.tid, w0 = F.wave;
    const bf16* QG = WSP(bf16, WS_QG) + h * 128; const bf16* KG = WSP(bf16, WS_KG) + h * 128; const bf16* VG = WSP(bf16, WS_VG) + h * 128;
    const float* GGp = WSP(float, WS_GG) + dir * 8 + h; const float* BBp = WSP(float, WS_BB) + dir * 8 + h;
    float* OD = (dir ? WSP(float, WS_OB) : WSP(float, WS_OF)) + h * 128;
    f32x16 S0t, S1t;
    { const int w = w0, lane = tid0 & 63, hi = lane >> 5, c31 = lane & 31, te_s = w & 3, td0 = w >> 2, td1 = 2 + (w >> 2);
    if (lat) { const float* s0 = A.in[I_ST] + ((((size_t)b * DEPTH + l) * 2 + dir) * HG + h) * (size_t)(DKV * DKV);
        const float* p0 = s0 + (32 * td0 + 4 * hi) * DKV + 32 * te_s + c31; const float* p1 = s0 + (32 * td1 + 4 * hi) * DKV + 32 * te_s + c31;
#pragma unroll
        for (int rg = 0; rg < 4; ++rg) {
#pragma unroll
            for (int x = 0; x < 4; ++x) { S0t[4 * rg + x] = p0[(8 * rg + x) * DKV]; S1t[4 * rg + x] = p1[(8 * rg + x) * DKV]; }
            asm volatile("" ::: "memory"); } }
    else {
#pragma unroll
        for (int r = 0; r < 16; ++r) { S0t[r] = 0.f; S1t[r] = 0.f; } }
    st_T(L + O_ST + 32 * te_s * SW + 32 * td0 * 2, SW, S0t, lane); st_T(L + O_ST + 32 * te_s * SW + 32 * td1 * 2, SW, S1t, lane); }
    v4u pq[2], pk[2], pv[2]; float pg = 0.f, pb = 0.f;
#define GDN_LOAD(c) do { _Pragma("unroll") for (int i_ = 0; i_ < 2; ++i_) { const int p_ = tid + 512 * i_, tl_ = 64 * (c) + (p_ >> 4), t_ = dir ? T - 1 - tl_ : tl_; const size_t off_ = (size_t)(row0 + t_) * GDN_W + 8 * (p_ & 15); \
        pq[i_] = *(const v4u*)(QG + off_); pk[i_] = *(const v4u*)(KG + off_); pv[i_] = *(const v4u*)(VG + off_); } \
        if (w == 0) { const int tl_ = 64 * (c) + lane, t_ = dir ? T - 1 - tl_ : tl_; pg = GGp[(size_t)(row0 + t_) * 16]; pb = BBp[(size_t)(row0 + t_) * 16]; } } while (0)
    { const int tid = tid0, w = w0, lane = tid0 & 63; GDN_LOAD(0); }
    for (int c = 0; c < NC; ++c) {
        int tid = tid0, w = w0; asm volatile("" : "+v"(tid)); asm volatile("" : "+s"(w));
        const int lane = tid & 63, hi = lane >> 5, c31 = lane & 31, te_s = w & 3, td0 = w >> 2, td1 = 2 + (w >> 2);
#pragma unroll
        for (int i = 0; i < 2; ++i) { const int p = tid + 512 * i, row = p >> 4, cb = p & 15;
            *(LAS v4u*)(L + O_QR + row * SW + cb * 16) = pq[i]; *(LAS v4u*)(L + O_KR + row * SW + cb * 16) = pk[i]; *(LAS v4u*)(L + O_VTMP + row * SW + cb * 16) = pv[i]; }
        if (w == 0) { float s = pg;
#pragma unroll
            for (int o = 1; o < 64; o <<= 1) { const float t = __shfl_up(s, o); if (lane >= o) s += t; }
            const float g63 = __shfl(s, 63), eg = __expf(s);
            *(LAS float*)(VEC + V_GC + 4 * lane) = s; *(LAS float*)(VEC + V_BE + 4 * lane) = pb; *(LAS float*)(VEC + V_EGC + 4 * lane) = eg; *(LAS float*)(VEC + V_BW + 4 * lane) = pb * eg;
            *(LAS float*)(VEC + V_SF + 4 * lane) = __expf(g63 - s); if (lane == 0) *(LAS float*)(VEC + V_EG63) = __expf(g63); }
        __syncthreads();
        if (c + 1 < NC) GDN_LOAD(c + 1);
#pragma unroll
        for (int n = 0; n < 4; ++n) { const int idx = 4 * n + (lane >> 4), rb = 2 * w + (idx >> 3), cbk = idx & 7, i16 = lane & 15, q = i16 >> 2, p = i16 & 3;
            const int so = (4 * rb + q) * SW + (16 * cbk + 4 * p) * 2, dof = (16 * cbk + i16) * SN + (4 * rb) * 2;
            const s16x4 kx = __builtin_bit_cast(s16x4, __builtin_amdgcn_ds_read_tr16_b64_v4i16((LAS s16x4*)(L + O_KR + so)));
            const s16x4 vx = __builtin_bit_cast(s16x4, __builtin_amdgcn_ds_read_tr16_b64_v4i16((LAS s16x4*)(L + O_VTMP + so)));
            *(LAS s16x4*)(L + O_KT + dof) = kx; *(LAS s16x4*)(L + O_VT + dof) = vx; }
        f32x16 Tt;
        constexpr int SB = 80;
        LAS unsigned char* W = L + O_LR + (w & 1) * 10240;
        LAS unsigned char* CRb = L + O_LR + 20480; LAS unsigned char* A32T = L + O_LR + 23040;
#pragma unroll
        for (int r = 0; r < 16; ++r) Tt[r] = 0.f;
        if (w < 3) {
            const int ti = (w == 0) ? 0 : 1, tj = (w == 1) ? 1 : 0; f32x16 acc;
#pragma unroll
            for (int r = 0; r < 16; ++r) acc[r] = 0.f;
            mma<8>(acc, L + O_KR + 32 * ti * SW, SW, L + O_KR + 32 * tj * SW, SW, lane);
            float gi[16], bi[16]; ldrow16(gi, VEC + V_GC, 32 * ti, hi); ldrow16(bi, VEC + V_BE, 32 * ti, hi);
            const float gj = *(LAS const float*)(VEC + V_GC + 4 * (32 * tj + c31)); const int j = 32 * tj + c31; f32x16 lv;
#pragma unroll
            for (int r = 0; r < 16; ++r) { const int i = 32 * ti + crow(r, hi); lv[r] = (i > j) ? bi[r] * acc[r] * __expf(gi[r] - gj) : 0.f; }
            if (w == 2) st_R(CRb, SB, lv, lane);
            else { const int jb = (lane >> 4) & 1; f32x16 ld, lo, z;
#pragma unroll
                for (int r = 0; r < 16; ++r) { const int ib = r >> 3; ld[r] = (ib == jb) ? lv[r] : 0.f; lo[r] = (ib == 1 && jb == 0) ? lv[r] : 0.f; Tt[r] = ((crow(r, hi) == c31) ? 1.f : 0.f) - ld[r]; }
                st_R(W, SB, ld, lane); st_T(W + 2560, SB, ld, lane); st_R(W + 5120, SB, Tt, lane); st_R(W + 7680, SB, lo, lane); LDS_WAIT();
#pragma unroll
                for (int r = 0; r < 16; ++r) z[r] = 0.f;
                mma<2>(z, W, SB, W + 2560, SB, lane); st_R(W, SB, z, lane); st_T(W + 2560, SB, z, lane); LDS_WAIT();
#pragma unroll
                for (int s2 = 0; s2 < 2; ++s2) { f32x16 z2;
#pragma unroll
                    for (int r = 0; r < 16; ++r) z2[r] = 0.f;
                    mma<2>(Tt, W + 5120, SB, W + 2560, SB, lane); mma<2>(z2, W, SB, W + 2560, SB, lane);
                    st_R(W + 5120, SB, Tt, lane); st_R(W, SB, z2, lane); st_T(W + 2560, SB, z2, lane); LDS_WAIT(); }
                mma<2>(Tt, W + 5120, SB, W + 2560, SB, lane); st_R(W + 5120, SB, Tt, lane); st_T(W + 2560, SB, Tt, lane); LDS_WAIT();
#pragma unroll
                for (int r = 0; r < 16; ++r) z[r] = 0.f;
                mma<2>(z, W + 7680, SB, W + 2560, SB, lane);
#pragma unroll
                for (int r = 0; r < 16; ++r) z[r] = -z[r];
                st_T(W, SB, z, lane); LDS_WAIT();
                mma<2>(Tt, W + 5120, SB, W, SB, lane);
                if (w == 0) st_T(A32T, SB, Tt, lane); else st_R(W + 5120, SB, Tt, lane); }
        } else if (w >= 4) { const int ti = (w >> 1) & 1, tj = w & 1; f32x16 acc;
#pragma unroll
            for (int r = 0; r < 16; ++r) acc[r] = 0.f;
            mma<8>(acc, L + O_QR + 32 * ti * SW, SW, L + O_KR + 32 * tj * SW, SW, lane);
            float gi[16]; ldrow16(gi, VEC + V_GC, 32 * ti, hi); const float gj = *(LAS const float*)(VEC + V_GC + 4 * (32 * tj + c31)); const int j = 32 * tj + c31; f32x16 av;
#pragma unroll
            for (int r = 0; r < 16; ++r) { const int i = 32 * ti + crow(r, hi); av[r] = (i >= j) ? acc[r] * __expf(gi[r] - gj) : 0.f; }
            st_R(L + O_AT + 32 * ti * SN + 32 * tj * 2, SN, av, lane); }
        __syncthreads();
        if (w == 2) { f32x16 y;
#pragma unroll
            for (int r = 0; r < 16; ++r) y[r] = 0.f;
            mma<2>(y, CRb, SB, A32T, SB, lane);
#pragma unroll
            for (int r = 0; r < 16; ++r) y[r] = -y[r];
            st_T(CRb, SB, y, lane); LDS_WAIT();
            mma<2>(Tt, L + O_LR + 10240 + 5120, SB, CRb, SB, lane); }
        __syncthreads();
        if (w < 4) { const int ti = (w == 0 || w == 3) ? 0 : 1, tj = (w == 1 || w == 3) ? 1 : 0;
            const float bj = *(LAS const float*)(VEC + V_BE + 4 * (32 * tj + c31)), bwj = *(LAS const float*)(VEC + V_BW + 4 * (32 * tj + c31)); f32x16 tu, tw;
#pragma unroll
            for (int r = 0; r < 16; ++r) { tu[r] = Tt[r] * bj; tw[r] = Tt[r] * bwj; }
            st_R(L + O_LR + 32 * ti * SN + 32 * tj * 2, SN, tu, lane); st_R(L + O_LR + 10240 + 32 * ti * SN + 32 * tj * 2, SN, tw, lane); }
        __syncthreads();
        const int ti = w >> 2, te = w & 3;
        f32x16 au, aw;
#pragma unroll
        for (int r = 0; r < 16; ++r) { au[r] = 0.f; aw[r] = 0.f; }
        mma<4>(au, L + O_LR + 32 * ti * SN, SN, L + O_VT + 32 * te * SN, SN, lane);
        mma<4>(aw, L + O_LR + 10240 + 32 * ti * SN, SN, L + O_KT + 32 * te * SN, SN, lane);
#pragma unroll
        for (int r = 0; r < 16; ++r) aw[r] = -aw[r];
        st_R(L + O_WR + 32 * ti * SW + 32 * te * 2, SW, aw, lane);
        __syncthreads();
        f32x16 aq;
#pragma unroll
        for (int r = 0; r < 16; ++r) aq[r] = 0.f;
        mma<8>(au, L + O_WR + 32 * ti * SW, SW, L + O_ST + 32 * te * SW, SW, lane);
        mma<8>(aq, L + O_QR + 32 * ti * SW, SW, L + O_ST + 32 * te * SW, SW, lane);
        { float sf[16]; ldrow16(sf, VEC + V_SF, 32 * ti, hi); f32x16 vs;
#pragma unroll
            for (int r = 0; r < 16; ++r) vs[r] = au[r] * sf[r];
            st_T(L + O_VNT + 32 * te * SN + 32 * ti * 2, SN, au, lane); st_T(L + O_VST + 32 * te * SN + 32 * ti * 2, SN, vs, lane); }
        __syncthreads();
        { float eg[16]; ldrow16(eg, VEC + V_EGC, 32 * ti, hi);
#pragma unroll
            for (int r = 0; r < 16; ++r) aq[r] *= eg[r];
            mma<4>(aq, L + O_AT + 32 * ti * SN, SN, L + O_VNT + 32 * te * SN, SN, lane);
#pragma unroll
            for (int r = 0; r < 16; ++r) { const int tl = 64 * c + 32 * ti + crow(r, hi), t = dir ? T - 1 - tl : tl; OD[(size_t)(row0 + t) * GDN_W + 32 * te + c31] = aq[r]; } }
        { const float e63 = *(LAS const float*)(VEC + V_EG63);
#pragma unroll
            for (int r = 0; r < 16; ++r) { S0t[r] *= e63; S1t[r] *= e63; }
            mma<4>(S0t, L + O_KT + 32 * td0 * SN, SN, L + O_VST + 32 * te_s * SN, SN, lane);
            mma<4>(S1t, L + O_KT + 32 * td1 * SN, SN, L + O_VST + 32 * te_s * SN, SN, lane);
            st_T(L + O_ST + 32 * te_s * SW + 32 * td0 * 2, SW, S0t, lane); st_T(L + O_ST + 32 * te_s * SW + 32 * td1 * 2, SW, S1t, lane); }
        __syncthreads();
    }
#undef GDN_LOAD
    int tid2 = tid0, w = w0; asm volatile("" : "+v"(tid2)); asm volatile("" : "+s"(w));
    const int lane = tid2 & 63, hi = lane >> 5, c31 = lane & 31, te_s = w & 3, td0 = w >> 2, td1 = 2 + (w >> 2);
    if (!lat) { float* so = F.out + OUT_ST + ((((size_t)b * DEPTH + l) * 2 + dir) * HG + h) * (size_t)(DKV * DKV);
        float* p0 = so + (32 * td0 + 4 * hi) * DKV + 32 * te_s + c31; float* p1 = so + (32 * td1 + 4 * hi) * DKV + 32 * te_s + c31;
#pragma unroll
        for (int rg = 0; rg < 4; ++rg) {
#pragma unroll
            for (int x = 0; x < 4; ++x) { p0[(8 * rg + x) * DKV] = S0t[4 * rg + x]; p1[(8 * rg + x) * DKV] = S1t[4 * rg + x]; }
            asm volatile("" ::: "memory"); } }
}
__device__ __forceinline__ void phase(ARGS_T& A, Frame& F, int l) {
    if (F.G > 2 * NCHAIN_LAT) { if (F.bx < NCHAIN_LAT) chain(A, F, l, F.bx); else for (int c = NCHAIN_LAT + (F.bx - NCHAIN_LAT); c < NCHAIN; c += F.G - NCHAIN_LAT) chain(A, F, l, c); }
    else for (int c = F.bx; c < NCHAIN; c += F.G) chain(A, F, l, c);
}
}

constexpr int PH_PER_LAYER = 10, N_PHASES = 2 + DEPTH * PH_PER_LAYER;
extern __shared__ __attribute__((aligned(16))) unsigned char lds[];
__device__ __forceinline__ void frame_init(Frame& F, ARGS_T& A) {
    F.lds = (LAS unsigned char*)lds; F.MISC = (volatile LAS unsigned*)(F.lds + MISC_OFF);
    F.tid = fresh_tid(); F.lane = F.tid & 63; F.wave = __builtin_amdgcn_readfirstlane(F.tid >> 6);
    F.G = gridDim.x; F.bx = fresh_bx(); F.vcu = (F.G % 8 == 0) ? (F.bx % 8) * (F.G / 8) + F.bx / 8 : F.bx;
    F.out = A.out; F.ws = A.ws; F.ctl = (gu32*)(A.ws + WS_CTL);
}
template <int LO, int HI>
__global__ void __launch_bounds__(NWAVES * 64, 2) trunk_fwd(Args args_unused) {
    { const int t0 = fresh_tid(); for (int u = t0; u < (LDS_BYTES - LDSCTL_OFF) / 4; u += NWAVES * 64) ((LAS unsigned*)((LAS unsigned char*)lds + LDSCTL_OFF))[u] = 0u; }
    __syncthreads();
    if (HI - LO > 1) { ARGS_T& A = *fresh_args(); (void)xcd_barrier_post((unsigned*)(A.ws + WS_CTL) + CW_BAR, (volatile LAS unsigned*)((LAS unsigned char*)lds + MISC_OFF) + 8); }
#define IN(k) (LO <= (k) && (k) < HI)
#define SEAM(k) do { if (IN(k) && IN((k) + 1)) { ARGS_T& A_ = *fresh_args(); XcdBarrier bar_; bar_.bar = (unsigned*)(A_.ws + WS_CTL) + CW_BAR; bar_.x = xb_xcc_id(); bar_.st = (volatile LAS unsigned*)((LAS unsigned char*)lds + MISC_OFF) + 8; xcd_barrier(bar_); } } while (0)
#define PHASE_BEGIN ARGS_T& A = *fresh_args(); Frame F; frame_init(F, A);

    if (IN(0)) { PHASE_BEGIN p0a_phase(A, F); } SEAM(0);
    if (IN(1)) { PHASE_BEGIN p0b_phase(A, F); } SEAM(1);
#pragma unroll
    for (int l = 0; l < DEPTH; ++l) {
        const int pb = 2 + l * PH_PER_LAYER;
        constexpr size_t MODL = 3 * 12288;
        if (IN(pb + 0)) { PHASE_BEGIN pg8::Gemm g{WSP(bf16, WS_H), WSP(bf16, WS_WIN) + (size_t)l * IN_WP * DM, M, IN_WP, DM}; pg8::StaticOrder S; S.init(M, IN_WP, F.G, F.bx);
            pg8::EpiBf16 E{WSP(bf16, WS_PROJ), IN_WP};
            pg8::gemm_phase<DM, pg8::EpiBf16, pg8::StaticOrder, true, true>(F.lds + RING_OFF, g, S, E); }
        SEAM(pb + 0);
        if (IN(pb + 1)) { PHASE_BEGIN prep_phase(A, F, l); } SEAM(pb + 1);
#if MK_GDN_REC
        if (IN(pb + 2)) { PHASE_BEGIN for (int it = F.bx; it < GDN_ITEMS; it += F.G) gdn_rec_item(A, F, l, it < 8 ? GDN_ITEMS_CTX + it : it - 8); }
#else
        if (IN(pb + 2)) { PHASE_BEGIN gdn::phase(A, F, l); }
#endif
        SEAM(pb + 2);
        if (IN(pb + 3)) { PHASE_BEGIN for (int it = F.bx; it < ATT_UNITS; it += F.G) attn_unit(F, it, (char*)lds + RING_OFF); }
        SEAM(pb + 3);
        if (IN(pb + 4)) { PHASE_BEGIN combine_phase(A, F, l); } SEAM(pb + 4);
        if (IN(pb + 5)) { PHASE_BEGIN pg8::Gemm g{WSP(bf16, WS_MIX), WSP(bf16, WS_WO) + (size_t)l * DM * DM, M, DM, DM}; pg8::StaticOrder S; S.init(M, DM, F.G, F.bx);
            const float* mod = WSP(float, WS_MOD) + (size_t)l * MODL;
            pg8::EpiResid E{l == 0 ? A.in[I_XP] : F.out, l == 0 ? A.in[I_XS] : F.out + (size_t)M_CTX * DM, F.out, mod + 2 * DM, DN_ALPHA};
            pg8::gemm_phase<DM, pg8::EpiResid, pg8::StaticOrder, true, true>(F.lds + RING_OFF, g, S, E); }
        SEAM(pb + 5);
        if (IN(pb + 6)) { PHASE_BEGIN const float* mod = WSP(float, WS_MOD) + (size_t)l * MODL; ln_phase(A, F, A.in[I_LN1G] + l * DM, A.in[I_LN1B] + l * DM, mod + 3 * DM, mod + 4 * DM, true); } SEAM(pb + 6);
        if (IN(pb + 7)) { PHASE_BEGIN pg8::Gemm g{WSP(bf16, WS_H), WSP(bf16, WS_WGU) + (size_t)l * 2 * DFF * DM, M, 2 * DFF, DM}; pg8::StaticOrder S; S.init(M, 2 * DFF, F.G, F.bx);
            pg8::EpiSwiGLU E{WSP(bf16, WS_PROJ), DFF};
            pg8::gemm_phase<DM, pg8::EpiSwiGLU, pg8::StaticOrder, true, true>(F.lds + RING_OFF, g, S, E); }
        SEAM(pb + 7);
        if (IN(pb + 8)) { PHASE_BEGIN pg8::Gemm g{WSP(bf16, WS_PROJ), WSP(bf16, WS_WD) + (size_t)l * DM * DFF, M, DM, DFF}; pg8::StaticOrder S; S.init(M, DM, F.G, F.bx);
            const float* mod = WSP(float, WS_MOD) + (size_t)l * MODL;
            pg8::EpiResid E{F.out, F.out + (size_t)M_CTX * DM, F.out, mod + 5 * DM, DN_ALPHA};
            pg8::gemm_phase<DFF, pg8::EpiResid, pg8::StaticOrder, true, true>(F.lds + RING_OFF, g, S, E); }
        SEAM(pb + 8);
        if (IN(pb + 9)) { PHASE_BEGIN const float* modn = WSP(float, WS_MOD) + (size_t)(l + 1) * MODL; ln_phase(A, F, A.in[I_LN2G] + l * DM, A.in[I_LN2B] + l * DM, modn, modn + DM, l + 1 < DEPTH); }
        if (l + 1 < DEPTH) SEAM(pb + 9);
    }
#undef IN
#undef SEAM
#undef PHASE_BEGIN
}

typedef void (*kfn_t)(Args);
template <int... P> static void fill_fns(kfn_t* f, std::integer_sequence<int, P...>) { ((f[P] = trunk_fwd<P, P + 1>), ...); }
extern "C" void kernel_launch(void* const* d_in, const int* in_sizes, int n_in, void* d_out, int out_size, void* d_ws, size_t ws_size, hipStream_t stream) {
    static int grid = 0; static kfn_t fns[N_PHASES + 1];
    if (grid == 0) {
        if (n_in != N_IN || in_sizes[I_XP] != M_CTX * DM || in_sizes[I_XS] != M_LAT * DM || (size_t)out_size != OUT_TOTAL || ws_size < WS_END) {
            fprintf(stderr, "kernel_launch: shape mismatch n_in %d out %d ws %zu (need %zu)\n", n_in, out_size, ws_size, (size_t)WS_END); grid = -1; return; }
        int dev = 0, cus = 0;
        if (hipGetDevice(&dev) != hipSuccess || hipDeviceGetAttribute(&cus, hipDeviceAttributeMultiprocessorCount, dev) != hipSuccess) { grid = -1; return; }
#if MK_PER_PHASE
        fill_fns(fns, std::make_integer_sequence<int, N_PHASES>{});
        for (int p = 0; p < N_PHASES; ++p)
            if (hipFuncSetAttribute((const void*)fns[p], hipFuncAttributeMaxDynamicSharedMemorySize, LDS_BYTES) != hipSuccess) { fprintf(stderr, "kernel_launch: hipFuncSetAttribute failed (phase %d)\n", p); grid = -1; return; }
#else
        fns[N_PHASES] = trunk_fwd<0, N_PHASES>;
        if (hipFuncSetAttribute((const void*)fns[N_PHASES], hipFuncAttributeMaxDynamicSharedMemorySize, LDS_BYTES) != hipSuccess) { fprintf(stderr, "kernel_launch: hipFuncSetAttribute failed\n"); grid = -1; return; }
#endif
        (void)hipGetLastError();
        grid = cus;
    }
    if (grid < 0) return;
    if (hipMemsetAsync((char*)d_ws + WS_CTL, 0, CTL_ZERO_BYTES, stream) != hipSuccess) { fprintf(stderr, "kernel_launch: hipMemsetAsync failed\n"); return; }
    Args a{};
    for (int i = 0; i < N_IN; ++i) a.in[i] = (const float*)d_in[i];
    a.out = (float*)d_out; a.ws = (unsigned char*)d_ws;
#if MK_PER_PHASE
    for (int p = 0; p < N_PHASES; ++p) {
        hipLaunchKernelGGL(fns[p], dim3(grid), dim3(NWAVES * 64), LDS_BYTES, stream, a);
        const hipError_t le = hipPeekAtLastError(); if (le != hipSuccess) { fprintf(stderr, "kernel_launch: launch %d failed: %s\n", p, hipGetErrorName(le)); break; } }
#else
    hipLaunchKernelGGL(fns[N_PHASES], dim3(grid), dim3(NWAVES * 64), LDS_BYTES, stream, a);
    { const hipError_t le = hipPeekAtLastError(); if (le != hipSuccess) fprintf(stderr, "kernel_launch: launch failed: %s\n", hipGetErrorName(le)); }
#endif
}
```

```cpp
#include <hip/hip_runtime.h>
#include <hip/hip_bf16.h>
#include <cstdio>
#include <cstdint>
#include <cmath>
#include <utility>
namespace pg8 {
#define PG8_LAS __attribute__((address_space(3)))
typedef unsigned short bf16_t;
typedef short bf16x8 __attribute__((ext_vector_type(8)));
typedef float f32x4 __attribute__((ext_vector_type(4)));
typedef unsigned u32x4 __attribute__((ext_vector_type(4)));
constexpr int BM = 256, BK = 64, HALF = 128, HTB = HALF * BK * 2  , STAGE_BYTES = 8 * HTB, NXCD = 8, WGM = 8;

__host__ __device__ __forceinline__ int lds_byte(int r, int c) { const int st = (r >> 4) * 2 + (c >> 5), rr = r & 15, cc = c & 31, ob = rr * 64 + cc * 2; return st * 1024 + (ob ^ (((ob >> 9) & 1) << 5)); }
__host__ __device__ __forceinline__ void stage_rc(int b, int& R, int& C) { const int st = b / 1024, sb = b % 1024, swz = sb ^ (((sb >> 9) & 1) << 5); R = (st >> 1) * 16 + swz / 64; C = (st & 1) * 32 + (swz % 64) / 2; }
__host__ __device__ __forceinline__ int perm32(int rho) { const int n = rho >> 4, i = rho & 15; return 8 * (i >> 2) + 4 * n + (i & 3); }

struct Unit { int pm, pn; };
struct Gemm { const bf16_t* A; const bf16_t* Bt; int M, N, K; };

struct StaticOrder {
    int nM, nN, nwg, G, c;
    __host__ __device__ void init(int M, int N, int G_, int c_) { nM = M / BM; nN = N / BM; nwg = nM * nN; G = G_; c = c_; }
    __host__ __device__ bool next(int i, Unit& u) const {
        const long L = (long)i * G + c; if (L >= nwg) return false;
        int wgid = (int)L; { const int q = nwg / NXCD, r = nwg % NXCD, xcd = wgid % NXCD, off = wgid / NXCD; wgid = (xcd < r ? xcd * (q + 1) : r * (q + 1) + (xcd - r) * q) + off; }
        const int nig = WGM * nN, gid = wgid / nig, fm = gid * WGM, gsz = (nM - fm) < WGM ? (nM - fm) : WGM;
        u.pm = fm + ((wgid % nig) % gsz); u.pn = (wgid % nig) / gsz; return true;
    }
    __device__ __forceinline__ void a_ready(const Unit&) const {}
    __device__ __forceinline__ void done(const Unit&) const {}
};


__device__ __forceinline__ unsigned cvt_pk_bf16(float lo, float hi) { unsigned r; asm volatile("v_cvt_pk_bf16_f32 %0, %1, %2" : "=v"(r) : "v"(lo), "v"(hi)); return r; }
__device__ __forceinline__ float silu_f(float x) { return x * __builtin_amdgcn_rcpf(1.0f + __builtin_amdgcn_exp2f(-1.4426950408889634f * x)); }

struct EpiBf16 {
    static constexpr bool PERM = true, AFTER_DRAIN = false;
    bf16_t* O; int ldc;
    __device__ __forceinline__ void operator()(const f32x4 (&acc)[2][2][4][2], const Unit& u, int wr, int wc, int fr, int fq) const {
        const int row0 = u.pm * BM + wr * 64 + fr; const int col0 = u.pn * BM + wc * 32 + 8 * fq;
#pragma unroll
        for (int ai = 0; ai < 2; ++ai)
#pragma unroll
            for (int m = 0; m < 4; ++m) { bf16_t* rowp = O + (size_t)(row0 + ai * HALF + m * 16) * ldc + col0;
#pragma unroll
                for (int bj = 0; bj < 2; ++bj) { const f32x4 v0 = acc[ai][bj][m][0], v1 = acc[ai][bj][m][1];
                    u32x4 w; w.x = cvt_pk_bf16(v0[0], v0[1]); w.y = cvt_pk_bf16(v0[2], v0[3]); w.z = cvt_pk_bf16(v1[0], v1[1]); w.w = cvt_pk_bf16(v1[2], v1[3]);
                    *(u32x4*)(rowp + bj * HALF) = w; } }
    }
};
struct EpiSwiGLU {
    static constexpr bool PERM = true, AFTER_DRAIN = false;
    bf16_t* O; int ldc;
    __device__ __forceinline__ void operator()(const f32x4 (&acc)[2][2][4][2], const Unit& u, int wr, int wc, int fr, int fq) const {
        const int row0 = u.pm * BM + wr * 64 + fr; const int col0 = u.pn * HALF + wc * 32 + 8 * fq;
#pragma unroll
        for (int ai = 0; ai < 2; ++ai)
#pragma unroll
            for (int m = 0; m < 4; ++m) { bf16_t* rowp = O + (size_t)(row0 + ai * HALF + m * 16) * ldc + col0;
                const f32x4 g0 = acc[ai][0][m][0], g1 = acc[ai][0][m][1], u0 = acc[ai][1][m][0], u1 = acc[ai][1][m][1];
                u32x4 w;
                w.x = cvt_pk_bf16(silu_f(g0[0]) * u0[0], silu_f(g0[1]) * u0[1]); w.y = cvt_pk_bf16(silu_f(g0[2]) * u0[2], silu_f(g0[3]) * u0[3]);
                w.z = cvt_pk_bf16(silu_f(g1[0]) * u1[0], silu_f(g1[1]) * u1[1]); w.w = cvt_pk_bf16(silu_f(g1[2]) * u1[2], silu_f(g1[3]) * u1[3]);
                *(u32x4*)rowp = w; }
    }
};
struct EpiResid {
    static constexpr bool PERM = false, AFTER_DRAIN = false;
    const float* xp; const float* xs; float* X; const float* gate; float alpha;
    __device__ __forceinline__ void operator()(const f32x4 (&acc)[2][2][4][2], const Unit& u, int wr, int wc, int fr, int fq) const {
        const int col0 = u.pn * BM + wc * 32 + 4 * fq; const int ci = u.pm < 32 ? 0 : 1 + ((u.pm - 32) >> 2);
        f32x4 gv[2][2];
#pragma unroll
        for (int bj = 0; bj < 2; ++bj)
#pragma unroll
            for (int n = 0; n < 2; ++n) gv[bj][n] = *(const f32x4*)(gate + (size_t)ci * 12288 + col0 + bj * HALF + n * 16);
#pragma unroll
        for (int ai = 0; ai < 2; ++ai)
#pragma unroll
            for (int m = 0; m < 4; ++m) { const int row = u.pm * BM + ai * HALF + wr * 64 + m * 16 + fr;
                const float* src = (row < 8192 ? xp + (size_t)row * 2048 : xs + (size_t)(row - 8192) * 2048) + col0; float* dst = X + (size_t)row * 2048 + col0;
#pragma unroll
                for (int bj = 0; bj < 2; ++bj)
#pragma unroll
                    for (int n = 0; n < 2; ++n) { const f32x4 xin = *(const f32x4*)(src + bj * HALF + n * 16);
                        *(f32x4*)(dst + bj * HALF + n * 16) = xin * alpha + gv[bj][n] * acc[ai][bj][m][n]; } }
    }
};

template <int KK, class Epi, class Sched, bool ALIGN_EPI = false, bool SP2 = false>
__device__ __forceinline__ void gemm_phase(PG8_LAS unsigned char* lds, const Gemm g, const Sched& S, const Epi& E) {
    int tid_ = threadIdx.x; asm volatile("" : "+v"(tid_)); const int tid = tid_, wid = __builtin_amdgcn_readfirstlane(tid >> 6), lane = tid & 63, wr = wid >> 2, wc = wid & 3, fr = lane & 15, fq = lane >> 4;
    constexpr int K = KK, nt = K / BK;
    unsigned voffA[2], voffB[2];
#pragma unroll
    for (int i = 0; i < 2; ++i) { int R, C; stage_rc(tid * 16 + i * 8192, R, C); const int Rb = Epi::PERM ? ((R & ~31) + perm32(R & 31)) : R;
        voffA[i] = (unsigned)(R * K + C) * 2u; voffB[i] = (unsigned)(Rb * K + C) * 2u; }
    const size_t kstep = (size_t)(BK * 2);
    const size_t hstep = (size_t)HALF * K * 2;
    const size_t tstep = 2 * hstep;
    const unsigned ldsw = (unsigned)wid * 1024u;
    const int aoff = lds_byte(wr * 64 + fr, fq * 8), boff = lds_byte(wc * 32 + fr, fq * 8);
#define PG8_SA(b, h) (((b) * 2 + (h)) * HTB)
#define PG8_SB(b, h) ((4 + (b) * 2 + (h)) * HTB)
#define PG8_STAGE(bufoff, gbase, voff) do { _Pragma("unroll") for (int _i = 0; _i < 2; ++_i) \
        __builtin_amdgcn_global_load_lds((const unsigned*)((const char*)(gbase) + (voff)[_i]), (PG8_LAS unsigned*)(lds + (bufoff) + ldsw + _i * 8192), 16, 0, 0); } while (0)
#define PG8_LDA(dst, b, h) do { _Pragma("unroll") for (int m = 0; m < 4; ++m) _Pragma("unroll") for (int k = 0; k < 2; ++k) dst[m][k] = *(const PG8_LAS bf16x8*)(lds + PG8_SA(b, h) + aoff + m * 2048 + k * 1024); } while (0)
#define PG8_LDB(dst, b, h) do { _Pragma("unroll") for (int n = 0; n < 2; ++n) _Pragma("unroll") for (int k = 0; k < 2; ++k) dst[n][k] = *(const PG8_LAS bf16x8*)(lds + PG8_SB(b, h) + boff + n * 2048 + k * 1024); } while (0)
#define PG8_MMA(ai, bj, At, Bt) do { __builtin_amdgcn_s_setprio(1); _Pragma("unroll") for (int m = 0; m < 4; ++m) _Pragma("unroll") for (int n = 0; n < 2; ++n) _Pragma("unroll") for (int k = 0; k < 2; ++k) \
        acc[ai][bj][m][n] = __builtin_amdgcn_mfma_f32_16x16x32_bf16(Bt[n][k], At[m][k], acc[ai][bj][m][n], 0, 0, 0); __builtin_amdgcn_s_setprio(0); } while (0)
#define PG8_WAIT_V(n) asm volatile("s_waitcnt vmcnt(" #n ")" ::: "memory")
#define PG8_WAIT_L(n) asm volatile("s_waitcnt lgkmcnt(" #n ")" ::: "memory")
#define PG8_BAR __builtin_amdgcn_s_barrier()
#define PG8_SCHED __builtin_amdgcn_sched_barrier(0)
    Unit cur, nxt; int ui = 0;
    if (!S.next(0, cur)) return;
    f32x4 acc[2][2][4][2];
#pragma unroll
    for (int a = 0; a < 2; ++a)
#pragma unroll
        for (int b = 0; b < 2; ++b)
#pragma unroll
            for (int m = 0; m < 4; ++m)
#pragma unroll
                for (int n = 0; n < 2; ++n) acc[a][b][m][n] = (f32x4){0.f, 0.f, 0.f, 0.f};
    bf16x8 At[4][2], B0[2][2], B1[2][2];
    const char* cA = (const char*)g.A + (size_t)cur.pm * tstep; const char* cB = (const char*)g.Bt + (size_t)cur.pn * tstep;
    S.a_ready(cur);
    if constexpr (SP2) {
        PG8_STAGE(PG8_SB(0, 0), cB, voffB); PG8_STAGE(PG8_SB(0, 1), cB + hstep, voffB); PG8_STAGE(PG8_SA(0, 0), cA, voffA); PG8_STAGE(PG8_SA(0, 1), cA + hstep, voffA);
        if (wr == 1) PG8_BAR;
        PG8_WAIT_V(2); PG8_BAR;
        PG8_STAGE(PG8_SB(1, 0), cB + kstep, voffB); PG8_STAGE(PG8_SA(1, 0), cA + kstep, voffA); PG8_STAGE(PG8_SB(1, 1), cB + hstep + kstep, voffB);
        PG8_WAIT_V(6); PG8_BAR;
    } else {
        PG8_STAGE(PG8_SB(0, 0), cB, voffB); PG8_STAGE(PG8_SA(0, 0), cA, voffA); PG8_STAGE(PG8_SB(0, 1), cB + hstep, voffB); PG8_STAGE(PG8_SA(0, 1), cA + hstep, voffA);
        if (wr == 1) PG8_BAR;
        PG8_WAIT_V(4); PG8_BAR;
        PG8_STAGE(PG8_SB(1, 0), cB + kstep, voffB); PG8_STAGE(PG8_SA(1, 0), cA + kstep, voffA); PG8_STAGE(PG8_SB(1, 1), cB + hstep + kstep, voffB);
        PG8_WAIT_V(6); PG8_BAR;
    }
    for (;;) {
        const bool has_next = S.next(ui + 1, nxt);
        const char* nA = has_next ? (const char*)g.A + (size_t)nxt.pm * tstep : cA; const char* nB = has_next ? (const char*)g.Bt + (size_t)nxt.pn * tstep : cB;
        for (int t = 0; t < nt; t += 2) {
            const bool last = (t == nt - 2);
            const char* a1 = cA + (size_t)(t + 1) * kstep;
            const char* a2 = last ? nA : cA + (size_t)(t + 2) * kstep; const char* b2 = last ? nB : cB + (size_t)(t + 2) * kstep;
            const char* a3 = a2 + kstep; const char* b3 = b2 + kstep;
            if (last && has_next) S.a_ready(nxt);
            if constexpr (SP2) {
            PG8_LDB(B0, 0, 0); PG8_LDB(B1, 0, 1); PG8_SCHED; PG8_LDA(At, 0, 0); PG8_STAGE(PG8_SA(1, 1), a1 + hstep, voffA);
            PG8_WAIT_V(8); PG8_WAIT_L(0); PG8_BAR; PG8_MMA(0, 0, At, B0); PG8_MMA(0, 1, At, B1); PG8_BAR; PG8_SCHED;
            PG8_LDA(At, 0, 1); PG8_STAGE(PG8_SB(0, 0), b2, voffB); PG8_STAGE(PG8_SB(0, 1), b2 + hstep, voffB); PG8_STAGE(PG8_SA(0, 0), a2, voffA);
            PG8_WAIT_V(8); PG8_WAIT_L(0); PG8_BAR; PG8_MMA(1, 0, At, B0); PG8_MMA(1, 1, At, B1); PG8_BAR; PG8_SCHED;
            PG8_LDB(B0, 1, 0); PG8_LDB(B1, 1, 1); PG8_SCHED; PG8_LDA(At, 1, 0); PG8_STAGE(PG8_SA(0, 1), a2 + hstep, voffA);
            PG8_WAIT_V(8); PG8_WAIT_L(0); PG8_BAR; PG8_MMA(0, 0, At, B0); PG8_MMA(0, 1, At, B1); PG8_BAR; PG8_SCHED;
            PG8_LDA(At, 1, 1); PG8_STAGE(PG8_SB(1, 0), b3, voffB); PG8_STAGE(PG8_SB(1, 1), b3 + hstep, voffB); PG8_STAGE(PG8_SA(1, 0), a3, voffA);
            PG8_WAIT_V(8); PG8_WAIT_L(0); PG8_BAR; PG8_MMA(1, 0, At, B0); PG8_MMA(1, 1, At, B1); PG8_BAR; PG8_SCHED;
            } else {
            PG8_LDB(B0, 0, 0); PG8_SCHED; PG8_LDA(At, 0, 0); PG8_STAGE(PG8_SA(1, 1), a1 + hstep, voffA);
            PG8_WAIT_L(8); PG8_BAR; PG8_WAIT_L(0); PG8_MMA(0, 0, At, B0); PG8_BAR; PG8_SCHED;
            PG8_LDB(B1, 0, 1); PG8_STAGE(PG8_SB(0, 0), b2, voffB);
            PG8_BAR; PG8_WAIT_L(0); PG8_MMA(0, 1, At, B1); PG8_BAR;
            PG8_LDA(At, 0, 1); PG8_STAGE(PG8_SA(0, 0), a2, voffA);
            PG8_BAR; PG8_WAIT_L(0); PG8_MMA(1, 0, At, B0); PG8_BAR; PG8_SCHED;
            PG8_STAGE(PG8_SB(0, 1), b2 + hstep, voffB);
            PG8_WAIT_V(6); PG8_BAR; PG8_MMA(1, 1, At, B1); PG8_BAR;
            PG8_LDB(B0, 1, 0); PG8_SCHED; PG8_LDA(At, 1, 0); PG8_STAGE(PG8_SA(0, 1), a2 + hstep, voffA);
            PG8_WAIT_L(8); PG8_BAR; PG8_WAIT_L(0); PG8_MMA(0, 0, At, B0); PG8_BAR; PG8_SCHED;
            PG8_LDB(B1, 1, 1); PG8_STAGE(PG8_SB(1, 0), b3, voffB);
            PG8_BAR; PG8_WAIT_L(0); PG8_MMA(0, 1, At, B1); PG8_BAR;
            PG8_LDA(At, 1, 1); PG8_STAGE(PG8_SA(1, 0), a3, voffA);
            PG8_BAR; PG8_WAIT_L(0); PG8_MMA(1, 0, At, B0); PG8_BAR; PG8_SCHED;
            PG8_STAGE(PG8_SB(1, 1), b3 + hstep, voffB);
            PG8_WAIT_V(6); PG8_BAR; PG8_MMA(1, 1, At, B1); PG8_BAR;
            }
        }
        if constexpr (ALIGN_EPI) { if (wr == 0) PG8_BAR; }
        if constexpr (!Epi::AFTER_DRAIN) { E(acc, cur, wr, wc, fr, fq); S.done(cur); }
        if (!has_next) break;
#pragma unroll
        for (int a = 0; a < 2; ++a)
#pragma unroll
            for (int b = 0; b < 2; ++b)
#pragma unroll
                for (int m = 0; m < 4; ++m)
#pragma unroll
                    for (int n = 0; n < 2; ++n) acc[a][b][m][n] = (f32x4){0.f, 0.f, 0.f, 0.f};
        cur = nxt; cA = nA; cB = nB; ++ui;
        if constexpr (ALIGN_EPI) { if (wr == 1) PG8_BAR; }
    }
    PG8_WAIT_V(0);
    if constexpr (!ALIGN_EPI) { if (wr == 0) PG8_BAR; }
    PG8_BAR;
    if constexpr (Epi::AFTER_DRAIN) { E.fused(acc, cur, wr, wc, fr, fq, lds, wid, lane); S.done(cur); }
#undef PG8_SA
#undef PG8_SB
#undef PG8_STAGE
#undef PG8_LDA
#undef PG8_LDB
#undef PG8_MMA
#undef PG8_WAIT_V
#undef PG8_WAIT_L
#undef PG8_BAR
#undef PG8_SCHED
}
}

namespace att {
using bf16 = __hip_bfloat16;
constexpr int   D = 128, NW = 8, QBLK = 32, KVBLK = 64;
constexpr float SCALE = 0.088388347648318440f;
constexpr float THR = 8.f;
constexpr int SDEPTH = 2;
constexpr int LDQ = 1024, LDK = 256, LDO = 2048;
using bf16x8 = __attribute__((ext_vector_type(8))) short;
using s16x4  = __attribute__((ext_vector_type(4))) short;
using f32x16 = __attribute__((ext_vector_type(16))) float;
using f32x8  = __attribute__((ext_vector_type(8))) float;
using u32x4  = __attribute__((ext_vector_type(4))) unsigned;
constexpr size_t SHM_V = KVBLK * D * 2, SHM_K = KVBLK * D * 2, SHM_ATTN = 2 * SHM_V + 2 * SHM_K + NW * 64 * 4;
#define KSWZ(row, colB) ((row) * 256 + ((colB) ^ (((row) & 7) << 4)))
#define SBAR() __builtin_amdgcn_sched_barrier(0)
__device__ __forceinline__ int crow(int r, int hi) { return (r & 3) + 8 * (r >> 2) + 4 * hi; }
__device__ __forceinline__ unsigned cvtpk(float lo, float hi) {
  unsigned r; asm volatile("v_cvt_pk_bf16_f32 %0, %1, %2" : "=v"(r) : "v"(lo), "v"(hi)); return r;
}
template <typename TIn> struct Stage;
template <> struct Stage<bf16>  { using T = bf16x8;
  __device__ static __forceinline__ T ld8(const bf16* p) { return *reinterpret_cast<const bf16x8*>(p); }
  __device__ static __forceinline__ bf16x8 tobf(T x) { return x; } };
template <> struct Stage<float> { using T = f32x8;
  __device__ static __forceinline__ T ld8(const float* p) { return *reinterpret_cast<const f32x8*>(p); }
  __device__ static __forceinline__ bf16x8 tobf(T x) {
    u32x4 w = {cvtpk(x[0], x[1]), cvtpk(x[2], x[3]), cvtpk(x[4], x[5]), cvtpk(x[6], x[7])}; return *reinterpret_cast<bf16x8*>(&w); } };

__device__ __forceinline__ void partialSM(f32x16& p0, f32x16& p1, float& m_reg, float& mn, float& alpha) {
  constexpr float C = SCALE * 1.4426950408889634f;
  float pmax = p0[0]; for (int r = 1; r < 16; ++r) pmax = fmaxf(pmax, p0[r]); for (int r = 0; r < 16; ++r) pmax = fmaxf(pmax, p1[r]);
  { auto rr = __builtin_amdgcn_permlane32_swap(__float_as_uint(pmax), __float_as_uint(pmax), false, false);
    pmax = fmaxf(__uint_as_float(rr[0]), __uint_as_float(rr[1])); }
  if (__builtin_expect(__all(pmax - m_reg <= THR / SCALE), 1)) { mn = m_reg; alpha = 1.f; }
  else { mn = fmaxf(m_reg, pmax); alpha = __builtin_amdgcn_exp2f((m_reg - mn) * C); m_reg = mn; }
  float mnC = -mn * C;
  for (int r = 0; r < 16; ++r) p0[r] = fmaf(p0[r], C, mnC); for (int r = 0; r < 16; ++r) p1[r] = fmaf(p1[r], C, mnC);
  for (int r = 0; r < 16; ++r) p0[r] = __builtin_amdgcn_exp2f(p0[r]);
}
__device__ __forceinline__ void finishSM(f32x16& p0, f32x16& p1, float alpha, float& l_reg, bf16x8& pa0, bf16x8& pa1, bf16x8& pa2, bf16x8& pa3) {
  for (int r = 0; r < 16; ++r) p1[r] = __builtin_amdgcn_exp2f(p1[r]);
  float ps = 0; for (int r = 0; r < 16; ++r) ps += p0[r]; for (int r = 0; r < 16; ++r) ps += p1[r];
  { auto rr = __builtin_amdgcn_permlane32_swap(__float_as_uint(ps), __float_as_uint(ps), false, false);
    ps = __uint_as_float(rr[0]) + __uint_as_float(rr[1]); }
  l_reg = l_reg * alpha + ps;
#define PK4(P, BASE, OUT) do { unsigned a0 = cvtpk(P[BASE + 0], P[BASE + 1]), a1 = cvtpk(P[BASE + 2], P[BASE + 3]);   \
    unsigned b0 = cvtpk(P[BASE + 4], P[BASE + 5]), b1 = cvtpk(P[BASE + 6], P[BASE + 7]);                              \
    auto r0 = __builtin_amdgcn_permlane32_swap(a0, b0, false, false); auto r1 = __builtin_amdgcn_permlane32_swap(a1, b1, false, false); \
    u32x4 w = {r0[0], r1[0], r0[1], r1[1]}; OUT = *reinterpret_cast<bf16x8*>(&w); } while (0)
  PK4(p0, 0, pa0); PK4(p0, 8, pa1); PK4(p1, 0, pa2); PK4(p1, 8, pa3);
#undef PK4
}
__device__ __forceinline__ void qkt(f32x16& p0, f32x16& p1, const bf16* Ks, const bf16x8* qr, int r32, int hi) {
  p0 = f32x16{}; p1 = f32x16{};
  for (int d0 = 0; d0 < 8; ++d0) { int cb = (d0 * 16 + hi * 8) * 2;
    bf16x8 b0 = *reinterpret_cast<const bf16x8*>((const char*)Ks + KSWZ(r32, cb));
    bf16x8 b1 = *reinterpret_cast<const bf16x8*>((const char*)Ks + KSWZ(32 + r32, cb));
    p0 = __builtin_amdgcn_mfma_f32_32x32x16_bf16(b0, qr[d0], p0, 0, 0, 0);
    p1 = __builtin_amdgcn_mfma_f32_32x32x16_bf16(b1, qr[d0], p1, 0, 0, 0); }
}
__device__ __forceinline__ int v_st(int k, int c) { const int kk = (k & ~0xC) | ((k & 4) << 1) | ((k & 8) >> 1); return ((kk >> 3) * 4 + (c >> 5)) * 512 + ((kk & 7) * 32 + (c & 31)) * 2; }
__device__ __forceinline__ int v_rd_base(int lane) { return ((lane & 3) << 3) | (((lane >> 2) & 3) << 6) | (((lane >> 4) & 1) << 5) | (((lane >> 5) & 1) << 8); }
constexpr int v_rd_off(int d0, int ks, int half) { return d0 * 512 + ks * 4096 + half * 2048; }
template <int OFF> __device__ __forceinline__ s16x4 tr_read(int vb) {
  s16x4 r; asm volatile("ds_read_b64_tr_b16 %0, %1 offset:%2" : "=&v"(r) : "v"(vb), "i"(OFF) : "memory"); return r;
}
template <int D0> __device__ __forceinline__ void pv_one(f32x16& od, int vb, bf16x8 pa0, bf16x8 pa1, bf16x8 pa2, bf16x8 pa3) {
  const s16x4 l0 = tr_read<v_rd_off(D0, 0, 0)>(vb), h0 = tr_read<v_rd_off(D0, 0, 1)>(vb), l1 = tr_read<v_rd_off(D0, 1, 0)>(vb), h1 = tr_read<v_rd_off(D0, 1, 1)>(vb);
  const s16x4 l2 = tr_read<v_rd_off(D0, 2, 0)>(vb), h2 = tr_read<v_rd_off(D0, 2, 1)>(vb), l3 = tr_read<v_rd_off(D0, 3, 0)>(vb), h3 = tr_read<v_rd_off(D0, 3, 1)>(vb);
  asm volatile("s_waitcnt lgkmcnt(0)" ::: "memory"); SBAR();
#define PK(L, H) (bf16x8){L[0], L[1], L[2], L[3], H[0], H[1], H[2], H[3]}
  od = __builtin_amdgcn_mfma_f32_32x32x16_bf16(pa0, PK(l0, h0), od, 0, 0, 0);
  od = __builtin_amdgcn_mfma_f32_32x32x16_bf16(pa1, PK(l1, h1), od, 0, 0, 0);
  od = __builtin_amdgcn_mfma_f32_32x32x16_bf16(pa2, PK(l2, h2), od, 0, 0, 0);
  od = __builtin_amdgcn_mfma_f32_32x32x16_bf16(pa3, PK(l3, h3), od, 0, 0, 0);
#undef PK
}
__device__ __forceinline__ void pv_d0(f32x16* o, int vb, bf16x8 pa0, bf16x8 pa1, bf16x8 pa2, bf16x8 pa3) {
  pv_one<0>(o[0], vb, pa0, pa1, pa2, pa3); pv_one<1>(o[1], vb, pa0, pa1, pa2, pa3); pv_one<2>(o[2], vb, pa0, pa1, pa2, pa3); pv_one<3>(o[3], vb, pa0, pa1, pa2, pa3);
}

template <typename TQ>
__device__ __forceinline__ void attn_dense_body(const TQ* __restrict__ Qb, const bf16* __restrict__ Kh, const bf16* __restrict__ Vh,
                                                bf16* __restrict__ Ob, int seq, char* lds) {
  using St = Stage<bf16>; using SQ = Stage<TQ>;
  int tid_ = threadIdx.x; asm volatile("" : "+v"(tid_)); const int tid = tid_, wid = tid >> 6, lane = tid & 63, r32 = lane & 31, hi = lane >> 5;
  bf16* V_lds = (bf16*)lds; bf16* K_lds = (bf16*)(lds + 2 * SHM_V);
  float* ws = (float*)(lds + 2 * SHM_V + 2 * SHM_K) + wid * 64; float* li_l = ws; float* al_l = ws + 32;
  float m_reg = -1e30f, l_reg = 0; f32x16 o[4] = {}; bf16x8 qr[8];
  const TQ* Qw = Qb + (long)(wid * QBLK + r32) * LDQ + hi * 8;
#pragma unroll
  for (int d0 = 0; d0 < 8; ++d0) qr[d0] = SQ::tobf(SQ::ld8(Qw + d0 * 16));
  const int sr = tid >> 4, sc = (tid & 15) * 8, vst0 = v_st(sr, sc), vst1 = v_st(32 + sr, sc);
  const int vb0 = (int)(uintptr_t)V_lds + v_rd_base(lane);
  struct { typename St::T vs0, vs1, ks0, ks1; } sr_[SDEPTH];
#define SLOAD(i, k0) do { sr_[i].vs0 = St::ld8(&Vh[(long)((k0) + sr) * LDK + sc]); sr_[i].vs1 = St::ld8(&Vh[(long)((k0) + 32 + sr) * LDK + sc]); \
    sr_[i].ks0 = St::ld8(&Kh[(long)((k0) + sr) * LDK + sc]); sr_[i].ks1 = St::ld8(&Kh[(long)((k0) + 32 + sr) * LDK + sc]); } while (0)
#define SWRITE(b, i) do { *(bf16x8*)((char*)V_lds + (b) * SHM_V + vst0) = St::tobf(sr_[i].vs0);          \
    *(bf16x8*)((char*)V_lds + (b) * SHM_V + vst1) = St::tobf(sr_[i].vs1); int kc = sc * 2;               \
    *(bf16x8*)((char*)K_lds + (b) * SHM_K + KSWZ(sr, kc)) = St::tobf(sr_[i].ks0);                       \
    *(bf16x8*)((char*)K_lds + (b) * SHM_K + KSWZ(32 + sr, kc)) = St::tobf(sr_[i].ks1); } while (0)
#define SWAIT() do { if constexpr (SDEPTH == 2) asm volatile("s_waitcnt vmcnt(4)" ::: "memory"); else asm volatile("s_waitcnt vmcnt(0)" ::: "memory"); } while (0)
#define RESC(a) do { if (__any((a) < 1.f)) { if (hi == 0) al_l[r32] = (a); asm volatile("s_waitcnt lgkmcnt(0)" ::: "memory"); \
    for (int d = 0; d < 4; ++d) for (int r = 0; r < 16; ++r) o[d][r] *= al_l[crow(r, hi)]; } } while (0)
  f32x16 pA0, pA1, pB0, pB1; float mnA, mnB, alA, alB; bf16x8 pa0, pa1, pa2, pa3; const int NT = seq / KVBLK;
  constexpr int SE = 0, SO = SDEPTH - 1;
  SLOAD(SE, 0); asm volatile("s_waitcnt vmcnt(0)" ::: "memory"); SWRITE(0, SE); __syncthreads();
  qkt(pA0, pA1, K_lds, qr, r32, hi); partialSM(pA0, pA1, m_reg, mnA, alA);
  SLOAD(SO, KVBLK); if constexpr (SDEPTH == 2) { if (2 < NT) SLOAD(SE, 2 * KVBLK); }
  SWAIT(); SWRITE(1, SO); __syncthreads();
  for (int j = 1; j + 1 < NT; j += 2) {
    SBAR(); qkt(pB0, pB1, (bf16*)((char*)K_lds + SHM_K), qr, r32, hi);
    finishSM(pA0, pA1, alA, l_reg, pa0, pa1, pa2, pa3); SBAR();
    SLOAD(SO, (j + SDEPTH) * KVBLK); SBAR();
    pv_d0(o, vb0, pa0, pa1, pa2, pa3); partialSM(pB0, pB1, m_reg, mnB, alB);
    __syncthreads(); SWAIT(); SWRITE(0, SE);
    RESC(alB); __syncthreads();
    SBAR(); qkt(pA0, pA1, K_lds, qr, r32, hi);
    finishSM(pB0, pB1, alB, l_reg, pa0, pa1, pa2, pa3); SBAR();
    if (SDEPTH == 1 || j + 3 < NT) SLOAD(SE, (j + 1 + SDEPTH) * KVBLK); SBAR();
    pv_d0(o, vb0 + (int)SHM_V, pa0, pa1, pa2, pa3); partialSM(pA0, pA1, m_reg, mnA, alA);
    __syncthreads(); SWAIT(); SWRITE(1, SO);
    RESC(alA); __syncthreads();
  }
  SBAR(); qkt(pB0, pB1, (bf16*)((char*)K_lds + SHM_K), qr, r32, hi);
  finishSM(pA0, pA1, alA, l_reg, pa0, pa1, pa2, pa3); SBAR();
  pv_d0(o, vb0, pa0, pa1, pa2, pa3); partialSM(pB0, pB1, m_reg, mnB, alB);
  __syncthreads(); RESC(alB);
  finishSM(pB0, pB1, alB, l_reg, pa0, pa1, pa2, pa3); SBAR();
  pv_d0(o, vb0 + (int)SHM_V, pa0, pa1, pa2, pa3);
  if (hi == 0) li_l[r32] = l_reg; asm volatile("s_waitcnt lgkmcnt(0)" ::: "memory");
  float rli[16];
#pragma unroll
  for (int r = 0; r < 16; ++r) rli[r] = __builtin_amdgcn_rcpf(li_l[crow(r, hi)]);
  bf16* Ow = Ob + (long)(wid * QBLK) * LDO;
#pragma unroll
  for (int r = 0; r < 16; ++r) { int orow = crow(r, hi);
    for (int d0 = 0; d0 < 4; ++d0) Ow[(long)orow * LDO + d0 * 32 + r32] = __float2bfloat16(o[d0][r] * rli[r]); }
#undef SLOAD
#undef SWRITE
#undef SWAIT
#undef RESC
}

}

#ifndef MK_PER_PHASE
#define MK_PER_PHASE 0
#endif
#ifndef MK_GDN_REC
#define MK_GDN_REC 0
#endif
#ifndef MK_DIAG
#define MK_DIAG 0
#endif
#ifndef MK_DIAG_A
#define MK_DIAG_A 0
#endif
#ifndef MK_DIAG_B
#define MK_DIAG_B 1
#endif
constexpr int NWAVES = 8;

constexpr int DM = 2048, NB_CTX = 32, SEQ = 256, DEPTH = 2, NB_LAT = 2, LSEQ = 1024, PAST = 512;
constexpr int M_CTX = NB_CTX * SEQ, M_LAT = NB_LAT * LSEQ, M = M_CTX + M_LAT;
constexpr int HG = 8, DKV = 128, GDN_W = 1024, NQ = 8, NKV = 2, HD = 128, ATT_W = 1024;
constexpr int QKV_W = 3072, IN_W = 5664, IN_WP = 5888, DFF = 5632, CONVK = 5;
constexpr int C_Z = 3072, C_B = 4096, C_A = 4112, C_AQ = 4128, C_AK = 5152, C_AV = 5408;
constexpr int KROWS = M_CTX + NB_LAT * (LSEQ + PAST);
constexpr float RMS_EPS = 1e-6f, LN_EPS = 1e-5f;
constexpr float DN_ALPHA = 1.4142135623730951f;
constexpr size_t OUT_YP = 0, OUT_YS = 16777216, OUT_CK = 20971520, OUT_CV = 25165824, OUT_ST = 29360128, OUT_TOTAL = 46137344;
enum { I_XP = 0, I_XS, I_CK, I_CV, I_ST, I_C, I_CCTX, I_WADA, I_BADA, I_WIN, I_CONVW, I_ALOG, I_DTB, I_GNW, I_QNW, I_KNW, I_WO, I_LN1G, I_LN1B, I_LN2G, I_LN2B, I_WGU, I_WD, N_IN };

constexpr size_t MiB = 1u << 20;
constexpr size_t WS_CTL = 0, CTL_ZERO_BYTES = 1 * MiB;
constexpr size_t WS_MOD = 1 * MiB;
constexpr size_t WS_WIN = 2 * MiB;
constexpr size_t WS_WO  = WS_WIN + (size_t)DEPTH * IN_WP * DM * 2;
constexpr size_t WS_WGU = WS_WO + (size_t)DEPTH * DM * DM * 2;
constexpr size_t WS_WD  = WS_WGU + (size_t)DEPTH * 2 * DFF * DM * 2;
constexpr size_t WS_H   = WS_WD + (size_t)DEPTH * DM * DFF * 2;
constexpr size_t WS_MIX = WS_H + (size_t)M * DM * 2;
constexpr size_t WS_PROJ = WS_MIX + (size_t)M * DM * 2;
constexpr size_t WS_QG  = WS_PROJ + (size_t)M * IN_WP * 2;
constexpr size_t WS_KG  = WS_QG + (size_t)M * GDN_W * 2;
constexpr size_t WS_VG  = WS_KG + (size_t)M * GDN_W * 2;
constexpr size_t WS_GG  = WS_VG + (size_t)M * GDN_W * 2;
constexpr size_t WS_BB  = WS_GG + (size_t)M * 16 * 4;
constexpr size_t WS_OF  = WS_BB + (size_t)M * 16 * 4;
constexpr size_t WS_OB  = WS_OF + (size_t)M * GDN_W * 4;
constexpr size_t WS_QA  = WS_OB + (size_t)M * GDN_W * 4;
constexpr size_t WS_KA  = WS_QA + (size_t)M * ATT_W * 2;
constexpr size_t WS_VA  = WS_KA + (size_t)KROWS * 256 * 2;
constexpr size_t WS_ROPE = WS_VA + (size_t)KROWS * 256 * 2;
constexpr size_t WS_END = WS_ROPE + (size_t)LSEQ * 64 * 16;
static_assert(WS_WIN % 256 == 0 && WS_WO % 256 == 0 && WS_WGU % 256 == 0 && WS_WD % 256 == 0 && WS_H % 256 == 0 && WS_MIX % 256 == 0 && WS_PROJ % 256 == 0 && WS_QG % 256 == 0 && WS_GG % 256 == 0 && WS_OF % 256 == 0 && WS_QA % 256 == 0 && WS_KA % 256 == 0 && WS_VA % 256 == 0, "ws alignment");
static_assert(WS_MOD + (size_t)DEPTH * 3 * 12288 * 4 <= WS_WIN, "mod table");
constexpr int CW_TMO = 0, CW_CODE = 1, CW_BAR = 4096;

constexpr int RING_OFF = 0, RING_BYTES = 131072;
constexpr int LDS_BYTES = 163840;
constexpr int LDSCTL_OFF = LDS_BYTES - 512, MISC_OFF = LDSCTL_OFF + 320;

#define GAS __attribute__((address_space(1)))
#define LAS __attribute__((address_space(3)))
typedef unsigned short bf16;
typedef unsigned v4u __attribute__((ext_vector_type(4)));
typedef unsigned v2u __attribute__((ext_vector_type(2)));
typedef float f32x4 __attribute__((ext_vector_type(4)));
typedef float f32x2 __attribute__((ext_vector_type(2)));
typedef GAS unsigned gu32;
#define RLX_AGENT __ATOMIC_RELAXED, __HIP_MEMORY_SCOPE_AGENT
#define LDS_WAIT() asm volatile("s_waitcnt lgkmcnt(0)" ::: "memory")
#define VM_WAIT() asm volatile("s_waitcnt vmcnt(0)" ::: "memory")
__device__ __forceinline__ unsigned f2bf(float f) { unsigned u = __builtin_bit_cast(unsigned, f); return (u + 0x7fffu + ((u >> 16) & 1u)) >> 16; }
__device__ __forceinline__ unsigned pk2(float lo, float hi) { return f2bf(lo) | (f2bf(hi) << 16); }
__device__ __forceinline__ float bf_lo(unsigned w) { return __builtin_bit_cast(float, w << 16); }
__device__ __forceinline__ float bf_hi(unsigned w) { return __builtin_bit_cast(float, w & 0xffff0000u); }
__device__ __forceinline__ float bf1(bf16 h) { return __builtin_bit_cast(float, (unsigned)h << 16); }
template <int CTRL> __device__ __forceinline__ float dppf(float v) { return __builtin_bit_cast(float, __builtin_amdgcn_update_dpp(0, __builtin_bit_cast(int, v), CTRL, 0xF, 0xF, true)); }
__device__ __forceinline__ float wave_sum(float v) {
    v += dppf<0xB1>(v);
    v += dppf<0x4E>(v);
    v += dppf<0x141>(v);
    v += dppf<0x140>(v);
    return ((__builtin_bit_cast(float, __builtin_amdgcn_readlane(__builtin_bit_cast(int, v), 15)) + __builtin_bit_cast(float, __builtin_amdgcn_readlane(__builtin_bit_cast(int, v), 31))) +
            (__builtin_bit_cast(float, __builtin_amdgcn_readlane(__builtin_bit_cast(int, v), 47)) + __builtin_bit_cast(float, __builtin_amdgcn_readlane(__builtin_bit_cast(int, v), 63))));
}
__device__ __forceinline__ float frcp(float x) { return __builtin_amdgcn_rcpf(x); }
__device__ __forceinline__ float frsq(float x) { return __builtin_amdgcn_rsqf(x); }
__device__ __forceinline__ float fexp(float x) { return __builtin_amdgcn_exp2f(1.4426950408889634f * x); }
__device__ __forceinline__ float silu(float x) { return x * frcp(1.0f + fexp(-x)); }
#define XB_TMO      128
#define XB_XCNT(j)  (256  + 64 * (j))
#define XB_XSUB(j)  (1280 + 64 * (j))
#define XB_XGEN(j)  (2304 + 64 * (j))
#define XB_TOP      3328
#define XB_TOPGEN   3392
#define XCD_BAR_WORDS 3456
#define XB_SPIN_CAP (1u << 18)

__device__ __forceinline__ unsigned xb_ld(unsigned* p)              { return __hip_atomic_load(p, __ATOMIC_RELAXED, __HIP_MEMORY_SCOPE_AGENT); }
__device__ __forceinline__ unsigned xb_add(unsigned* p, unsigned v) { return __hip_atomic_fetch_add(p, v, __ATOMIC_RELAXED, __HIP_MEMORY_SCOPE_AGENT); }
__device__ __forceinline__ unsigned xb_xcc_id() { return (unsigned)__builtin_amdgcn_s_getreg((3 << 11) | 20) & 0xFu; }
#define XB_SPIN(cond, bar) do { unsigned _sp = 0; while (cond) { __builtin_amdgcn_s_sleep(1); \
    if ((++_sp & 255u) == 0u) { if (xb_ld(&(bar)[XB_TMO])) break; if (_sp > XB_SPIN_CAP) { atomicAdd(&(bar)[XB_TMO], 1u); break; } } } } while (0)

struct XcdBarrier {
    unsigned* bar; unsigned x;
    volatile LAS unsigned* st;
};

__device__ __forceinline__ XcdBarrier xcd_barrier_post(unsigned* bar, volatile LAS unsigned* st) {
    XcdBarrier b; b.bar = bar; b.x = xb_xcc_id(); b.st = st;
    if (threadIdx.x == 0) (void)xb_add(&bar[XB_XCNT(b.x)], 1u);
    return b;
}
__device__ __forceinline__ void xcd_barrier_complete(unsigned* bar, unsigned x, unsigned& nloc, unsigned& nx) {
    const unsigned G = gridDim.x * gridDim.y * gridDim.z;
    unsigned sum, cnt, mine, sp = 0u;
    for (;;) {
        sum = 0u; cnt = 0u; mine = 0u;
#pragma unroll
        for (unsigned j = 0; j < 16; ++j) { const unsigned c = xb_ld(&bar[XB_XCNT(j)]); sum += c; cnt += (c > 0u) ? 1u : 0u; mine = (j == x) ? c : mine; }
        if (sum == G) break;
        __builtin_amdgcn_s_sleep(1);
        if ((++sp & 255u) == 0u) { if (xb_ld(&bar[XB_TMO])) break; if (sp > XB_SPIN_CAP) { atomicAdd(&bar[XB_TMO], 1u); break; } }
    }
    nloc = mine > 0u ? mine : 1u; nx = cnt > 0u ? cnt : 1u;
}

__device__ __forceinline__ void xcd_barrier(const XcdBarrier& b) {
    asm volatile("s_waitcnt vmcnt(0)" ::: "memory");
    __syncthreads();
    if (threadIdx.x == 0) {
        unsigned* bar = b.bar;
        __builtin_amdgcn_s_waitcnt(0);
        unsigned nloc = b.st[0], nx = b.st[1];
        if (nloc == 0u) { xcd_barrier_complete(bar, b.x, nloc, nx); b.st[0] = nloc; b.st[1] = nx; }
        const unsigned old = xb_add(&bar[XB_XSUB(b.x)], 1u);
        const unsigned gen = old / nloc;
        if (old + 1u == (gen + 1u) * nloc) {
            __builtin_amdgcn_fence(__ATOMIC_RELEASE, "agent");
            asm volatile("s_waitcnt vmcnt(0)" ::: "memory");
            const unsigned og = xb_add(&bar[XB_TOP], 1u);
            const unsigned tg = og / nx;
            if (og + 1u == (tg + 1u) * nx) xb_add(&bar[XB_TOPGEN], 1u);
            else XB_SPIN(xb_ld(&bar[XB_TOPGEN]) == tg, bar);
            __builtin_amdgcn_fence(__ATOMIC_ACQUIRE, "agent");
            xb_add(&bar[XB_XGEN(b.x)], 1u);
            asm volatile("s_waitcnt vmcnt(0)" ::: "memory");
        } else {
            XB_SPIN(xb_ld(&bar[XB_XGEN(b.x)]) == gen, bar);
            __builtin_amdgcn_fence(__ATOMIC_ACQUIRE, "agent");
            asm volatile("s_waitcnt vmcnt(0)" ::: "memory");
        }
    }
    __syncthreads();
}

struct Args { const float* in[N_IN]; float* out; unsigned char* ws; int ph_lo, ph_hi; };
static_assert(sizeof(Args) == 8 * (N_IN + 2) + 8, "Args has no padding");
#define CAS __attribute__((address_space(4)))
#define ARGS_T const CAS Args
__device__ __forceinline__ ARGS_T* fresh_args() { const CAS char* p = (const CAS char*)__builtin_amdgcn_kernarg_segment_ptr(); asm volatile("" : "+s"(p)); return (ARGS_T*)p; }
__device__ __forceinline__ int fresh_tid() { int t = threadIdx.x; asm volatile("" : "+v"(t)); return t; }
__device__ __forceinline__ int fresh_bx() { int b = blockIdx.x; asm volatile("" : "+s"(b)); return b; }

struct Frame {
    LAS unsigned char* lds;
    volatile LAS unsigned* MISC;
    gu32* ctl;
    int tid, lane, wave;
    int vcu, G, bx;
    float* out;
    unsigned char* ws;
};
#define WSP(T, off) ((T*)(F.ws + (off)))

__device__ __forceinline__ void p0_transpose_item(const float* W, int K, int N, bf16* WT, int k0, int n0, int drow0, LAS float* scr, int lane) {
#pragma unroll 8
    for (int i = 0; i < 32; ++i) { const int kk = 2 * i + (lane >> 5); scr[kk * 33 + (lane & 31)] = W[(size_t)(k0 + kk) * N + n0 + (lane & 31)]; }
    LDS_WAIT(); asm volatile("" ::: "memory");
    const int c = lane & 7;
#pragma unroll
    for (int j = 0; j < 4; ++j) { const int n = (lane >> 3) + 8 * j; const LAS float* s = scr + (8 * c) * 33 + n;
        v4u o; o.x = pk2(s[0 * 33], s[1 * 33]); o.y = pk2(s[2 * 33], s[3 * 33]); o.z = pk2(s[4 * 33], s[5 * 33]); o.w = pk2(s[6 * 33], s[7 * 33]);
        *(GAS v4u*)(WT + (size_t)(drow0 + n) * K + k0 + 8 * c) = o; }
    LDS_WAIT(); asm volatile("" ::: "memory");
}
__device__ __forceinline__ void p0a_phase(ARGS_T& A, Frame& F) {
    LAS float* sl = (LAS float*)(F.lds);
    LAS float* red = (LAS float*)(F.lds + 32768);
    for (int i = F.tid; i < 3 * DM; i += NWAVES * 64) { const int ci = i / DM, k = i % DM; const float c = ci == 0 ? A.in[I_CCTX][k] : A.in[I_C][(ci - 1) * DM + k]; sl[i] = silu(c); }
    __syncthreads();
    for (int grp = F.bx; grp < 256; grp += F.G) {
        const int l = grp >> 7, n0 = (grp & 127) * 96;
        const int cg = F.tid % 24, kg = F.tid / 24;
        float a[3][4];
#pragma unroll
        for (int ci = 0; ci < 3; ++ci)
#pragma unroll
            for (int j = 0; j < 4; ++j) a[ci][j] = 0.f;
        if (kg < 21) {
            const float* wp = A.in[I_WADA] + (size_t)l * DM * 12288 + n0 + 4 * cg;
#pragma unroll 4
            for (int k = kg; k < DM; k += 21) { const f32x4 w = *(const f32x4*)(wp + (size_t)k * 12288); const float s0 = sl[k], s1 = sl[DM + k], s2 = sl[2 * DM + k];
#pragma unroll
                for (int j = 0; j < 4; ++j) { a[0][j] += s0 * w[j]; a[1][j] += s1 * w[j]; a[2][j] += s2 * w[j]; } }
#pragma unroll
            for (int ci = 0; ci < 3; ++ci)
#pragma unroll
                for (int j = 0; j < 4; ++j) red[(kg * 24 + cg) * 12 + ci * 4 + j] = a[ci][j];
        }
        __syncthreads();
        if (F.tid < 288) { const int c2 = F.tid / 12, j = F.tid % 12, ci = j >> 2, cc = j & 3; float s = 0.f;
            for (int q = 0; q < 21; ++q) s += red[(q * 24 + c2) * 12 + j];
            const int n = n0 + 4 * c2 + cc;
            WSP(float, WS_MOD)[((size_t)l * 3 + ci) * 12288 + n] = s + A.in[I_BADA][(size_t)l * 12288 + n]; }
        __syncthreads();
    }
    LAS float* scr = (LAS float*)(F.lds + RING_OFF + F.wave * 16384);
    const int gw = F.vcu * NWAVES + F.wave, NGW = F.G * NWAVES;
    constexpr int I_IN = (DM / 64) * (IN_W / 32), I_O = (DM / 64) * (DM / 32), I_GU = (DM / 64) * (2 * DFF / 32), I_D = (DFF / 64) * (DM / 32), I_LAYER = I_IN + I_O + I_GU + I_D;
    for (int it = gw; it < DEPTH * I_LAYER; it += NGW) {
        const int l = it / I_LAYER; int r = it % I_LAYER;
        if (r < I_IN) { const int nblk = IN_W / 32, kb = r / nblk, nb = r % nblk;
            p0_transpose_item(A.in[I_WIN] + (size_t)l * DM * IN_W, DM, IN_W, WSP(bf16, WS_WIN) + (size_t)l * IN_WP * DM, 64 * kb, 32 * nb, 32 * nb, scr, F.lane); continue; } r -= I_IN;
        if (r < I_O) { const int nblk = DM / 32, kb = r / nblk, nb = r % nblk;
            p0_transpose_item(A.in[I_WO] + (size_t)l * DM * DM, DM, DM, WSP(bf16, WS_WO) + (size_t)l * DM * DM, 64 * kb, 32 * nb, 32 * nb, scr, F.lane); continue; } r -= I_O;
        if (r < I_GU) { const int nblk = 2 * DFF / 32, kb = r / nblk, nb = r % nblk, n0 = 32 * nb, s = n0 / DFF, j = n0 % DFF, p = j / 128, rr = j % 128;
            p0_transpose_item(A.in[I_WGU] + (size_t)l * DM * 2 * DFF, DM, 2 * DFF, WSP(bf16, WS_WGU) + (size_t)l * 2 * DFF * DM, 64 * kb, n0, 256 * p + 128 * s + rr, scr, F.lane); continue; } r -= I_GU;
        { const int nblk = DM / 32, kb = r / nblk, nb = r % nblk;
            p0_transpose_item(A.in[I_WD] + (size_t)l * DFF * DM, DFF, DM, WSP(bf16, WS_WD) + (size_t)l * DM * DFF, 64 * kb, 32 * nb, 32 * nb, scr, F.lane); }
    }
    { const int gt = F.vcu * NWAVES * 64 + F.tid, NGT = F.G * NWAVES * 64; constexpr int PADV = (IN_WP - IN_W) * DM * 2 / 16;
        for (int i = gt; i < DEPTH * PADV; i += NGT) { const int l = i / PADV, r = i % PADV; ((GAS v4u*)(WSP(bf16, WS_WIN) + (size_t)l * IN_WP * DM + (size_t)IN_W * DM))[r] = (v4u){0u, 0u, 0u, 0u}; } }
}

__device__ __forceinline__ int cond_of_row(int row) { return row < M_CTX ? 0 : 1 + ((row - M_CTX) >> 10); }
__device__ __forceinline__ void p0b_phase(ARGS_T& A, Frame& F) {
    const int gw = F.vcu * NWAVES + F.wave, NGW = F.G * NWAVES;
    for (int t = gw; t < LSEQ; t += NGW) { const int lane = F.lane; const float pos = (float)(lane < 32 ? (t >> 6) : (t & 63)); const int i0 = 2 * (lane & 15);
        const float f0 = powf(10000.f, -(float)(2 * i0) / 64.f), f1 = powf(10000.f, -(float)(2 * i0 + 2) / 64.f); float s0, c0, s1, c1;
        sincosf(pos * f0, &s0, &c0); sincosf(pos * f1, &s1, &c1);
        *(f32x4*)(WSP(float, WS_ROPE) + ((size_t)t * 64 + lane) * 4) = (f32x4){c0, s0, c1, s1}; }
    for (int row = gw; row < M; row += NGW) {
        const float* xr = row < M_CTX ? A.in[I_XP] + (size_t)row * DM : A.in[I_XS] + (size_t)(row - M_CTX) * DM;
        const float* mod = WSP(float, WS_MOD) + (size_t)cond_of_row(row) * 12288;
        GAS v2u* o8 = (GAS v2u*)(WSP(bf16, WS_H) + (size_t)row * DM) + F.lane;
#pragma unroll
        for (int j = 0; j < 8; ++j) { const int c = 4 * F.lane + 256 * j; const f32x4 x = *(const f32x4*)(xr + c), sh = *(const f32x4*)(mod + c), sc = *(const f32x4*)(mod + DM + c);
            const f32x4 h = x * (sc + 1.0f) + sh; o8[64 * j] = (v2u){pk2(h[0], h[1]), pk2(h[2], h[3])}; }
    }
}
__device__ __forceinline__ void ln_phase(ARGS_T& A, Frame& F, const float* lg, const float* lb, const float* modsh, const float* modsc, bool write_h) {
    const int gw = F.vcu * NWAVES + F.wave, NGW = F.G * NWAVES;
    float* X = F.out;
    for (int row = gw; row < M; row += NGW) {
        float* xr = X + (size_t)row * DM;
        f32x4 v[8]; float s = 0.f;
#pragma unroll
        for (int j = 0; j < 8; ++j) { v[j] = *(const f32x4*)(xr + 4 * F.lane + 256 * j); s += (v[j][0] + v[j][1]) + (v[j][2] + v[j][3]); }
        const float mean = wave_sum(s) * (1.f / DM); float s2 = 0.f;
#pragma unroll
        for (int j = 0; j < 8; ++j) { v[j] = v[j] - mean; s2 += (v[j][0] * v[j][0] + v[j][1] * v[j][1]) + (v[j][2] * v[j][2] + v[j][3] * v[j][3]); }
        const float rstd = frsq(wave_sum(s2) * (1.f / DM) + LN_EPS);
        const int ci = cond_of_row(row);
        GAS v2u* o8 = (GAS v2u*)(WSP(bf16, WS_H) + (size_t)row * DM) + F.lane;
#pragma unroll
        for (int j = 0; j < 8; ++j) { const int c = 4 * F.lane + 256 * j; const f32x4 g = *(const f32x4*)(lg + c), b = *(const f32x4*)(lb + c);
            const f32x4 y = v[j] * rstd * g + b; *(f32x4*)(xr + c) = y;
            if (write_h) { const f32x4 sh = *(const f32x4*)(modsh + (size_t)ci * 12288 + c), sc = *(const f32x4*)(modsc + (size_t)ci * 12288 + c);
                const f32x4 h = y * (sc + 1.0f) + sh; o8[64 * j] = (v2u){pk2(h[0], h[1]), pk2(h[2], h[3])}; } }
    }
}

__device__ __forceinline__ void prep_phase(ARGS_T& A, Frame& F, int l) {
    LAS float* cw = (LAS float*)(F.lds);
    { const float* cwg = A.in[I_CONVW] + (size_t)l * CONVK * QKV_W;
      for (int i = F.tid; i < CONVK * QKV_W / 4; i += NWAVES * 64) ((LAS f32x4*)cw)[i] = ((const f32x4*)cwg)[i]; }
    __syncthreads();
    const int gw = F.vcu * NWAVES + F.wave, NGW = F.G * NWAVES, lane = F.lane;
    const bf16* PROJ = WSP(bf16, WS_PROJ);
    for (int r = gw; r < NB_LAT * PAST; r += NGW) {
        const int b = r / PAST, j = r % PAST; const size_t src = ((size_t)(b * DEPTH + l) * PAST + j) * 256 + 4 * lane; const size_t krow = (size_t)M_CTX + (size_t)b * (LSEQ + PAST) + LSEQ + j;
        const f32x4 kv = *(const f32x4*)(A.in[I_CK] + src), vv = *(const f32x4*)(A.in[I_CV] + src);
        *(GAS v2u*)(WSP(bf16, WS_KA) + krow * 256 + 4 * lane) = (v2u){pk2(kv[0], kv[1]), pk2(kv[2], kv[3])};
        *(GAS v2u*)(WSP(bf16, WS_VA) + krow * 256 + 4 * lane) = (v2u){pk2(vv[0], vv[1]), pk2(vv[2], vv[3])}; }
    constexpr int RUN = 8, NRUN = M / RUN;
    const float sgn = (lane & 16) ? 1.f : -1.f;
    const f32x2 qw = *(const f32x2*)(A.in[I_QNW] + l * HD + 2 * lane), kw = *(const f32x2*)(A.in[I_KNW] + l * HD + 2 * lane);
    const float dtb = A.in[I_DTB][l * 16 + (lane & 15)], nealog = -fexp(A.in[I_ALOG][l * 16 + (lane & 15)]);
#define PREP_LOADROW(dst, tt) do { if ((tt) >= 0 && (tt) < T) { const bf16* pr_ = PROJ + (size_t)(seq0 + (tt)) * IN_WP + 1024 * part + 2 * lane; _Pragma("unroll") for (int i_ = 0; i_ < 8; ++i_) dst[i_] = *(const unsigned*)(pr_ + 128 * i_); } \
        else { _Pragma("unroll") for (int i_ = 0; i_ < 8; ++i_) dst[i_] = 0u; } } while (0)
#define PREP_LOADATT(dst, gb_, ga_, row_) do { const bf16* pr_ = PROJ + (size_t)(row_) * IN_WP; const int c0_ = part == 2 ? C_AK : C_AQ + 512 * part; _Pragma("unroll") for (int h_ = 0; h_ < 4; ++h_) dst[h_] = *(const unsigned*)(pr_ + c0_ + 128 * h_ + 2 * lane); \
        gb_ = pr_[C_B + (lane & 15)]; ga_ = pr_[C_A + (lane & 15)]; } while (0)
    for (int item = gw; item < 3 * NRUN; item += NGW) {
        const int part = item / NRUN, run = item % NRUN;
        const int rowb = run * RUN; const bool lat = rowb >= M_CTX;
        int seq0, tb, T, bidx;
        if (!lat) { seq0 = rowb & ~(SEQ - 1); tb = rowb & (SEQ - 1); T = SEQ; bidx = rowb >> 8; } else { const int r = rowb - M_CTX; seq0 = M_CTX + (r & ~(LSEQ - 1)); tb = r & (LSEQ - 1); T = LSEQ; bidx = r >> 10; }
        unsigned w0[8], w1[8], w2[8], w3[8], w4[8], nx[8], an[4]; bf16 gbn, gan;
        PREP_LOADROW(w0, tb - 2); PREP_LOADROW(w1, tb - 1); PREP_LOADROW(w2, tb); PREP_LOADROW(w3, tb + 1); PREP_LOADROW(w4, tb + 2);
        PREP_LOADATT(an, gbn, gan, rowb);
        bf16* gdst = (part == 0 ? WSP(bf16, WS_QG) : part == 1 ? WSP(bf16, WS_KG) : WSP(bf16, WS_VG)) + 2 * lane;
        const LAS float* cwp = cw + 1024 * part + 2 * lane;
#pragma unroll 1
        for (int tk = 0; tk < RUN; ++tk) {
            const int row = rowb + tk, t = tb + tk;
            unsigned ac[4]; const bf16 gbc = gbn, gac = gan;
#pragma unroll
            for (int h = 0; h < 4; ++h) ac[h] = an[h];
            if (tk + 1 < RUN) { PREP_LOADROW(nx, t + 3); PREP_LOADATT(an, gbn, gan, row + 1); }
#pragma unroll
            for (int i = 0; i < 8; ++i) { const LAS float* c = cwp + 128 * i;
                const f32x2 c0 = *(const LAS f32x2*)(c), c1 = *(const LAS f32x2*)(c + QKV_W), c2 = *(const LAS f32x2*)(c + 2 * QKV_W), c3 = *(const LAS f32x2*)(c + 3 * QKV_W), c4 = *(const LAS f32x2*)(c + 4 * QKV_W);
                float y0 = c0[0] * bf_lo(w0[i]) + c1[0] * bf_lo(w1[i]) + c2[0] * bf_lo(w2[i]) + c3[0] * bf_lo(w3[i]) + c4[0] * bf_lo(w4[i]);
                float y1 = c0[1] * bf_hi(w0[i]) + c1[1] * bf_hi(w1[i]) + c2[1] * bf_hi(w2[i]) + c3[1] * bf_hi(w3[i]) + c4[1] * bf_hi(w4[i]);
                y0 = silu(y0); y1 = silu(y1);
                if (part < 2) { const float ss = wave_sum(y0 * y0 + y1 * y1); float sc = frsq(ss + RMS_EPS); if (part == 0) sc *= 0.08838834764831845f; y0 *= sc; y1 *= sc; }
                *(GAS unsigned*)(gdst + (size_t)row * GDN_W + 128 * i) = pg8::cvt_pk_bf16(y0, y1); if ((i & 3) == 3) __builtin_amdgcn_sched_barrier(0); }
            const size_t krow = lat ? (size_t)M_CTX + (size_t)bidx * (LSEQ + PAST) + t : (size_t)row;
            float rc0 = 1.f, rs0 = 0.f, rc1 = 1.f, rs1 = 0.f;
            if (lat) { const f32x4 rt = *(const f32x4*)(WSP(float, WS_ROPE) + ((size_t)t * 64 + lane) * 4); rc0 = rt[0]; rs0 = rt[1]; rc1 = rt[2]; rs1 = rt[3]; }
            if (part < 2) {
#pragma unroll
                for (int h = 0; h < 4; ++h) { float x0 = bf_lo(ac[h]), x1 = bf_hi(ac[h]);
                    const float r = frsq(wave_sum(x0 * x0 + x1 * x1) * (1.f / HD) + RMS_EPS); x0 = x0 * r * qw[0]; x1 = x1 * r * qw[1];
                    if (lat) { const float o0 = __shfl_xor(x0, 16), o1 = __shfl_xor(x1, 16); x0 = x0 * rc0 + sgn * o0 * rs0; x1 = x1 * rc1 + sgn * o1 * rs1; }
                    *(GAS unsigned*)(WSP(bf16, WS_QA) + (size_t)row * ATT_W + 128 * (4 * part + h) + 2 * lane) = pg8::cvt_pk_bf16(x0, x1); }
            } else {
#pragma unroll
                for (int h = 0; h < 2; ++h) { float x0 = bf_lo(ac[h]), x1 = bf_hi(ac[h]);
                    const float r = frsq(wave_sum(x0 * x0 + x1 * x1) * (1.f / HD) + RMS_EPS); x0 = x0 * r * kw[0]; x1 = x1 * r * kw[1];
                    if (!lat) *(f32x2*)(F.out + OUT_CK + ((size_t)(bidx * DEPTH + l) * SEQ + t) * 256 + 128 * h + 2 * lane) = (f32x2){x0, x1};
                    else { const float o0 = __shfl_xor(x0, 16), o1 = __shfl_xor(x1, 16); x0 = x0 * rc0 + sgn * o0 * rs0; x1 = x1 * rc1 + sgn * o1 * rs1; }
                    *(GAS unsigned*)(WSP(bf16, WS_KA) + krow * 256 + 128 * h + 2 * lane) = pg8::cvt_pk_bf16(x0, x1); }
#pragma unroll
                for (int h = 0; h < 2; ++h) { const unsigned w = ac[2 + h];
                    *(GAS unsigned*)(WSP(bf16, WS_VA) + krow * 256 + 128 * h + 2 * lane) = w;
                    if (!lat) *(f32x2*)(F.out + OUT_CV + ((size_t)(bidx * DEPTH + l) * SEQ + t) * 256 + 128 * h + 2 * lane) = (f32x2){bf_lo(w), bf_hi(w)}; }
                if (lane < 16) { const float bv = bf1(gbc), av = bf1(gac) + dtb;
                    const float sp = fmaxf(av, 0.f) + __logf(1.f + fexp(-fabsf(av)));
                    WSP(float, WS_GG)[(size_t)row * 16 + lane] = nealog * sp;
                    WSP(float, WS_BB)[(size_t)row * 16 + lane] = frcp(1.f + fexp(-bv)); }
            }
#pragma unroll
            for (int i = 0; i < 8; ++i) { w0[i] = w1[i]; w1[i] = w2[i]; w2[i] = w3[i]; w3[i] = w4[i]; w4[i] = nx[i]; }
        }
    }
#undef PREP_LOADROW
#undef PREP_LOADATT
}

constexpr int GDN_ITEMS_CTX = NB_CTX * HG * 2 / 4, GDN_ITEMS = GDN_ITEMS_CTX + NB_LAT * HG * 2 / 4;
__device__ __forceinline__ void gdn_rec_item(ARGS_T& A, Frame& F, int l, int it) {
    const bool lat = it >= GDN_ITEMS_CTX; const int cbase = lat ? (it - GDN_ITEMS_CTX) * 4 : it * 4;
    const int slot = F.tid >> 7, e = F.tid & 127, c = cbase + slot, b = c >> 4, h = (c >> 1) & 7, dir = c & 1;
    const int T = lat ? LSEQ : SEQ, row0 = lat ? M_CTX + b * LSEQ : b * SEQ;
    float S[128];
    if (lat) { const float* s0 = A.in[I_ST] + ((((size_t)b * DEPTH + l) * 2 + dir) * HG + h) * (size_t)(DKV * DKV) + e;
#pragma unroll
        for (int d = 0; d < 128; ++d) S[d] = s0[(size_t)d * DKV]; }
    else {
#pragma unroll
        for (int d = 0; d < 128; ++d) S[d] = 0.f; }
    constexpr int NBS = 16, SLOTF = NBS * 384 + 64;
    LAS float* kq = (LAS float*)(F.lds) + slot * SLOTF;
    const bf16 *KG = WSP(bf16, WS_KG), *QG = WSP(bf16, WS_QG), *VG = WSP(bf16, WS_VG);
    float* OD = dir ? WSP(float, WS_OB) : WSP(float, WS_OF);
    for (int i0 = 0; i0 < T; i0 += NBS) {
        __syncthreads();
#pragma unroll 4
        for (int j = 0; j < NBS; ++j) { const int t = dir ? T - 1 - (i0 + j) : i0 + j; const size_t off = (size_t)(row0 + t) * GDN_W + h * 128 + e;
            kq[j * 384 + e] = bf1(KG[off]); kq[j * 384 + 128 + e] = bf1(QG[off]); kq[j * 384 + 256 + e] = bf1(VG[off]); }
        if (e < NBS) { const int t = dir ? T - 1 - (i0 + e) : i0 + e; const size_t off = (size_t)(row0 + t) * 16 + dir * 8 + h;
            kq[NBS * 384 + e] = WSP(float, WS_GG)[off]; kq[NBS * 384 + 16 + e] = WSP(float, WS_BB)[off]; }
        __syncthreads();
        for (int j = 0; j < NBS; ++j) {
            const LAS float* kp = kq + j * 384; const float decay = __expf(kq[NBS * 384 + j]), beta = kq[NBS * 384 + 16 + j], v = kp[256 + e];
            float kv0 = 0.f, kv1 = 0.f;
#pragma unroll
            for (int dc = 0; dc < 128; dc += 16) {
#pragma unroll
                for (int d = dc; d < dc + 16; d += 4) { const f32x4 k4 = *(const LAS f32x4*)(kp + d); kv0 += k4[0] * S[d] + k4[2] * S[d + 2]; kv1 += k4[1] * S[d + 1] + k4[3] * S[d + 3]; }
                __builtin_amdgcn_sched_barrier(0); }
            const float delta = beta * (v - decay * (kv0 + kv1));
            float o0 = 0.f, o1 = 0.f;
#pragma unroll
            for (int dc = 0; dc < 128; dc += 8) {
#pragma unroll
                for (int d = dc; d < dc + 8; d += 4) { const f32x4 k4 = *(const LAS f32x4*)(kp + d), q4 = *(const LAS f32x4*)(kp + 128 + d);
                    S[d] = decay * S[d] + k4[0] * delta; S[d + 1] = decay * S[d + 1] + k4[1] * delta; S[d + 2] = decay * S[d + 2] + k4[2] * delta; S[d + 3] = decay * S[d + 3] + k4[3] * delta;
                    o0 += q4[0] * S[d] + q4[2] * S[d + 2]; o1 += q4[1] * S[d + 1] + q4[3] * S[d + 3]; }
                __builtin_amdgcn_sched_barrier(0); }
            const int t = dir ? T - 1 - (i0 + j) : i0 + j;
            OD[(size_t)(row0 + t) * GDN_W + h * 128 + e] = o0 + o1;
        }
    }
    if (!lat) { float* so = F.out + OUT_ST + ((((size_t)b * DEPTH + l) * 2 + dir) * HG + h) * (size_t)(DKV * DKV) + e;
#pragma unroll
        for (int d = 0; d < 128; ++d) so[(size_t)d * DKV] = S[d]; }
    __syncthreads();
}
constexpr int ATT_UNITS_LAT = NB_LAT * NQ * (LSEQ / 256), ATT_UNITS = ATT_UNITS_LAT + NB_CTX * NQ;
__device__ __forceinline__ void attn_unit(Frame& F, int u, char* lds) {
    const att::bf16* QA = (const att::bf16*)WSP(bf16, WS_QA); const att::bf16* KA = (const att::bf16*)WSP(bf16, WS_KA); const att::bf16* VA = (const att::bf16*)WSP(bf16, WS_VA);
    att::bf16* MIX = (att::bf16*)WSP(bf16, WS_MIX);
    int qrow0, krow0, h, seq;
    if (u < ATT_UNITS_LAT) { const int b = u / (NQ * 4), r = u % (NQ * 4); h = r >> 2; const int qb = r & 3; qrow0 = M_CTX + b * LSEQ + qb * 256; krow0 = M_CTX + b * (LSEQ + PAST); seq = LSEQ + PAST; }
    else { const int v = u - ATT_UNITS_LAT, b = v >> 3; h = v & 7; qrow0 = b * SEQ; krow0 = b * SEQ; seq = SEQ; }
    const int kvh = h >> 2;
    att::attn_dense_body<att::bf16>(QA + (size_t)qrow0 * ATT_W + h * HD, KA + (size_t)krow0 * 256 + kvh * HD, VA + (size_t)krow0 * 256 + kvh * HD, MIX + (size_t)qrow0 * DM + GDN_W + h * HD, seq, lds);
    __syncthreads();
}
__device__ __forceinline__ void combine_phase(ARGS_T& A, Frame& F, int l) {
    const int gw = F.vcu * NWAVES + F.wave, NGW = F.G * NWAVES, lane = F.lane;
    const f32x2 nw = *(const f32x2*)(A.in[I_GNW] + l * DKV + 2 * lane);
    for (int row = gw; row < M; row += NGW) {
        const float* of = WSP(float, WS_OF) + (size_t)row * GDN_W + 2 * lane; const float* ob = WSP(float, WS_OB) + (size_t)row * GDN_W + 2 * lane;
        const bf16* z = WSP(bf16, WS_PROJ) + (size_t)row * IN_WP + C_Z + 2 * lane; bf16* mx = WSP(bf16, WS_MIX) + (size_t)row * DM + 2 * lane;
#pragma unroll
        for (int h = 0; h < HG; ++h) { const f32x2 a = *(const f32x2*)(of + 128 * h), b = *(const f32x2*)(ob + 128 * h); const float o0 = a[0] + b[0], o1 = a[1] + b[1];
            const float r = frsq(wave_sum(o0 * o0 + o1 * o1) * (1.f / DKV) + RMS_EPS); const unsigned zw = *(const unsigned*)(z + 128 * h);
            *(GAS unsigned*)(mx + 128 * h) = pk2(o0 * r * nw[0] * silu(bf_lo(zw)), o1 * r * nw[1] * silu(bf_hi(zw))); }
    }
}

namespace gdn {
typedef short bf16x8 __attribute__((ext_vector_type(8)));
typedef short s16x4 __attribute__((ext_vector_type(4)));
typedef float f32x16 __attribute__((ext_vector_type(16)));
constexpr int O_QR = 0, O_KR = 17408, O_KT = 34816, O_VT = 53248, O_ST = 71680, O_LR = 106496, O_LT = 115712, O_PR = 124928, O_AT = 134144, O_VEC = 143360, O_VTMP = 145408, O_END = 162816;
constexpr int O_WR = O_KR, O_VNT = O_VT, O_VST = O_LR;
constexpr int SW = 272, SN = 144;
constexpr int V_GC = 0, V_BE = 256, V_EGC = 512, V_BW = 768, V_SF = 1024, V_EG63 = 1280;
constexpr int NCHAIN_LAT = NB_LAT * HG * 2, NCHAIN = NCHAIN_LAT + NB_CTX * HG * 2;
static_assert(O_END + 512 <= LDS_BYTES && O_END <= LDSCTL_OFF, "gdn LDS map");

__device__ __forceinline__ int crow(int r, int hi) { return (r & 3) + 8 * (r >> 2) + 4 * hi; }
__device__ __forceinline__ unsigned cvt2(float lo, float hi) { return pg8::cvt_pk_bf16(lo, hi); }
template <int KS> __device__ __forceinline__ void mma(f32x16& acc, LAS const unsigned char* A, int sa, LAS const unsigned char* B, int sb, int lane) {
    LAS const unsigned char* pa = A + (lane & 31) * sa + (lane >> 5) * 16; LAS const unsigned char* pb = B + (lane & 31) * sb + (lane >> 5) * 16;
#pragma unroll
    for (int ks = 0; ks < KS; ++ks) { const bf16x8 a = *(LAS const bf16x8*)(pa + ks * 32), b = *(LAS const bf16x8*)(pb + ks * 32); acc = __builtin_amdgcn_mfma_f32_32x32x16_bf16(a, b, acc, 0, 0, 0);
        if ((ks & 3) == 3) __builtin_amdgcn_sched_barrier(0); }
}
template <int KS> __device__ __forceinline__ void ldfrag(bf16x8 (&f)[KS], LAS const unsigned char* A, int sa, int lane) {
    LAS const unsigned char* pa = A + (lane & 31) * sa + (lane >> 5) * 16;
#pragma unroll
    for (int ks = 0; ks < KS; ++ks) f[ks] = *(LAS const bf16x8*)(pa + ks * 32);
}
__device__ __forceinline__ void st_T(LAS unsigned char* dst, int sd, const f32x16& v, int lane) {
    LAS unsigned char* p = dst + (lane & 31) * sd + (lane >> 5) * 8;
#pragma unroll
    for (int rg = 0; rg < 4; ++rg) *(LAS v2u*)(p + rg * 16) = (v2u){cvt2(v[4 * rg], v[4 * rg + 1]), cvt2(v[4 * rg + 2], v[4 * rg + 3])};
}
__device__ __forceinline__ void st_R(LAS unsigned char* dst, int sd, const f32x16& v, int lane) {
    const int hi = lane >> 5; LAS unsigned char* p = dst + (lane & 31) * 2;
#pragma unroll
    for (int r = 0; r < 16; r += 2) { const unsigned w = cvt2(v[r], v[r + 1]);
        *(LAS unsigned short*)(p + crow(r, hi) * sd) = (unsigned short)(w & 0xffffu); *(LAS unsigned short*)(p + crow(r + 1, hi) * sd) = (unsigned short)(w >> 16); }
}
__device__ __forceinline__ void ldrow16(float (&o)[16], LAS const unsigned char* vec, int m0, int hi) {
#pragma unroll
    for (int rg = 0; rg < 4; ++rg) { const f32x4 t = *(LAS const f32x4*)(vec + 4 * (m0 + 8 * rg + 4 * hi)); o[4 * rg] = t[0]; o[4 * rg + 1] = t[1]; o[4 * rg + 2] = t[2]; o[4 * rg + 3] = t[3]; }
}

__device__ __forceinline__ void chain(ARGS_T& A, Frame& F, int l, int cid) {
    const bool lat = cid < NCHAIN_LAT; const int c2 = lat ? cid : cid - NCHAIN_LAT; const int b = c2 >> 4, h = (c2 >> 1) & 7, dir = c2 & 1;
    const int T = lat ? LSEQ : SEQ, NC = T / 64, row0 = lat ? M_CTX + b * LSEQ : b * SEQ;
    LAS unsigned char* L = F.lds; LAS unsigned char* VEC = L + O_VEC;
    const int tid0 = F.tid, w0 = F.wave;
    const bf16* QG = WSP(bf16, WS_QG) + h * 128; const bf16* KG = WSP(bf16, WS_KG) + h * 128; const bf16* VG = WSP(bf16, WS_VG) + h * 128;
    const float* GGp = WSP(float, WS_GG) + dir * 8 + h; const float* BBp = WSP(float, WS_BB) + dir * 8 + h;
    float* OD = (dir ? WSP(float, WS_OB) : WSP(float, WS_OF)) + h * 128;
    f32x16 S0t, S1t;
    { const int w = w0, lane = tid0 & 63, hi = lane >> 5, c31 = lane & 31, te_s = w & 3, td0 = w >> 2, td1 = 2 + (w >> 2);
    if (lat) { const float* s0 = A.in[I_ST] + ((((size_t)b * DEPTH + l) * 2 + dir) * HG + h) * (size_t)(DKV * DKV);
        const float* p0 = s0 + (32 * td0 + 4 * hi) * DKV + 32 * te_s + c31; const float* p1 = s0 + (32 * td1 + 4 * hi) * DKV + 32 * te_s + c31;
#pragma unroll
        for (int rg = 0; rg < 4; ++rg) {
#pragma unroll
            for (int x = 0; x < 4; ++x) { S0t[4 * rg + x] = p0[(8 * rg + x) * DKV]; S1t[4 * rg + x] = p1[(8 * rg + x) * DKV]; }
            asm volatile("" ::: "memory"); } }
    else {
#pragma unroll
        for (int r = 0; r < 16; ++r) { S0t[r] = 0.f; S1t[r] = 0.f; } }
    st_T(L + O_ST + 32 * te_s * SW + 32 * td0 * 2, SW, S0t, lane); st_T(L + O_ST + 32 * te_s * SW + 32 * td1 * 2, SW, S1t, lane); }
    v4u pq[2], pk[2], pv[2]; float pg = 0.f, pb = 0.f;
#define GDN_LOAD(c) do { _Pragma("unroll") for (int i_ = 0; i_ < 2; ++i_) { const int p_ = tid + 512 * i_, tl_ = 64 * (c) + (p_ >> 4), t_ = dir ? T - 1 - tl_ : tl_; const size_t off_ = (size_t)(row0 + t_) * GDN_W + 8 * (p_ & 15); \
        pq[i_] = *(const v4u*)(QG + off_); pk[i_] = *(const v4u*)(KG + off_); pv[i_] = *(const v4u*)(VG + off_); } \
        if (w == 0) { const int tl_ = 64 * (c) + lane, t_ = dir ? T - 1 - tl_ : tl_; pg = GGp[(size_t)(row0 + t_) * 16]; pb = BBp[(size_t)(row0 + t_) * 16]; } } while (0)
    { const int tid = tid0, w = w0, lane = tid0 & 63; GDN_LOAD(0); }
    for (int c = 0; c < NC; ++c) {
        int tid = tid0, w = w0; asm volatile("" : "+v"(tid)); asm volatile("" : "+s"(w));
        const int lane = tid & 63, hi = lane >> 5, c31 = lane & 31, te_s = w & 3, td0 = w >> 2, td1 = 2 + (w >> 2);
#pragma unroll
        for (int i = 0; i < 2; ++i) { const int p = tid + 512 * i, row = p >> 4, cb = p & 15;
            *(LAS v4u*)(L + O_QR + row * SW + cb * 16) = pq[i]; *(LAS v4u*)(L + O_KR + row * SW + cb * 16) = pk[i]; *(LAS v4u*)(L + O_VTMP + row * SW + cb * 16) = pv[i]; }
        if (w == 0) { float s = pg;
#pragma unroll
            for (int o = 1; o < 64; o <<= 1) { const float t = __shfl_up(s, o); if (lane >= o) s += t; }
            const float g63 = __shfl(s, 63), eg = __expf(s);
            *(LAS float*)(VEC + V_GC + 4 * lane) = s; *(LAS float*)(VEC + V_BE + 4 * lane) = pb; *(LAS float*)(VEC + V_EGC + 4 * lane) = eg; *(LAS float*)(VEC + V_BW + 4 * lane) = pb * eg;
            *(LAS float*)(VEC + V_SF + 4 * lane) = __expf(g63 - s); if (lane == 0) *(LAS float*)(VEC + V_EG63) = __expf(g63); }
        __syncthreads();
        if (c + 1 < NC) GDN_LOAD(c + 1);
#pragma unroll
        for (int n = 0; n < 4; ++n) { const int idx = 4 * n + (lane >> 4), rb = 2 * w + (idx >> 3), cbk = idx & 7, i16 = lane & 15, q = i16 >> 2, p = i16 & 3;
            const int so = (4 * rb + q) * SW + (16 * cbk + 4 * p) * 2, dof = (16 * cbk + i16) * SN + (4 * rb) * 2;
            const s16x4 kx = __builtin_bit_cast(s16x4, __builtin_amdgcn_ds_read_tr16_b64_v4i16((LAS s16x4*)(L + O_KR + so)));
            const s16x4 vx = __builtin_bit_cast(s16x4, __builtin_amdgcn_ds_read_tr16_b64_v4i16((LAS s16x4*)(L + O_VTMP + so)));
            *(LAS s16x4*)(L + O_KT + dof) = kx; *(LAS s16x4*)(L + O_VT + dof) = vx; }
        f32x16 Tt;
        constexpr int SB = 80;
        LAS unsigned char* W = L + O_LR + (w & 1) * 10240;
        LAS unsigned char* CRb = L + O_LR + 20480; LAS unsigned char* A32T = L + O_LR + 23040;
#pragma unroll
        for (int r = 0; r < 16; ++r) Tt[r] = 0.f;
        if (w < 3) {
            const int ti = (w == 0) ? 0 : 1, tj = (w == 1) ? 1 : 0; f32x16 acc;
#pragma unroll
            for (int r = 0; r < 16; ++r) acc[r] = 0.f;
            mma<8>(acc, L + O_KR + 32 * ti * SW, SW, L + O_KR + 32 * tj * SW, SW, lane);
            float gi[16], bi[16]; ldrow16(gi, VEC + V_GC, 32 * ti, hi); ldrow16(bi, VEC + V_BE, 32 * ti, hi);
            const float gj = *(LAS const float*)(VEC + V_GC + 4 * (32 * tj + c31)); const int j = 32 * tj + c31; f32x16 lv;
#pragma unroll
            for (int r = 0; r < 16; ++r) { const int i = 32 * ti + crow(r, hi); lv[r] = (i > j) ? bi[r] * acc[r] * __expf(gi[r] - gj) : 0.f; }
            if (w == 2) st_R(CRb, SB, lv, lane);
            else { const int jb = (lane >> 4) & 1; f32x16 ld, lo, z;
#pragma unroll
                for (int r = 0; r < 16; ++r) { const int ib = r >> 3; ld[r] = (ib == jb) ? lv[r] : 0.f; lo[r] = (ib == 1 && jb == 0) ? lv[r] : 0.f; Tt[r] = ((crow(r, hi) == c31) ? 1.f : 0.f) - ld[r]; }
                st_R(W, SB, ld, lane); st_T(W + 2560, SB, ld, lane); st_R(W + 5120, SB, Tt, lane); st_R(W + 7680, SB, lo, lane); LDS_WAIT();
#pragma unroll
                for (int r = 0; r < 16; ++r) z[r] = 0.f;
                mma<2>(z, W, SB, W + 2560, SB, lane); st_R(W, SB, z, lane); st_T(W + 2560, SB, z, lane); LDS_WAIT();
#pragma unroll
                for (int s2 = 0; s2 < 2; ++s2) { f32x16 z2;
#pragma unroll
                    for (int r = 0; r < 16; ++r) z2[r] = 0.f;
                    mma<2>(Tt, W + 5120, SB, W + 2560, SB, lane); mma<2>(z2, W, SB, W + 2560, SB, lane);
                    st_R(W + 5120, SB, Tt, lane); st_R(W, SB, z2, lane); st_T(W + 2560, SB, z2, lane); LDS_WAIT(); }
                mma<2>(Tt, W + 5120, SB, W + 2560, SB, lane); st_R(W + 5120, SB, Tt, lane); st_T(W + 2560, SB, Tt, lane); LDS_WAIT();
#pragma unroll
                for (int r = 0; r < 16; ++r) z[r] = 0.f;
                mma<2>(z, W + 7680, SB, W + 2560, SB, lane);
#pragma unroll
                for (int r = 0; r < 16; ++r) z[r] = -z[r];
                st_T(W, SB, z, lane); LDS_WAIT();
                mma<2>(Tt, W + 5120, SB, W, SB, lane);
                if (w == 0) st_T(A32T, SB, Tt, lane); else st_R(W + 5120, SB, Tt, lane); }
        } else if (w >= 4) { const int ti = (w >> 1) & 1, tj = w & 1; f32x16 acc;
#pragma unroll
            for (int r = 0; r < 16; ++r) acc[r] = 0.f;
            mma<8>(acc, L + O_QR + 32 * ti * SW, SW, L + O_KR + 32 * tj * SW, SW, lane);
            float gi[16]; ldrow16(gi, VEC + V_GC, 32 * ti, hi); const float gj = *(LAS const float*)(VEC + V_GC + 4 * (32 * tj + c31)); const int j = 32 * tj + c31; f32x16 av;
#pragma unroll
            for (int r = 0; r < 16; ++r) { const int i = 32 * ti + crow(r, hi); av[r] = (i >= j) ? acc[r] * __expf(gi[r] - gj) : 0.f; }
            st_R(L + O_AT + 32 * ti * SN + 32 * tj * 2, SN, av, lane); }
        __syncthreads();
        if (w == 2) { f32x16 y;
#pragma unroll
            for (int r = 0; r < 16; ++r) y[r] = 0.f;
            mma<2>(y, CRb, SB, A32T, SB, lane);
#pragma unroll
            for (int r = 0; r < 16; ++r) y[r] = -y[r];
            st_T(CRb, SB, y, lane); LDS_WAIT();
            mma<2>(Tt, L + O_LR + 10240 + 5120, SB, CRb, SB, lane); }
        __syncthreads();
        if (w < 4) { const int ti = (w == 0 || w == 3) ? 0 : 1, tj = (w == 1 || w == 3) ? 1 : 0;
            const float bj = *(LAS const float*)(VEC + V_BE + 4 * (32 * tj + c31)), bwj = *(LAS const float*)(VEC + V_BW + 4 * (32 * tj + c31)); f32x16 tu, tw;
#pragma unroll
            for (int r = 0; r < 16; ++r) { tu[r] = Tt[r] * bj; tw[r] = Tt[r] * bwj; }
            st_R(L + O_LR + 32 * ti * SN + 32 * tj * 2, SN, tu, lane); st_R(L + O_LR + 10240 + 32 * ti * SN + 32 * tj * 2, SN, tw, lane); }
        __syncthreads();
        const int ti = w >> 2, te = w & 3;
        f32x16 au, aw;
#pragma unroll
        for (int r = 0; r < 16; ++r) { au[r] = 0.f; aw[r] = 0.f; }
        mma<4>(au, L + O_LR + 32 * ti * SN, SN, L + O_VT + 32 * te * SN, SN, lane);
        mma<4>(aw, L + O_LR + 10240 + 32 * ti * SN, SN, L + O_KT + 32 * te * SN, SN, lane);
#pragma unroll
        for (int r = 0; r < 16; ++r) aw[r] = -aw[r];
        st_R(L + O_WR + 32 * ti * SW + 32 * te * 2, SW, aw, lane);
        __syncthreads();
        f32x16 aq;
#pragma unroll
        for (int r = 0; r < 16; ++r) aq[r] = 0.f;
        mma<8>(au, L + O_WR + 32 * ti * SW, SW, L + O_ST + 32 * te * SW, SW, lane);
        mma<8>(aq, L + O_QR + 32 * ti * SW, SW, L + O_ST + 32 * te * SW, SW, lane);
        { float sf[16]; ldrow16(sf, VEC + V_SF, 32 * ti, hi); f32x16 vs;
#pragma unroll
            for (int r = 0; r < 16; ++r) vs[r] = au[r] * sf[r];
            st_T(L + O_VNT + 32 * te * SN + 32 * ti * 2, SN, au, lane); st_T(L + O_VST + 32 * te * SN + 32 * ti * 2, SN, vs, lane); }
        __syncthreads();
        { float eg[16]; ldrow16(eg, VEC + V_EGC, 32 * ti, hi);
#pragma unroll
            for (int r = 0; r < 16; ++r) aq[r] *= eg[r];
            mma<4>(aq, L + O_AT + 32 * ti * SN, SN, L + O_VNT + 32 * te * SN, SN, lane);
#pragma unroll
            for (int r = 0; r < 16; ++r) { const int tl = 64 * c + 32 * ti + crow(r, hi), t = dir ? T - 1 - tl : tl; OD[(size_t)(row0 + t) * GDN_W + 32 * te + c31] = aq[r]; } }
        { const float e63 = *(LAS const float*)(VEC + V_EG63);
#pragma unroll
            for (int r = 0; r < 16; ++r) { S0t[r] *= e63; S1t[r] *= e63; }
            mma<4>(S0t, L + O_KT + 32 * td0 * SN, SN, L + O_VST + 32 * te_s * SN, SN, lane);
            mma<4>(S1t, L + O_KT + 32 * td1 * SN, SN, L + O_VST + 32 * te_s * SN, SN, lane);
            st_T(L + O_ST + 32 * te_s * SW + 32 * td0 * 2, SW, S0t, lane); st_T(L + O_ST + 32 * te_s * SW + 32 * td1 * 2, SW, S1t, lane); }
        __syncthreads();
    }
#undef GDN_LOAD
    int tid2 = tid0, w = w0; asm volatile("" : "+v"(tid2)); asm volatile("" : "+s"(w));
    const int lane = tid2 & 63, hi = lane >> 5, c31 = lane & 31, te_s = w & 3, td0 = w >> 2, td1 = 2 + (w >> 2);
    if (!lat) { float* so = F.out + OUT_ST + ((((size_t)b * DEPTH + l) * 2 + dir) * HG + h) * (size_t)(DKV * DKV);
        float* p0 = so + (32 * td0 + 4 * hi) * DKV + 32 * te_s + c31; float* p1 = so + (32 * td1 + 4 * hi) * DKV + 32 * te_s + c31;
#pragma unroll
        for (int rg = 0; rg < 4; ++rg) {
#pragma unroll
            for (int x = 0; x < 4; ++x) { p0[(8 * rg + x) * DKV] = S0t[4 * rg + x]; p1[(8 * rg + x) * DKV] = S1t[4 * rg + x]; }
            asm volatile("" ::: "memory"); } }
}
__device__ __forceinline__ void phase(ARGS_T& A, Frame& F, int l) {
    if (F.G > 2 * NCHAIN_LAT) { if (F.bx < NCHAIN_LAT) chain(A, F, l, F.bx); else for (int c = NCHAIN_LAT + (F.bx - NCHAIN_LAT); c < NCHAIN; c += F.G - NCHAIN_LAT) chain(A, F, l, c); }
    else for (int c = F.bx; c < NCHAIN; c += F.G) chain(A, F, l, c);
}
}

constexpr int PH_PER_LAYER = 10, N_PHASES = 2 + DEPTH * PH_PER_LAYER;
extern __shared__ __attribute__((aligned(16))) unsigned char lds[];
__device__ __forceinline__ void frame_init(Frame& F, ARGS_T& A) {
    F.lds = (LAS unsigned char*)lds; F.MISC = (volatile LAS unsigned*)(F.lds + MISC_OFF);
    F.tid = fresh_tid(); F.lane = F.tid & 63; F.wave = __builtin_amdgcn_readfirstlane(F.tid >> 6);
    F.G = gridDim.x; F.bx = fresh_bx(); F.vcu = (F.G % 8 == 0) ? (F.bx % 8) * (F.G / 8) + F.bx / 8 : F.bx;
    F.out = A.out; F.ws = A.ws; F.ctl = (gu32*)(A.ws + WS_CTL);
}
template <int LO, int HI>
__global__ void __launch_bounds__(NWAVES * 64, 2) trunk_fwd(Args args_unused) {
    { const int t0 = fresh_tid(); for (int u = t0; u < (LDS_BYTES - LDSCTL_OFF) / 4; u += NWAVES * 64) ((LAS unsigned*)((LAS unsigned char*)lds + LDSCTL_OFF))[u] = 0u; }
    __syncthreads();
    if (HI - LO > 1) { ARGS_T& A = *fresh_args(); (void)xcd_barrier_post((unsigned*)(A.ws + WS_CTL) + CW_BAR, (volatile LAS unsigned*)((LAS unsigned char*)lds + MISC_OFF) + 8); }
#define IN(k) (LO <= (k) && (k) < HI)
#define SEAM(k) do { if (IN(k) && IN((k) + 1)) { ARGS_T& A_ = *fresh_args(); XcdBarrier bar_; bar_.bar = (unsigned*)(A_.ws + WS_CTL) + CW_BAR; bar_.x = xb_xcc_id(); bar_.st = (volatile LAS unsigned*)((LAS unsigned char*)lds + MISC_OFF) + 8; xcd_barrier(bar_); } } while (0)
#define PHASE_BEGIN ARGS_T& A = *fresh_args(); Frame F; frame_init(F, A);
#if MK_DIAG
#define STAMP(k) do { if (blockIdx.x == 0 && threadIdx.x == 0) ((volatile LAS unsigned long long*)((LAS unsigned char*)lds + LDSCTL_OFF))[(k) + 1] = __builtin_amdgcn_s_memrealtime(); } while (0)
    if (blockIdx.x == 0 && threadIdx.x == 0) ((volatile LAS unsigned long long*)((LAS unsigned char*)lds + LDSCTL_OFF))[0] = __builtin_amdgcn_s_memrealtime();
#else
#define STAMP(k) do { } while (0)
#endif

    if (IN(0)) { PHASE_BEGIN p0a_phase(A, F); } SEAM(0); STAMP(0);
    if (IN(1)) { PHASE_BEGIN p0b_phase(A, F); } SEAM(1); STAMP(1);
#pragma unroll
    for (int l = 0; l < DEPTH; ++l) {
        const int pb = 2 + l * PH_PER_LAYER;
        constexpr size_t MODL = 3 * 12288;
        if (IN(pb + 0)) { PHASE_BEGIN pg8::Gemm g{WSP(bf16, WS_H), WSP(bf16, WS_WIN) + (size_t)l * IN_WP * DM, M, IN_WP, DM}; pg8::StaticOrder S; S.init(M, IN_WP, F.G, F.bx);
            pg8::EpiBf16 E{WSP(bf16, WS_PROJ), IN_WP};
            pg8::gemm_phase<DM, pg8::EpiBf16, pg8::StaticOrder, true, true>(F.lds + RING_OFF, g, S, E); }
        SEAM(pb + 0); STAMP(pb + 0);
        if (IN(pb + 1)) { PHASE_BEGIN prep_phase(A, F, l); } SEAM(pb + 1); STAMP(pb + 1);
#if MK_GDN_REC
        if (IN(pb + 2)) { PHASE_BEGIN for (int it = F.bx; it < GDN_ITEMS; it += F.G) gdn_rec_item(A, F, l, it < 8 ? GDN_ITEMS_CTX + it : it - 8); }
#else
        if (IN(pb + 2)) { PHASE_BEGIN gdn::phase(A, F, l); }
#endif
        SEAM(pb + 2); STAMP(pb + 2);
        if (IN(pb + 3)) { PHASE_BEGIN for (int it = F.bx; it < ATT_UNITS; it += F.G) attn_unit(F, it, (char*)lds + RING_OFF); }
        SEAM(pb + 3); STAMP(pb + 3);
        if (IN(pb + 4)) { PHASE_BEGIN combine_phase(A, F, l); } SEAM(pb + 4); STAMP(pb + 4);
        if (IN(pb + 5)) { PHASE_BEGIN pg8::Gemm g{WSP(bf16, WS_MIX), WSP(bf16, WS_WO) + (size_t)l * DM * DM, M, DM, DM}; pg8::StaticOrder S; S.init(M, DM, F.G, F.bx);
            const float* mod = WSP(float, WS_MOD) + (size_t)l * MODL;
            pg8::EpiResid E{l == 0 ? A.in[I_XP] : F.out, l == 0 ? A.in[I_XS] : F.out + (size_t)M_CTX * DM, F.out, mod + 2 * DM, DN_ALPHA};
            pg8::gemm_phase<DM, pg8::EpiResid, pg8::StaticOrder, true, true>(F.lds + RING_OFF, g, S, E); }
        SEAM(pb + 5); STAMP(pb + 5);
        if (IN(pb + 6)) { PHASE_BEGIN const float* mod = WSP(float, WS_MOD) + (size_t)l * MODL; ln_phase(A, F, A.in[I_LN1G] + l * DM, A.in[I_LN1B] + l * DM, mod + 3 * DM, mod + 4 * DM, true); } SEAM(pb + 6); STAMP(pb + 6);
        if (IN(pb + 7)) { PHASE_BEGIN pg8::Gemm g{WSP(bf16, WS_H), WSP(bf16, WS_WGU) + (size_t)l * 2 * DFF * DM, M, 2 * DFF, DM}; pg8::StaticOrder S; S.init(M, 2 * DFF, F.G, F.bx);
            pg8::EpiSwiGLU E{WSP(bf16, WS_PROJ), DFF};
            pg8::gemm_phase<DM, pg8::EpiSwiGLU, pg8::StaticOrder, true, true>(F.lds + RING_OFF, g, S, E); }
        SEAM(pb + 7); STAMP(pb + 7);
        if (IN(pb + 8)) { PHASE_BEGIN pg8::Gemm g{WSP(bf16, WS_PROJ), WSP(bf16, WS_WD) + (size_t)l * DM * DFF, M, DM, DFF}; pg8::StaticOrder S; S.init(M, DM, F.G, F.bx);
            const float* mod = WSP(float, WS_MOD) + (size_t)l * MODL;
            pg8::EpiResid E{F.out, F.out + (size_t)M_CTX * DM, F.out, mod + 5 * DM, DN_ALPHA};
            pg8::gemm_phase<DFF, pg8::EpiResid, pg8::StaticOrder, true, true>(F.lds + RING_OFF, g, S, E); }
        SEAM(pb + 8); STAMP(pb + 8);
        if (IN(pb + 9)) { PHASE_BEGIN const float* modn = WSP(float, WS_MOD) + (size_t)(l + 1) * MODL; ln_phase(A, F, A.in[I_LN2G] + l * DM, A.in[I_LN2B] + l * DM, modn, modn + DM, l + 1 < DEPTH); }
        if (l + 1 < DEPTH) SEAM(pb + 9);
        STAMP(pb + 9);
    }
#if MK_DIAG
    if (blockIdx.x == 0 && threadIdx.x == 0) {
        volatile LAS unsigned long long* st = (volatile LAS unsigned long long*)((LAS unsigned char*)lds + LDSCTL_OFF);
        unsigned long long tot = 0;
        for (int k = 0; k < N_PHASES; ++k) { const int ty = k < 2 ? k : 2 + (k - 2) % PH_PER_LAYER; if (ty == MK_DIAG_A || MK_DIAG_A == 99) tot += st[k + 1] - st[k]; }
        const unsigned long long t0 = __builtin_amdgcn_s_memrealtime();
        while (__builtin_amdgcn_s_memrealtime() - t0 < 4 * tot) __builtin_amdgcn_s_sleep(8);
    }
#endif
#undef IN
#undef SEAM
#undef PHASE_BEGIN
}

typedef void (*kfn_t)(Args);
template <int... P> static void fill_fns(kfn_t* f, std::integer_sequence<int, P...>) { ((f[P] = trunk_fwd<P, P + 1>), ...); }
extern "C" void kernel_launch(void* const* d_in, const int* in_sizes, int n_in, void* d_out, int out_size, void* d_ws, size_t ws_size, hipStream_t stream) {
    static int grid = 0; static kfn_t fns[N_PHASES + 1];
    if (grid == 0) {
        if (n_in != N_IN || in_sizes[I_XP] != M_CTX * DM || in_sizes[I_XS] != M_LAT * DM || (size_t)out_size != OUT_TOTAL || ws_size < WS_END) {
            fprintf(stderr, "kernel_launch: shape mismatch n_in %d out %d ws %zu (need %zu)\n", n_in, out_size, ws_size, (size_t)WS_END); grid = -1; return; }
        int dev = 0, cus = 0;
        if (hipGetDevice(&dev) != hipSuccess || hipDeviceGetAttribute(&cus, hipDeviceAttributeMultiprocessorCount, dev) != hipSuccess) { grid = -1; return; }
#if MK_PER_PHASE
        fill_fns(fns, std::make_integer_sequence<int, N_PHASES>{});
        for (int p = 0; p < N_PHASES; ++p)
            if (hipFuncSetAttribute((const void*)fns[p], hipFuncAttributeMaxDynamicSharedMemorySize, LDS_BYTES) != hipSuccess) { fprintf(stderr, "kernel_launch: hipFuncSetAttribute failed (phase %d)\n", p); grid = -1; return; }
#else
        fns[N_PHASES] = trunk_fwd<0, N_PHASES>;
        if (hipFuncSetAttribute((const void*)fns[N_PHASES], hipFuncAttributeMaxDynamicSharedMemorySize, LDS_BYTES) != hipSuccess) { fprintf(stderr, "kernel_launch: hipFuncSetAttribute failed\n"); grid = -1; return; }
#endif
        (void)hipGetLastError();
        grid = cus;
    }
    if (grid < 0) return;
    if (hipMemsetAsync((char*)d_ws + WS_CTL, 0, CTL_ZERO_BYTES, stream) != hipSuccess) { fprintf(stderr, "kernel_launch: hipMemsetAsync failed\n"); return; }
    Args a{};
    for (int i = 0; i < N_IN; ++i) a.in[i] = (const float*)d_in[i];
    a.out = (float*)d_out; a.ws = (unsigned char*)d_ws;
#if MK_PER_PHASE
    for (int p = 0; p < N_PHASES; ++p) {
        hipLaunchKernelGGL(fns[p], dim3(grid), dim3(NWAVES * 64), LDS_BYTES, stream, a);
        const hipError_t le = hipPeekAtLastError(); if (le != hipSuccess) { fprintf(stderr, "kernel_launch: launch %d failed: %s\n", p, hipGetErrorName(le)); break; } }
#else
    hipLaunchKernelGGL(fns[N_PHASES], dim3(grid), dim3(NWAVES * 64), LDS_BYTES, stream, a);
    { const hipError_t le = hipPeekAtLastError(); if (le != hipSuccess) fprintf(stderr, "kernel_launch: launch failed: %s\n", hipGetErrorName(le)); }
#endif
}
```

```cpp
#include <hip/hip_runtime.h>
#include <hip/hip_bf16.h>
#include <cstdio>
#include <cstdint>
#include <cmath>
#include <utility>
namespace pg8 {
#define PG8_LAS __attribute__((address_space(3)))
typedef unsigned short bf16_t;
typedef short bf16x8 __attribute__((ext_vector_type(8)));
typedef float f32x4 __attribute__((ext_vector_type(4)));
typedef unsigned u32x4 __attribute__((ext_vector_type(4)));
constexpr int BM = 256, BK = 64, HALF = 128, HTB = HALF * BK * 2  , STAGE_BYTES = 8 * HTB, NXCD = 8, WGM = 8;

__host__ __device__ __forceinline__ int lds_byte(int r, int c) { const int st = (r >> 4) * 2 + (c >> 5), rr = r & 15, cc = c & 31, ob = rr * 64 + cc * 2; return st * 1024 + (ob ^ (((ob >> 9) & 1) << 5)); }
__host__ __device__ __forceinline__ void stage_rc(int b, int& R, int& C) { const int st = b / 1024, sb = b % 1024, swz = sb ^ (((sb >> 9) & 1) << 5); R = (st >> 1) * 16 + swz / 64; C = (st & 1) * 32 + (swz % 64) / 2; }
__host__ __device__ __forceinline__ int perm32(int rho) { const int n = rho >> 4, i = rho & 15; return 8 * (i >> 2) + 4 * n + (i & 3); }

struct Unit { int pm, pn, k0, nt, sp; };
struct Gemm { const bf16_t* A; const bf16_t* Bt; int M, N, K; };

struct StaticOrder {
    int nM, nN, nwg, G, c, ntk;
    __host__ __device__ void init(int M, int N, int G_, int c_, int K) { nM = M / BM; nN = N / BM; nwg = nM * nN; G = G_; c = c_; ntk = K / BK; }
    __host__ __device__ bool next(int i, Unit& u) const {
        const long L = (long)i * G + c; if (L >= nwg) return false;
        int wgid = (int)L; { const int q = nwg / NXCD, r = nwg % NXCD, xcd = wgid % NXCD, off = wgid / NXCD; wgid = (xcd < r ? xcd * (q + 1) : r * (q + 1) + (xcd - r) * q) + off; }
        const int nig = WGM * nN, gid = wgid / nig, fm = gid * WGM, gsz = (nM - fm) < WGM ? (nM - fm) : WGM;
        u.pm = fm + ((wgid % nig) % gsz); u.pn = (wgid % nig) / gsz; u.k0 = 0; u.nt = ntk; u.sp = -1; return true;
    }
    __device__ __forceinline__ void a_ready(const Unit&) const {}
    __device__ __forceinline__ void done(const Unit&) const {}
};
struct TailOrder {
    int G, c, ntk;
    __host__ __device__ void init(int G_, int c_, int K) { G = G_; c = c_; ntk = K / BK; }
    __host__ __device__ bool next(int i, Unit& u) const {
        const int L = i * G + c; if (L >= 512) return false;
        const int f = L & 255, xcd = f & 7, idx = f >> 3;
        const bool whole = L < 256; const int q = ntk >> 2, sp = idx >> 3;
        u.pm = whole ? 4 * xcd + (idx & 3) : 32 + xcd; u.pn = whole ? (idx >> 2) : (idx & 7); u.sp = whole ? -1 : sp; u.nt = whole ? ntk : q; u.k0 = whole ? 0 : sp * q * BK;
        return true;
    }
    __device__ __forceinline__ void a_ready(const Unit&) const {}
    __device__ __forceinline__ void done(const Unit&) const {}
};


__device__ __forceinline__ unsigned cvt_pk_bf16(float lo, float hi) { unsigned r; asm volatile("v_cvt_pk_bf16_f32 %0, %1, %2" : "=v"(r) : "v"(lo), "v"(hi)); return r; }
__device__ __forceinline__ float silu_f(float x) { return x * __builtin_amdgcn_rcpf(1.0f + __builtin_amdgcn_exp2f(-1.4426950408889634f * x)); }

struct EpiBf16 {
    static constexpr bool PERM = true, AFTER_DRAIN = false;
    bf16_t* O; int ldc;
    __device__ __forceinline__ void operator()(const f32x4 (&acc)[2][2][4][2], const Unit& u, int wr, int wc, int fr, int fq) const {
        const int row0 = u.pm * BM + wr * 64 + fr; const int col0 = u.pn * BM + wc * 32 + 8 * fq;
#pragma unroll
        for (int ai = 0; ai < 2; ++ai)
#pragma unroll
            for (int m = 0; m < 4; ++m) { bf16_t* rowp = O + (size_t)(row0 + ai * HALF + m * 16) * ldc + col0;
#pragma unroll
                for (int bj = 0; bj < 2; ++bj) { const f32x4 v0 = acc[ai][bj][m][0], v1 = acc[ai][bj][m][1];
                    u32x4 w; w.x = cvt_pk_bf16(v0[0], v0[1]); w.y = cvt_pk_bf16(v0[2], v0[3]); w.z = cvt_pk_bf16(v1[0], v1[1]); w.w = cvt_pk_bf16(v1[2], v1[3]);
                    *(u32x4*)(rowp + bj * HALF) = w; } }
    }
};
struct EpiSwiGLU {
    static constexpr bool PERM = true, AFTER_DRAIN = false;
    bf16_t* O; int ldc;
    __device__ __forceinline__ void operator()(const f32x4 (&acc)[2][2][4][2], const Unit& u, int wr, int wc, int fr, int fq) const {
        const int row0 = u.pm * BM + wr * 64 + fr; const int col0 = u.pn * HALF + wc * 32 + 8 * fq;
#pragma unroll
        for (int ai = 0; ai < 2; ++ai)
#pragma unroll
            for (int m = 0; m < 4; ++m) { bf16_t* rowp = O + (size_t)(row0 + ai * HALF + m * 16) * ldc + col0;
                const f32x4 g0 = acc[ai][0][m][0], g1 = acc[ai][0][m][1], u0 = acc[ai][1][m][0], u1 = acc[ai][1][m][1];
                u32x4 w;
                w.x = cvt_pk_bf16(silu_f(g0[0]) * u0[0], silu_f(g0[1]) * u0[1]); w.y = cvt_pk_bf16(silu_f(g0[2]) * u0[2], silu_f(g0[3]) * u0[3]);
                w.z = cvt_pk_bf16(silu_f(g1[0]) * u1[0], silu_f(g1[1]) * u1[1]); w.w = cvt_pk_bf16(silu_f(g1[2]) * u1[2], silu_f(g1[3]) * u1[3]);
                *(u32x4*)rowp = w; }
    }
};
struct EpiResid {
    static constexpr bool PERM = false, AFTER_DRAIN = false;
    const float* xp; float* X; const float* gate; float alpha; float* part;
    __device__ __forceinline__ void operator()(const f32x4 (&acc)[2][2][4][2], const Unit& u, int wr, int wc, int fr, int fq) const {
        const int col0 = u.pn * BM + wc * 32 + 4 * fq;
        if (u.sp >= 0) {
#pragma unroll
            for (int ai = 0; ai < 2; ++ai)
#pragma unroll
                for (int m = 0; m < 4; ++m) { const int row = (u.pm - 32) * BM + ai * HALF + wr * 64 + m * 16 + fr; float* dst = part + ((size_t)u.sp * 2048 + row) * 2048 + col0;
#pragma unroll
                    for (int bj = 0; bj < 2; ++bj)
#pragma unroll
                        for (int n = 0; n < 2; ++n) *(f32x4*)(dst + bj * HALF + n * 16) = acc[ai][bj][m][n]; }
            return; }
        f32x4 gv[2][2];
#pragma unroll
        for (int bj = 0; bj < 2; ++bj)
#pragma unroll
            for (int n = 0; n < 2; ++n) gv[bj][n] = *(const f32x4*)(gate + col0 + bj * HALF + n * 16);
#pragma unroll
        for (int ai = 0; ai < 2; ++ai)
#pragma unroll
            for (int m = 0; m < 4; ++m) { const int row = u.pm * BM + ai * HALF + wr * 64 + m * 16 + fr;
                const float* src = xp + (size_t)row * 2048 + col0; float* dst = X + (size_t)row * 2048 + col0;
#pragma unroll
                for (int bj = 0; bj < 2; ++bj)
#pragma unroll
                    for (int n = 0; n < 2; ++n) { const f32x4 xin = *(const f32x4*)(src + bj * HALF + n * 16);
                        *(f32x4*)(dst + bj * HALF + n * 16) = xin * alpha + gv[bj][n] * acc[ai][bj][m][n]; } }
    }
};

template <int KK, class Epi, class Sched, bool ALIGN_EPI = false, bool SP2 = false>
__device__ __forceinline__ void gemm_phase(PG8_LAS unsigned char* lds, const Gemm g, const Sched& S, const Epi& E) {
    int tid_ = threadIdx.x; asm volatile("" : "+v"(tid_)); const int tid = tid_, wid = __builtin_amdgcn_readfirstlane(tid >> 6), lane = tid & 63, wr = wid >> 2, wc = wid & 3, fr = lane & 15, fq = lane >> 4;
    constexpr int K = KK;
    unsigned voffA[2], voffB[2];
#pragma unroll
    for (int i = 0; i < 2; ++i) { int R, C; stage_rc(tid * 16 + i * 8192, R, C); const int Rb = Epi::PERM ? ((R & ~31) + perm32(R & 31)) : R;
        voffA[i] = (unsigned)(R * K + C) * 2u; voffB[i] = (unsigned)(Rb * K + C) * 2u; }
    const size_t kstep = (size_t)(BK * 2);
    const size_t hstep = (size_t)HALF * K * 2;
    const size_t tstep = 2 * hstep;
    const unsigned ldsw = (unsigned)wid * 1024u;
    const int aoff = lds_byte(wr * 64 + fr, fq * 8), boff = lds_byte(wc * 32 + fr, fq * 8);
#define PG8_SA(b, h) (((b) * 2 + (h)) * HTB)
#define PG8_SB(b, h) ((4 + (b) * 2 + (h)) * HTB)
#define PG8_STAGE(bufoff, gbase, voff) do { _Pragma("unroll") for (int _i = 0; _i < 2; ++_i) \
        __builtin_amdgcn_global_load_lds((const unsigned*)((const char*)(gbase) + (voff)[_i]), (PG8_LAS unsigned*)(lds + (bufoff) + ldsw + _i * 8192), 16, 0, 0); } while (0)
#define PG8_LDA(dst, b, h) do { _Pragma("unroll") for (int m = 0; m < 4; ++m) _Pragma("unroll") for (int k = 0; k < 2; ++k) dst[m][k] = *(const PG8_LAS bf16x8*)(lds + PG8_SA(b, h) + aoff + m * 2048 + k * 1024); } while (0)
#define PG8_LDB(dst, b, h) do { _Pragma("unroll") for (int n = 0; n < 2; ++n) _Pragma("unroll") for (int k = 0; k < 2; ++k) dst[n][k] = *(const PG8_LAS bf16x8*)(lds + PG8_SB(b, h) + boff + n * 2048 + k * 1024); } while (0)
#define PG8_MMA(ai, bj, At, Bt) do { __builtin_amdgcn_s_setprio(1); _Pragma("unroll") for (int m = 0; m < 4; ++m) _Pragma("unroll") for (int n = 0; n < 2; ++n) _Pragma("unroll") for (int k = 0; k < 2; ++k) \
        acc[ai][bj][m][n] = __builtin_amdgcn_mfma_f32_16x16x32_bf16(Bt[n][k], At[m][k], acc[ai][bj][m][n], 0, 0, 0); __builtin_amdgcn_s_setprio(0); } while (0)
#define PG8_WAIT_V(n) asm volatile("s_waitcnt vmcnt(" #n ")" ::: "memory")
#define PG8_WAIT_L(n) asm volatile("s_waitcnt lgkmcnt(" #n ")" ::: "memory")
#define PG8_BAR __builtin_amdgcn_s_barrier()
#define PG8_SCHED __builtin_amdgcn_sched_barrier(0)
    Unit cur, nxt; int ui = 0;
    if (!S.next(0, cur)) return;
    f32x4 acc[2][2][4][2];
#pragma unroll
    for (int a = 0; a < 2; ++a)
#pragma unroll
        for (int b = 0; b < 2; ++b)
#pragma unroll
            for (int m = 0; m < 4; ++m)
#pragma unroll
                for (int n = 0; n < 2; ++n) acc[a][b][m][n] = (f32x4){0.f, 0.f, 0.f, 0.f};
    bf16x8 At[4][2], B0[2][2], B1[2][2];
    const char* cA = (const char*)g.A + (size_t)cur.pm * tstep + (size_t)cur.k0 * 2; const char* cB = (const char*)g.Bt + (size_t)cur.pn * tstep + (size_t)cur.k0 * 2;
    S.a_ready(cur);
    if constexpr (SP2) {
        PG8_STAGE(PG8_SB(0, 0), cB, voffB); PG8_STAGE(PG8_SB(0, 1), cB + hstep, voffB); PG8_STAGE(PG8_SA(0, 0), cA, voffA); PG8_STAGE(PG8_SA(0, 1), cA + hstep, voffA);
        if (wr == 1) PG8_BAR;
        PG8_WAIT_V(2); PG8_BAR;
        PG8_STAGE(PG8_SB(1, 0), cB + kstep, voffB); PG8_STAGE(PG8_SA(1, 0), cA + kstep, voffA); PG8_STAGE(PG8_SB(1, 1), cB + hstep + kstep, voffB);
        PG8_WAIT_V(6); PG8_BAR;
    } else {
        PG8_STAGE(PG8_SB(0, 0), cB, voffB); PG8_STAGE(PG8_SA(0, 0), cA, voffA); PG8_STAGE(PG8_SB(0, 1), cB + hstep, voffB); PG8_STAGE(PG8_SA(0, 1), cA + hstep, voffA);
        if (wr == 1) PG8_BAR;
        PG8_WAIT_V(4); PG8_BAR;
        PG8_STAGE(PG8_SB(1, 0), cB + kstep, voffB); PG8_STAGE(PG8_SA(1, 0), cA + kstep, voffA); PG8_STAGE(PG8_SB(1, 1), cB + hstep + kstep, voffB);
        PG8_WAIT_V(6); PG8_BAR;
    }
    for (;;) {
        const bool has_next = S.next(ui + 1, nxt);
        const char* nA = has_next ? (const char*)g.A + (size_t)nxt.pm * tstep + (size_t)nxt.k0 * 2 : cA; const char* nB = has_next ? (const char*)g.Bt + (size_t)nxt.pn * tstep + (size_t)nxt.k0 * 2 : cB;
        const int nt = cur.nt;
        for (int t = 0; t < nt; t += 2) {
            const bool last = (t == nt - 2);
            const char* a1 = cA + (size_t)(t + 1) * kstep;
            const char* a2 = last ? nA : cA + (size_t)(t + 2) * kstep; const char* b2 = last ? nB : cB + (size_t)(t + 2) * kstep;
            const char* a3 = a2 + kstep; const char* b3 = b2 + kstep;
            if (last && has_next) S.a_ready(nxt);
            if constexpr (SP2) {
            PG8_LDB(B0, 0, 0); PG8_LDB(B1, 0, 1); PG8_SCHED; PG8_LDA(At, 0, 0); PG8_STAGE(PG8_SA(1, 1), a1 + hstep, voffA);
            PG8_WAIT_V(8); PG8_WAIT_L(0); PG8_BAR; PG8_MMA(0, 0, At, B0); PG8_MMA(0, 1, At, B1); PG8_BAR; PG8_SCHED;
            PG8_LDA(At, 0, 1); PG8_STAGE(PG8_SB(0, 0), b2, voffB); PG8_STAGE(PG8_SB(0, 1), b2 + hstep, voffB); PG8_STAGE(PG8_SA(0, 0), a2, voffA);
            PG8_WAIT_V(8); PG8_WAIT_L(0); PG8_BAR; PG8_MMA(1, 0, At, B0); PG8_MMA(1, 1, At, B1); PG8_BAR; PG8_SCHED;
            PG8_LDB(B0, 1, 0); PG8_LDB(B1, 1, 1); PG8_SCHED; PG8_LDA(At, 1, 0); PG8_STAGE(PG8_SA(0, 1), a2 + hstep, voffA);
            PG8_WAIT_V(8); PG8_WAIT_L(0); PG8_BAR; PG8_MMA(0, 0, At, B0); PG8_MMA(0, 1, At, B1); PG8_BAR; PG8_SCHED;
            PG8_LDA(At, 1, 1); PG8_STAGE(PG8_SB(1, 0), b3, voffB); PG8_STAGE(PG8_SB(1, 1), b3 + hstep, voffB); PG8_STAGE(PG8_SA(1, 0), a3, voffA);
            PG8_WAIT_V(8); PG8_WAIT_L(0); PG8_BAR; PG8_MMA(1, 0, At, B0); PG8_MMA(1, 1, At, B1); PG8_BAR; PG8_SCHED;
            } else {
            PG8_LDB(B0, 0, 0); PG8_SCHED; PG8_LDA(At, 0, 0); PG8_STAGE(PG8_SA(1, 1), a1 + hstep, voffA);
            PG8_WAIT_L(8); PG8_BAR; PG8_WAIT_L(0); PG8_MMA(0, 0, At, B0); PG8_BAR; PG8_SCHED;
            PG8_LDB(B1, 0, 1); PG8_STAGE(PG8_SB(0, 0), b2, voffB);
            PG8_BAR; PG8_WAIT_L(0); PG8_MMA(0, 1, At, B1); PG8_BAR;
            PG8_LDA(At, 0, 1); PG8_STAGE(PG8_SA(0, 0), a2, voffA);
            PG8_BAR; PG8_WAIT_L(0); PG8_MMA(1, 0, At, B0); PG8_BAR; PG8_SCHED;
            PG8_STAGE(PG8_SB(0, 1), b2 + hstep, voffB);
            PG8_WAIT_V(6); PG8_BAR; PG8_MMA(1, 1, At, B1); PG8_BAR;
            PG8_LDB(B0, 1, 0); PG8_SCHED; PG8_LDA(At, 1, 0); PG8_STAGE(PG8_SA(0, 1), a2 + hstep, voffA);
            PG8_WAIT_L(8); PG8_BAR; PG8_WAIT_L(0); PG8_MMA(0, 0, At, B0); PG8_BAR; PG8_SCHED;
            PG8_LDB(B1, 1, 1); PG8_STAGE(PG8_SB(1, 0), b3, voffB);
            PG8_BAR; PG8_WAIT_L(0); PG8_MMA(0, 1, At, B1); PG8_BAR;
            PG8_LDA(At, 1, 1); PG8_STAGE(PG8_SA(1, 0), a3, voffA);
            PG8_BAR; PG8_WAIT_L(0); PG8_MMA(1, 0, At, B0); PG8_BAR; PG8_SCHED;
            PG8_STAGE(PG8_SB(1, 1), b3 + hstep, voffB);
            PG8_WAIT_V(6); PG8_BAR; PG8_MMA(1, 1, At, B1); PG8_BAR;
            }
        }
        if constexpr (ALIGN_EPI) { if (wr == 0) PG8_BAR; }
        if constexpr (!Epi::AFTER_DRAIN) { E(acc, cur, wr, wc, fr, fq); S.done(cur); }
        if (!has_next) break;
#pragma unroll
        for (int a = 0; a < 2; ++a)
#pragma unroll
            for (int b = 0; b < 2; ++b)
#pragma unroll
                for (int m = 0; m < 4; ++m)
#pragma unroll
                    for (int n = 0; n < 2; ++n) acc[a][b][m][n] = (f32x4){0.f, 0.f, 0.f, 0.f};
        cur = nxt; cA = nA; cB = nB; ++ui;
        if constexpr (ALIGN_EPI) { if (wr == 1) PG8_BAR; }
    }
    PG8_WAIT_V(0);
    if constexpr (!ALIGN_EPI) { if (wr == 0) PG8_BAR; }
    PG8_BAR;
    if constexpr (Epi::AFTER_DRAIN) { E.fused(acc, cur, wr, wc, fr, fq, lds, wid, lane); S.done(cur); }
#undef PG8_SA
#undef PG8_SB
#undef PG8_STAGE
#undef PG8_LDA
#undef PG8_LDB
#undef PG8_MMA
#undef PG8_WAIT_V
#undef PG8_WAIT_L
#undef PG8_BAR
#undef PG8_SCHED
}
}

namespace att {
using bf16 = __hip_bfloat16;
constexpr int   D = 128, NW = 8, QBLK = 32, KVBLK = 64;
constexpr float SCALE = 0.088388347648318440f;
constexpr float THR = 8.f;
constexpr int SDEPTH = 2;
constexpr int LDQ = 1024, LDK = 256, LDO = 2048;
using bf16x8 = __attribute__((ext_vector_type(8))) short;
using s16x4  = __attribute__((ext_vector_type(4))) short;
using f32x16 = __attribute__((ext_vector_type(16))) float;
using f32x8  = __attribute__((ext_vector_type(8))) float;
using u32x4  = __attribute__((ext_vector_type(4))) unsigned;
constexpr size_t SHM_V = KVBLK * D * 2, SHM_K = KVBLK * D * 2, SHM_ATTN = 2 * SHM_V + 2 * SHM_K + NW * 64 * 4;
#define KSWZ(row, colB) ((row) * 256 + ((colB) ^ (((row) & 7) << 4)))
#define SBAR() __builtin_amdgcn_sched_barrier(0)
__device__ __forceinline__ int crow(int r, int hi) { return (r & 3) + 8 * (r >> 2) + 4 * hi; }
__device__ __forceinline__ unsigned cvtpk(float lo, float hi) {
  unsigned r; asm volatile("v_cvt_pk_bf16_f32 %0, %1, %2" : "=v"(r) : "v"(lo), "v"(hi)); return r;
}
template <typename TIn> struct Stage;
template <> struct Stage<bf16>  { using T = bf16x8;
  __device__ static __forceinline__ T ld8(const bf16* p) { return *reinterpret_cast<const bf16x8*>(p); }
  __device__ static __forceinline__ bf16x8 tobf(T x) { return x; } };
template <> struct Stage<float> { using T = f32x8;
  __device__ static __forceinline__ T ld8(const float* p) { return *reinterpret_cast<const f32x8*>(p); }
  __device__ static __forceinline__ bf16x8 tobf(T x) {
    u32x4 w = {cvtpk(x[0], x[1]), cvtpk(x[2], x[3]), cvtpk(x[4], x[5]), cvtpk(x[6], x[7])}; return *reinterpret_cast<bf16x8*>(&w); } };

__device__ __forceinline__ void partialSM(f32x16& p0, f32x16& p1, float& m_reg, float& mn, float& alpha) {
  constexpr float C = SCALE * 1.4426950408889634f;
  float pmax = p0[0]; for (int r = 1; r < 16; ++r) pmax = fmaxf(pmax, p0[r]); for (int r = 0; r < 16; ++r) pmax = fmaxf(pmax, p1[r]);
  { auto rr = __builtin_amdgcn_permlane32_swap(__float_as_uint(pmax), __float_as_uint(pmax), false, false);
    pmax = fmaxf(__uint_as_float(rr[0]), __uint_as_float(rr[1])); }
  if (__builtin_expect(__all(pmax - m_reg <= THR / SCALE), 1)) { mn = m_reg; alpha = 1.f; }
  else { mn = fmaxf(m_reg, pmax); alpha = __builtin_amdgcn_exp2f((m_reg - mn) * C); m_reg = mn; }
  float mnC = -mn * C;
  for (int r = 0; r < 16; ++r) p0[r] = fmaf(p0[r], C, mnC); for (int r = 0; r < 16; ++r) p1[r] = fmaf(p1[r], C, mnC);
  for (int r = 0; r < 16; ++r) p0[r] = __builtin_amdgcn_exp2f(p0[r]);
}
__device__ __forceinline__ void finishSM(f32x16& p0, f32x16& p1, float alpha, float& l_reg, bf16x8& pa0, bf16x8& pa1, bf16x8& pa2, bf16x8& pa3) {
  for (int r = 0; r < 16; ++r) p1[r] = __builtin_amdgcn_exp2f(p1[r]);
  float ps = 0; for (int r = 0; r < 16; ++r) ps += p0[r]; for (int r = 0; r < 16; ++r) ps += p1[r];
  { auto rr = __builtin_amdgcn_permlane32_swap(__float_as_uint(ps), __float_as_uint(ps), false, false);
    ps = __uint_as_float(rr[0]) + __uint_as_float(rr[1]); }
  l_reg = l_reg * alpha + ps;
#define PK4(P, BASE, OUT) do { unsigned a0 = cvtpk(P[BASE + 0], P[BASE + 1]), a1 = cvtpk(P[BASE + 2], P[BASE + 3]);   \
    unsigned b0 = cvtpk(P[BASE + 4], P[BASE + 5]), b1 = cvtpk(P[BASE + 6], P[BASE + 7]);                              \
    auto r0 = __builtin_amdgcn_permlane32_swap(a0, b0, false, false); auto r1 = __builtin_amdgcn_permlane32_swap(a1, b1, false, false); \
    u32x4 w = {r0[0], r1[0], r0[1], r1[1]}; OUT = *reinterpret_cast<bf16x8*>(&w); } while (0)
  PK4(p0, 0, pa0); PK4(p0, 8, pa1); PK4(p1, 0, pa2); PK4(p1, 8, pa3);
#undef PK4
}
__device__ __forceinline__ void qkt(f32x16& p0, f32x16& p1, const bf16* Ks, const bf16x8* qr, int r32, int hi) {
  p0 = f32x16{}; p1 = f32x16{};
  for (int d0 = 0; d0 < 8; ++d0) { int cb = (d0 * 16 + hi * 8) * 2;
    bf16x8 b0 = *reinterpret_cast<const bf16x8*>((const char*)Ks + KSWZ(r32, cb));
    bf16x8 b1 = *reinterpret_cast<const bf16x8*>((const char*)Ks + KSWZ(32 + r32, cb));
    p0 = __builtin_amdgcn_mfma_f32_32x32x16_bf16(b0, qr[d0], p0, 0, 0, 0);
    p1 = __builtin_amdgcn_mfma_f32_32x32x16_bf16(b1, qr[d0], p1, 0, 0, 0); }
}
__device__ __forceinline__ int v_st(int k, int c) { const int kk = (k & ~0xC) | ((k & 4) << 1) | ((k & 8) >> 1); return ((kk >> 3) * 4 + (c >> 5)) * 512 + ((kk & 7) * 32 + (c & 31)) * 2; }
__device__ __forceinline__ int v_rd_base(int lane) { return ((lane & 3) << 3) | (((lane >> 2) & 3) << 6) | (((lane >> 4) & 1) << 5) | (((lane >> 5) & 1) << 8); }
constexpr int v_rd_off(int d0, int ks, int half) { return d0 * 512 + ks * 4096 + half * 2048; }
template <int OFF> __device__ __forceinline__ s16x4 tr_read(int vb) {
  s16x4 r; asm volatile("ds_read_b64_tr_b16 %0, %1 offset:%2" : "=&v"(r) : "v"(vb), "i"(OFF) : "memory"); return r;
}
template <int D0> __device__ __forceinline__ void pv_one(f32x16& od, int vb, bf16x8 pa0, bf16x8 pa1, bf16x8 pa2, bf16x8 pa3) {
  const s16x4 l0 = tr_read<v_rd_off(D0, 0, 0)>(vb), h0 = tr_read<v_rd_off(D0, 0, 1)>(vb), l1 = tr_read<v_rd_off(D0, 1, 0)>(vb), h1 = tr_read<v_rd_off(D0, 1, 1)>(vb);
  const s16x4 l2 = tr_read<v_rd_off(D0, 2, 0)>(vb), h2 = tr_read<v_rd_off(D0, 2, 1)>(vb), l3 = tr_read<v_rd_off(D0, 3, 0)>(vb), h3 = tr_read<v_rd_off(D0, 3, 1)>(vb);
  asm volatile("s_waitcnt lgkmcnt(0)" ::: "memory"); SBAR();
#define PK(L, H) (bf16x8){L[0], L[1], L[2], L[3], H[0], H[1], H[2], H[3]}
  od = __builtin_amdgcn_mfma_f32_32x32x16_bf16(pa0, PK(l0, h0), od, 0, 0, 0);
  od = __builtin_amdgcn_mfma_f32_32x32x16_bf16(pa1, PK(l1, h1), od, 0, 0, 0);
  od = __builtin_amdgcn_mfma_f32_32x32x16_bf16(pa2, PK(l2, h2), od, 0, 0, 0);
  od = __builtin_amdgcn_mfma_f32_32x32x16_bf16(pa3, PK(l3, h3), od, 0, 0, 0);
#undef PK
}
__device__ __forceinline__ void pv_d0(f32x16* o, int vb, bf16x8 pa0, bf16x8 pa1, bf16x8 pa2, bf16x8 pa3) {
  pv_one<0>(o[0], vb, pa0, pa1, pa2, pa3); pv_one<1>(o[1], vb, pa0, pa1, pa2, pa3); pv_one<2>(o[2], vb, pa0, pa1, pa2, pa3); pv_one<3>(o[3], vb, pa0, pa1, pa2, pa3);
}

template <typename TQ>
__device__ __forceinline__ void attn_dense_body(const TQ* __restrict__ Qb, const bf16* __restrict__ Kh, const bf16* __restrict__ Vh,
                                                bf16* __restrict__ Ob, int seq, char* lds) {
  using St = Stage<bf16>; using SQ = Stage<TQ>;
  int tid_ = threadIdx.x; asm volatile("" : "+v"(tid_)); const int tid = tid_, wid = tid >> 6, lane = tid & 63, r32 = lane & 31, hi = lane >> 5;
  bf16* V_lds = (bf16*)lds; bf16* K_lds = (bf16*)(lds + 2 * SHM_V);
  float* ws = (float*)(lds + 2 * SHM_V + 2 * SHM_K) + wid * 64; float* li_l = ws; float* al_l = ws + 32;
  float m_reg = -1e30f, l_reg = 0; f32x16 o[4] = {}; bf16x8 qr[8];
  const TQ* Qw = Qb + (long)(wid * QBLK + r32) * LDQ + hi * 8;
#pragma unroll
  for (int d0 = 0; d0 < 8; ++d0) qr[d0] = SQ::tobf(SQ::ld8(Qw + d0 * 16));
  const int sr = tid >> 4, sc = (tid & 15) * 8, vst0 = v_st(sr, sc), vst1 = v_st(32 + sr, sc);
  const int vb0 = (int)(uintptr_t)V_lds + v_rd_base(lane);
  struct { typename St::T vs0, vs1, ks0, ks1; } sr_[SDEPTH];
#define SLOAD(i, k0) do { sr_[i].vs0 = St::ld8(&Vh[(long)((k0) + sr) * LDK + sc]); sr_[i].vs1 = St::ld8(&Vh[(long)((k0) + 32 + sr) * LDK + sc]); \
    sr_[i].ks0 = St::ld8(&Kh[(long)((k0) + sr) * LDK + sc]); sr_[i].ks1 = St::ld8(&Kh[(long)((k0) + 32 + sr) * LDK + sc]); } while (0)
#define SWRITE(b, i) do { *(bf16x8*)((char*)V_lds + (b) * SHM_V + vst0) = St::tobf(sr_[i].vs0);          \
    *(bf16x8*)((char*)V_lds + (b) * SHM_V + vst1) = St::tobf(sr_[i].vs1); int kc = sc * 2;               \
    *(bf16x8*)((char*)K_lds + (b) * SHM_K + KSWZ(sr, kc)) = St::tobf(sr_[i].ks0);                       \
    *(bf16x8*)((char*)K_lds + (b) * SHM_K + KSWZ(32 + sr, kc)) = St::tobf(sr_[i].ks1); } while (0)
#define SWAIT() do { if constexpr (SDEPTH == 2) asm volatile("s_waitcnt vmcnt(4)" ::: "memory"); else asm volatile("s_waitcnt vmcnt(0)" ::: "memory"); } while (0)
#define RESC(a) do { if (__any((a) < 1.f)) { if (hi == 0) al_l[r32] = (a); asm volatile("s_waitcnt lgkmcnt(0)" ::: "memory"); \
    for (int d = 0; d < 4; ++d) for (int r = 0; r < 16; ++r) o[d][r] *= al_l[crow(r, hi)]; } } while (0)
  f32x16 pA0, pA1, pB0, pB1; float mnA, mnB, alA, alB; bf16x8 pa0, pa1, pa2, pa3; const int NT = seq / KVBLK;
  constexpr int SE = 0, SO = SDEPTH - 1;
  SLOAD(SE, 0); asm volatile("s_waitcnt vmcnt(0)" ::: "memory"); SWRITE(0, SE); __syncthreads();
  qkt(pA0, pA1, K_lds, qr, r32, hi); partialSM(pA0, pA1, m_reg, mnA, alA);
  SLOAD(SO, KVBLK); if constexpr (SDEPTH == 2) { if (2 < NT) SLOAD(SE, 2 * KVBLK); }
  SWAIT(); SWRITE(1, SO); __syncthreads();
  for (int j = 1; j + 1 < NT; j += 2) {
    SBAR(); qkt(pB0, pB1, (bf16*)((char*)K_lds + SHM_K), qr, r32, hi);
    finishSM(pA0, pA1, alA, l_reg, pa0, pa1, pa2, pa3); SBAR();
    SLOAD(SO, (j + SDEPTH) * KVBLK); SBAR();
    pv_d0(o, vb0, pa0, pa1, pa2, pa3); partialSM(pB0, pB1, m_reg, mnB, alB);
    __syncthreads(); SWAIT(); SWRITE(0, SE);
    RESC(alB); __syncthreads();
    SBAR(); qkt(pA0, pA1, K_lds, qr, r32, hi);
    finishSM(pB0, pB1, alB, l_reg, pa0, pa1, pa2, pa3); SBAR();
    if (SDEPTH == 1 || j + 3 < NT) SLOAD(SE, (j + 1 + SDEPTH) * KVBLK); SBAR();
    pv_d0(o, vb0 + (int)SHM_V, pa0, pa1, pa2, pa3); partialSM(pA0, pA1, m_reg, mnA, alA);
    __syncthreads(); SWAIT(); SWRITE(1, SO);
    RESC(alA); __syncthreads();
  }
  SBAR(); qkt(pB0, pB1, (bf16*)((char*)K_lds + SHM_K), qr, r32, hi);
  finishSM(pA0, pA1, alA, l_reg, pa0, pa1, pa2, pa3); SBAR();
  pv_d0(o, vb0, pa0, pa1, pa2, pa3); partialSM(pB0, pB1, m_reg, mnB, alB);
  __syncthreads(); RESC(alB);
  finishSM(pB0, pB1, alB, l_reg, pa0, pa1, pa2, pa3); SBAR();
  pv_d0(o, vb0 + (int)SHM_V, pa0, pa1, pa2, pa3);
  if (hi == 0) li_l[r32] = l_reg; asm volatile("s_waitcnt lgkmcnt(0)" ::: "memory");
  float rli[16];
#pragma unroll
  for (int r = 0; r < 16; ++r) rli[r] = __builtin_amdgcn_rcpf(li_l[crow(r, hi)]);
  bf16* Ow = Ob + (long)(wid * QBLK) * LDO;
#pragma unroll
  for (int r = 0; r < 16; ++r) { int orow = crow(r, hi);
    for (int d0 = 0; d0 < 4; ++d0) Ow[(long)orow * LDO + d0 * 32 + r32] = __float2bfloat16(o[d0][r] * rli[r]); }
#undef SLOAD
#undef SWRITE
#undef SWAIT
#undef RESC
}

}

#ifndef MK_PER_PHASE
#define MK_PER_PHASE 0
#endif
#ifndef MK_GDN_REC
#define MK_GDN_REC 0
#endif
#ifndef MK_DIAG
#define MK_DIAG 0
#endif
#ifndef MK_DIAG_A
#define MK_DIAG_A 0
#endif
#ifndef MK_DIAG_B
#define MK_DIAG_B 1
#endif
constexpr int NWAVES = 8;

constexpr int DM = 2048, NB_CTX = 32, SEQ = 256, DEPTH = 2, NB_LAT = 2, LSEQ = 1024, PAST = 512;
constexpr int M_CTX = NB_CTX * SEQ, M_LAT = NB_LAT * LSEQ, M = M_CTX + M_LAT;
constexpr int HG = 8, DKV = 128, GDN_W = 1024, NQ = 8, NKV = 2, HD = 128, ATT_W = 1024;
constexpr int QKV_W = 3072, IN_W = 5664, IN_WP = 5888, DFF = 5632, CONVK = 5;
constexpr int C_Z = 3072, C_B = 4096, C_A = 4112, C_AQ = 4128, C_AK = 5152, C_AV = 5408;
constexpr int KROWS = M_CTX + NB_LAT * (LSEQ + PAST);
constexpr float RMS_EPS = 1e-6f, LN_EPS = 1e-5f;
constexpr float DN_ALPHA = 1.4142135623730951f;
constexpr size_t OUT_YP = 0, OUT_YS = 16777216, OUT_CK = 20971520, OUT_CV = 25165824, OUT_ST = 29360128, OUT_TOTAL = 46137344;
enum { I_XP = 0, I_XS, I_CK, I_CV, I_ST, I_C, I_CCTX, I_WADA, I_BADA, I_WIN, I_CONVW, I_ALOG, I_DTB, I_GNW, I_QNW, I_KNW, I_WO, I_LN1G, I_LN1B, I_LN2G, I_LN2B, I_WGU, I_WD, N_IN };

constexpr size_t MiB = 1u << 20;
constexpr size_t WS_CTL = 0, CTL_ZERO_BYTES = 1 * MiB;
constexpr size_t WS_MOD = 1 * MiB;
constexpr size_t WS_WIN = 2 * MiB;
constexpr size_t WS_WO  = WS_WIN + (size_t)DEPTH * IN_WP * DM * 2;
constexpr size_t WS_WGU = WS_WO + (size_t)DEPTH * DM * DM * 2;
constexpr size_t WS_WD  = WS_WGU + (size_t)DEPTH * 2 * DFF * DM * 2;
constexpr size_t WS_H   = WS_WD + (size_t)DEPTH * DM * DFF * 2;
constexpr size_t WS_MIX = WS_H + (size_t)M * DM * 2;
constexpr size_t WS_PROJ = WS_MIX + (size_t)M * DM * 2;
constexpr size_t WS_QG  = WS_PROJ + (size_t)M * IN_WP * 2;
constexpr size_t WS_KG  = WS_QG + (size_t)M * GDN_W * 2;
constexpr size_t WS_VG  = WS_KG + (size_t)M * GDN_W * 2;
constexpr size_t WS_GG  = WS_VG + (size_t)M * GDN_W * 2;
constexpr size_t WS_BB  = WS_GG + (size_t)M * 16 * 4;
constexpr size_t WS_OF  = WS_BB + (size_t)M * 16 * 4;
constexpr size_t WS_OB  = WS_OF + (size_t)M * GDN_W * 4;
constexpr size_t WS_QA  = WS_OB + (size_t)M * GDN_W * 4;
constexpr size_t WS_KA  = WS_QA + (size_t)M * ATT_W * 2;
constexpr size_t WS_VA  = WS_KA + (size_t)KROWS * 256 * 2;
constexpr size_t WS_ROPE = WS_VA + (size_t)KROWS * 256 * 2;
constexpr size_t WS_PART = WS_ROPE + (size_t)LSEQ * 64 * 16;
constexpr size_t WS_END = WS_PART + (size_t)4 * M_LAT * DM * 4;
static_assert(WS_WIN % 256 == 0 && WS_WO % 256 == 0 && WS_WGU % 256 == 0 && WS_WD % 256 == 0 && WS_H % 256 == 0 && WS_MIX % 256 == 0 && WS_PROJ % 256 == 0 && WS_QG % 256 == 0 && WS_GG % 256 == 0 && WS_OF % 256 == 0 && WS_QA % 256 == 0 && WS_KA % 256 == 0 && WS_VA % 256 == 0, "ws alignment");
static_assert(WS_MOD + (size_t)DEPTH * 3 * 12288 * 4 <= WS_WIN, "mod table");
constexpr int CW_TMO = 0, CW_CODE = 1, CW_BAR = 4096;

constexpr int RING_OFF = 0, RING_BYTES = 131072;
constexpr int LDS_BYTES = 163840;
constexpr int LDSCTL_OFF = LDS_BYTES - 512, MISC_OFF = LDSCTL_OFF + 320;

#define GAS __attribute__((address_space(1)))
#define LAS __attribute__((address_space(3)))
typedef unsigned short bf16;
typedef unsigned v4u __attribute__((ext_vector_type(4)));
typedef unsigned v2u __attribute__((ext_vector_type(2)));
typedef float f32x4 __attribute__((ext_vector_type(4)));
typedef float f32x2 __attribute__((ext_vector_type(2)));
typedef GAS unsigned gu32;
#define RLX_AGENT __ATOMIC_RELAXED, __HIP_MEMORY_SCOPE_AGENT
#define LDS_WAIT() asm volatile("s_waitcnt lgkmcnt(0)" ::: "memory")
#define VM_WAIT() asm volatile("s_waitcnt vmcnt(0)" ::: "memory")
__device__ __forceinline__ unsigned f2bf(float f) { unsigned u = __builtin_bit_cast(unsigned, f); return (u + 0x7fffu + ((u >> 16) & 1u)) >> 16; }
__device__ __forceinline__ unsigned pk2(float lo, float hi) { return f2bf(lo) | (f2bf(hi) << 16); }
__device__ __forceinline__ float bf_lo(unsigned w) { return __builtin_bit_cast(float, w << 16); }
__device__ __forceinline__ float bf_hi(unsigned w) { return __builtin_bit_cast(float, w & 0xffff0000u); }
__device__ __forceinline__ float bf1(bf16 h) { return __builtin_bit_cast(float, (unsigned)h << 16); }
template <int CTRL> __device__ __forceinline__ float dppf(float v) { return __builtin_bit_cast(float, __builtin_amdgcn_update_dpp(0, __builtin_bit_cast(int, v), CTRL, 0xF, 0xF, true)); }
__device__ __forceinline__ float wave_sum(float v) {
    v += dppf<0xB1>(v);
    v += dppf<0x4E>(v);
    v += dppf<0x141>(v);
    v += dppf<0x140>(v);
    return ((__builtin_bit_cast(float, __builtin_amdgcn_readlane(__builtin_bit_cast(int, v), 15)) + __builtin_bit_cast(float, __builtin_amdgcn_readlane(__builtin_bit_cast(int, v), 31))) +
            (__builtin_bit_cast(float, __builtin_amdgcn_readlane(__builtin_bit_cast(int, v), 47)) + __builtin_bit_cast(float, __builtin_amdgcn_readlane(__builtin_bit_cast(int, v), 63))));
}
__device__ __forceinline__ float frcp(float x) { return __builtin_amdgcn_rcpf(x); }
__device__ __forceinline__ float frsq(float x) { return __builtin_amdgcn_rsqf(x); }
__device__ __forceinline__ float fexp(float x) { return __builtin_amdgcn_exp2f(1.4426950408889634f * x); }
__device__ __forceinline__ float silu(float x) { return x * frcp(1.0f + fexp(-x)); }
#define XB_TMO      128
#define XB_XCNT(j)  (256  + 64 * (j))
#define XB_XSUB(j)  (1280 + 64 * (j))
#define XB_XGEN(j)  (2304 + 64 * (j))
#define XB_TOP      3328
#define XB_TOPGEN   3392
#define XCD_BAR_WORDS 3456
#define XB_SPIN_CAP (1u << 18)

__device__ __forceinline__ unsigned xb_ld(unsigned* p)              { return __hip_atomic_load(p, __ATOMIC_RELAXED, __HIP_MEMORY_SCOPE_AGENT); }
__device__ __forceinline__ unsigned xb_add(unsigned* p, unsigned v) { return __hip_atomic_fetch_add(p, v, __ATOMIC_RELAXED, __HIP_MEMORY_SCOPE_AGENT); }
__device__ __forceinline__ unsigned xb_xcc_id() { return (unsigned)__builtin_amdgcn_s_getreg((3 << 11) | 20) & 0xFu; }
#define XB_SPIN(cond, bar) do { unsigned _sp = 0; while (cond) { __builtin_amdgcn_s_sleep(1); \
    if ((++_sp & 255u) == 0u) { if (xb_ld(&(bar)[XB_TMO])) break; if (_sp > XB_SPIN_CAP) { atomicAdd(&(bar)[XB_TMO], 1u); break; } } } } while (0)

struct XcdBarrier {
    unsigned* bar; unsigned x;
    volatile LAS unsigned* st;
};

__device__ __forceinline__ XcdBarrier xcd_barrier_post(unsigned* bar, volatile LAS unsigned* st) {
    XcdBarrier b; b.bar = bar; b.x = xb_xcc_id(); b.st = st;
    if (threadIdx.x == 0) (void)xb_add(&bar[XB_XCNT(b.x)], 1u);
    return b;
}
__device__ __forceinline__ void xcd_barrier_complete(unsigned* bar, unsigned x, unsigned& nloc, unsigned& nx) {
    const unsigned G = gridDim.x * gridDim.y * gridDim.z;
    unsigned sum, cnt, mine, sp = 0u;
    for (;;) {
        sum = 0u; cnt = 0u; mine = 0u;
#pragma unroll
        for (unsigned j = 0; j < 16; ++j) { const unsigned c = xb_ld(&bar[XB_XCNT(j)]); sum += c; cnt += (c > 0u) ? 1u : 0u; mine = (j == x) ? c : mine; }
        if (sum == G) break;
        __builtin_amdgcn_s_sleep(1);
        if ((++sp & 255u) == 0u) { if (xb_ld(&bar[XB_TMO])) break; if (sp > XB_SPIN_CAP) { atomicAdd(&bar[XB_TMO], 1u); break; } }
    }
    nloc = mine > 0u ? mine : 1u; nx = cnt > 0u ? cnt : 1u;
}

__device__ __forceinline__ void xcd_barrier(const XcdBarrier& b) {
    asm volatile("s_waitcnt vmcnt(0)" ::: "memory");
    __syncthreads();
    if (threadIdx.x == 0) {
        unsigned* bar = b.bar;
        __builtin_amdgcn_s_waitcnt(0);
        unsigned nloc = b.st[0], nx = b.st[1];
        if (nloc == 0u) { xcd_barrier_complete(bar, b.x, nloc, nx); b.st[0] = nloc; b.st[1] = nx; }
        const unsigned old = xb_add(&bar[XB_XSUB(b.x)], 1u);
        const unsigned gen = old / nloc;
        if (old + 1u == (gen + 1u) * nloc) {
            __builtin_amdgcn_fence(__ATOMIC_RELEASE, "agent");
            asm volatile("s_waitcnt vmcnt(0)" ::: "memory");
            const unsigned og = xb_add(&bar[XB_TOP], 1u);
            const unsigned tg = og / nx;
            if (og + 1u == (tg + 1u) * nx) xb_add(&bar[XB_TOPGEN], 1u);
            else XB_SPIN(xb_ld(&bar[XB_TOPGEN]) == tg, bar);
            __builtin_amdgcn_fence(__ATOMIC_ACQUIRE, "agent");
            xb_add(&bar[XB_XGEN(b.x)], 1u);
            asm volatile("s_waitcnt vmcnt(0)" ::: "memory");
        } else {
            XB_SPIN(xb_ld(&bar[XB_XGEN(b.x)]) == gen, bar);
            __builtin_amdgcn_fence(__ATOMIC_ACQUIRE, "agent");
            asm volatile("s_waitcnt vmcnt(0)" ::: "memory");
        }
    }
    __syncthreads();
}

struct Args { const float* in[N_IN]; float* out; unsigned char* ws; int ph_lo, ph_hi; };
static_assert(sizeof(Args) == 8 * (N_IN + 2) + 8, "Args has no padding");
#define CAS __attribute__((address_space(4)))
#define ARGS_T const CAS Args
__device__ __forceinline__ ARGS_T* fresh_args() { const CAS char* p = (const CAS char*)__builtin_amdgcn_kernarg_segment_ptr(); asm volatile("" : "+s"(p)); return (ARGS_T*)p; }
__device__ __forceinline__ int fresh_tid() { int t = threadIdx.x; asm volatile("" : "+v"(t)); return t; }
__device__ __forceinline__ int fresh_bx() { int b = blockIdx.x; asm volatile("" : "+s"(b)); return b; }

struct Frame {
    LAS unsigned char* lds;
    volatile LAS unsigned* MISC;
    gu32* ctl;
    int tid, lane, wave;
    int vcu, G, bx;
    float* out;
    unsigned char* ws;
};
#define WSP(T, off) ((T*)(F.ws + (off)))

__device__ __forceinline__ void p0_transpose_item(const float* W, int K, int N, bf16* WT, int k0, int n0, int drow0, LAS float* scr, int lane) {
#pragma unroll 8
    for (int i = 0; i < 32; ++i) { const int kk = 2 * i + (lane >> 5); scr[kk * 33 + (lane & 31)] = W[(size_t)(k0 + kk) * N + n0 + (lane & 31)]; }
    LDS_WAIT(); asm volatile("" ::: "memory");
    const int c = lane & 7;
#pragma unroll
    for (int j = 0; j < 4; ++j) { const int n = (lane >> 3) + 8 * j; const LAS float* s = scr + (8 * c) * 33 + n;
        v4u o; o.x = pk2(s[0 * 33], s[1 * 33]); o.y = pk2(s[2 * 33], s[3 * 33]); o.z = pk2(s[4 * 33], s[5 * 33]); o.w = pk2(s[6 * 33], s[7 * 33]);
        *(GAS v4u*)(WT + (size_t)(drow0 + n) * K + k0 + 8 * c) = o; }
    LDS_WAIT(); asm volatile("" ::: "memory");
}
__device__ __forceinline__ void p0a_phase(ARGS_T& A, Frame& F) {
    LAS float* sl = (LAS float*)(F.lds);
    LAS float* red = (LAS float*)(F.lds + 32768);
    for (int i = F.tid; i < 3 * DM; i += NWAVES * 64) { const int ci = i / DM, k = i % DM; const float c = ci == 0 ? A.in[I_CCTX][k] : A.in[I_C][(ci - 1) * DM + k]; sl[i] = silu(c); }
    __syncthreads();
    for (int grp = F.bx; grp < 256; grp += F.G) {
        const int l = grp >> 7, n0 = (grp & 127) * 96;
        const int cg = F.tid % 24, kg = F.tid / 24;
        float a[3][4];
#pragma unroll
        for (int ci = 0; ci < 3; ++ci)
#pragma unroll
            for (int j = 0; j < 4; ++j) a[ci][j] = 0.f;
        if (kg < 21) {
            const float* wp = A.in[I_WADA] + (size_t)l * DM * 12288 + n0 + 4 * cg;
#pragma unroll 4
            for (int k = kg; k < DM; k += 21) { const f32x4 w = *(const f32x4*)(wp + (size_t)k * 12288); const float s0 = sl[k], s1 = sl[DM + k], s2 = sl[2 * DM + k];
#pragma unroll
                for (int j = 0; j < 4; ++j) { a[0][j] += s0 * w[j]; a[1][j] += s1 * w[j]; a[2][j] += s2 * w[j]; } }
#pragma unroll
            for (int ci = 0; ci < 3; ++ci)
#pragma unroll
                for (int j = 0; j < 4; ++j) red[(kg * 24 + cg) * 12 + ci * 4 + j] = a[ci][j];
        }
        __syncthreads();
        if (F.tid < 288) { const int c2 = F.tid / 12, j = F.tid % 12, ci = j >> 2, cc = j & 3; float s = 0.f;
            for (int q = 0; q < 21; ++q) s += red[(q * 24 + c2) * 12 + j];
            const int n = n0 + 4 * c2 + cc;
            WSP(float, WS_MOD)[((size_t)l * 3 + ci) * 12288 + n] = s + A.in[I_BADA][(size_t)l * 12288 + n]; }
        __syncthreads();
    }
    LAS float* scr = (LAS float*)(F.lds + RING_OFF + F.wave * 16384);
    const int gw = F.vcu * NWAVES + F.wave, NGW = F.G * NWAVES;
    constexpr int I_IN = (DM / 64) * (IN_W / 32), I_O = (DM / 64) * (DM / 32), I_GU = (DM / 64) * (2 * DFF / 32), I_D = (DFF / 64) * (DM / 32), I_LAYER = I_IN + I_O + I_GU + I_D;
    for (int it = gw; it < DEPTH * I_LAYER; it += NGW) {
        const int l = it / I_LAYER; int r = it % I_LAYER;
        if (r < I_IN) { const int nblk = IN_W / 32, kb = r / nblk, nb = r % nblk;
            p0_transpose_item(A.in[I_WIN] + (size_t)l * DM * IN_W, DM, IN_W, WSP(bf16, WS_WIN) + (size_t)l * IN_WP * DM, 64 * kb, 32 * nb, 32 * nb, scr, F.lane); continue; } r -= I_IN;
        if (r < I_O) { const int nblk = DM / 32, kb = r / nblk, nb = r % nblk;
            p0_transpose_item(A.in[I_WO] + (size_t)l * DM * DM, DM, DM, WSP(bf16, WS_WO) + (size_t)l * DM * DM, 64 * kb, 32 * nb, 32 * nb, scr, F.lane); continue; } r -= I_O;
        if (r < I_GU) { const int nblk = 2 * DFF / 32, kb = r / nblk, nb = r % nblk, n0 = 32 * nb, s = n0 / DFF, j = n0 % DFF, p = j / 128, rr = j % 128;
            p0_transpose_item(A.in[I_WGU] + (size_t)l * DM * 2 * DFF, DM, 2 * DFF, WSP(bf16, WS_WGU) + (size_t)l * 2 * DFF * DM, 64 * kb, n0, 256 * p + 128 * s + rr, scr, F.lane); continue; } r -= I_GU;
        { const int nblk = DM / 32, kb = r / nblk, nb = r % nblk;
            p0_transpose_item(A.in[I_WD] + (size_t)l * DFF * DM, DFF, DM, WSP(bf16, WS_WD) + (size_t)l * DM * DFF, 64 * kb, 32 * nb, 32 * nb, scr, F.lane); }
    }
    { const int gt = F.vcu * NWAVES * 64 + F.tid, NGT = F.G * NWAVES * 64; constexpr int PADV = (IN_WP - IN_W) * DM * 2 / 16;
        for (int i = gt; i < DEPTH * PADV; i += NGT) { const int l = i / PADV, r = i % PADV; ((GAS v4u*)(WSP(bf16, WS_WIN) + (size_t)l * IN_WP * DM + (size_t)IN_W * DM))[r] = (v4u){0u, 0u, 0u, 0u}; } }
}

__device__ __forceinline__ int cond_of_row(int row) { return row < M_CTX ? 0 : 1 + ((row - M_CTX) >> 10); }
__device__ __forceinline__ void p0b_phase(ARGS_T& A, Frame& F) {
    const int gw = F.vcu * NWAVES + F.wave, NGW = F.G * NWAVES;
    for (int t = gw; t < LSEQ; t += NGW) { const int lane = F.lane; const float pos = (float)(lane < 32 ? (t >> 6) : (t & 63)); const int i0 = 2 * (lane & 15);
        const float f0 = powf(10000.f, -(float)(2 * i0) / 64.f), f1 = powf(10000.f, -(float)(2 * i0 + 2) / 64.f); float s0, c0, s1, c1;
        sincosf(pos * f0, &s0, &c0); sincosf(pos * f1, &s1, &c1);
        *(f32x4*)(WSP(float, WS_ROPE) + ((size_t)t * 64 + lane) * 4) = (f32x4){c0, s0, c1, s1}; }
    for (int row = gw; row < M; row += NGW) {
        const float* xr = row < M_CTX ? A.in[I_XP] + (size_t)row * DM : A.in[I_XS] + (size_t)(row - M_CTX) * DM;
        const float* mod = WSP(float, WS_MOD) + (size_t)cond_of_row(row) * 12288;
        GAS v2u* o8 = (GAS v2u*)(WSP(bf16, WS_H) + (size_t)row * DM) + F.lane;
#pragma unroll
        for (int j = 0; j < 8; ++j) { const int c = 4 * F.lane + 256 * j; const f32x4 x = *(const f32x4*)(xr + c), sh = *(const f32x4*)(mod + c), sc = *(const f32x4*)(mod + DM + c);
            const f32x4 h = x * (sc + 1.0f) + sh; o8[64 * j] = (v2u){pk2(h[0], h[1]), pk2(h[2], h[3])}; }
    }
}
__device__ __forceinline__ void ln_phase(ARGS_T& A, Frame& F, const float* lg, const float* lb, const float* modsh, const float* modsc, bool write_h, const float* part, const float* xin_lat, const float* gate, float alpha) {
    const int gw = F.vcu * NWAVES + F.wave, NGW = F.G * NWAVES;
    float* X = F.out;
    for (int row = gw; row < M; row += NGW) {
        float* xr = X + (size_t)row * DM;
        f32x4 v[8]; float s = 0.f;
#pragma unroll
        for (int j = 0; j < 8; ++j) v[j] = *(const f32x4*)((part && row >= M_CTX ? xin_lat + (size_t)(row - M_CTX) * DM : xr) + 4 * F.lane + 256 * j);
        if (part && row >= M_CTX) { const float* pr = part + (size_t)(row - M_CTX) * DM + 4 * F.lane; const float* gr = gate + (size_t)cond_of_row(row) * 12288 + 4 * F.lane;
#pragma unroll
            for (int j = 0; j < 8; ++j) { const f32x4 p0 = *(const f32x4*)(pr + 256 * j), p1 = *(const f32x4*)(pr + (size_t)M_LAT * DM + 256 * j), p2 = *(const f32x4*)(pr + (size_t)2 * M_LAT * DM + 256 * j), p3 = *(const f32x4*)(pr + (size_t)3 * M_LAT * DM + 256 * j);
                v[j] = v[j] * alpha + *(const f32x4*)(gr + 256 * j) * ((p0 + p1) + (p2 + p3)); } }
#pragma unroll
        for (int j = 0; j < 8; ++j) s += (v[j][0] + v[j][1]) + (v[j][2] + v[j][3]);
        const float mean = wave_sum(s) * (1.f / DM); float s2 = 0.f;
#pragma unroll
        for (int j = 0; j < 8; ++j) { v[j] = v[j] - mean; s2 += (v[j][0] * v[j][0] + v[j][1] * v[j][1]) + (v[j][2] * v[j][2] + v[j][3] * v[j][3]); }
        const float rstd = frsq(wave_sum(s2) * (1.f / DM) + LN_EPS);
        const int ci = cond_of_row(row);
        GAS v2u* o8 = (GAS v2u*)(WSP(bf16, WS_H) + (size_t)row * DM) + F.lane;
#pragma unroll
        for (int j = 0; j < 8; ++j) { const int c = 4 * F.lane + 256 * j; const f32x4 g = *(const f32x4*)(lg + c), b = *(const f32x4*)(lb + c);
            const f32x4 y = v[j] * rstd * g + b; *(f32x4*)(xr + c) = y;
            if (write_h) { const f32x4 sh = *(const f32x4*)(modsh + (size_t)ci * 12288 + c), sc = *(const f32x4*)(modsc + (size_t)ci * 12288 + c);
                const f32x4 h = y * (sc + 1.0f) + sh; o8[64 * j] = (v2u){pk2(h[0], h[1]), pk2(h[2], h[3])}; } }
    }
}

__device__ __forceinline__ void prep_phase(ARGS_T& A, Frame& F, int l) {
    LAS float* cw = (LAS float*)(F.lds);
    { const float* cwg = A.in[I_CONVW] + (size_t)l * CONVK * QKV_W;
      for (int i = F.tid; i < CONVK * QKV_W / 4; i += NWAVES * 64) ((LAS f32x4*)cw)[i] = ((const f32x4*)cwg)[i]; }
    __syncthreads();
    const int gw = F.vcu * NWAVES + F.wave, NGW = F.G * NWAVES, lane = F.lane;
    const bf16* PROJ = WSP(bf16, WS_PROJ);
    for (int r = gw; r < NB_LAT * PAST; r += NGW) {
        const int b = r / PAST, j = r % PAST; const size_t src = ((size_t)(b * DEPTH + l) * PAST + j) * 256 + 4 * lane; const size_t krow = (size_t)M_CTX + (size_t)b * (LSEQ + PAST) + LSEQ + j;
        const f32x4 kv = *(const f32x4*)(A.in[I_CK] + src), vv = *(const f32x4*)(A.in[I_CV] + src);
        *(GAS v2u*)(WSP(bf16, WS_KA) + krow * 256 + 4 * lane) = (v2u){pk2(kv[0], kv[1]), pk2(kv[2], kv[3])};
        *(GAS v2u*)(WSP(bf16, WS_VA) + krow * 256 + 4 * lane) = (v2u){pk2(vv[0], vv[1]), pk2(vv[2], vv[3])}; }
    constexpr int RUN = 8, NRUN = M / RUN;
    const float sgn = (lane & 16) ? 1.f : -1.f;
    const f32x2 qw = *(const f32x2*)(A.in[I_QNW] + l * HD + 2 * lane), kw = *(const f32x2*)(A.in[I_KNW] + l * HD + 2 * lane);
    const float dtb = A.in[I_DTB][l * 16 + (lane & 15)], nealog = -fexp(A.in[I_ALOG][l * 16 + (lane & 15)]);
#define PREP_LOADROW(dst, tt) do { if ((tt) >= 0 && (tt) < T) { const bf16* pr_ = PROJ + (size_t)(seq0 + (tt)) * IN_WP + 1024 * part + 2 * lane; _Pragma("unroll") for (int i_ = 0; i_ < 8; ++i_) dst[i_] = *(const unsigned*)(pr_ + 128 * i_); } \
        else { _Pragma("unroll") for (int i_ = 0; i_ < 8; ++i_) dst[i_] = 0u; } } while (0)
#define PREP_LOADATT(dst, gb_, ga_, row_) do { const bf16* pr_ = PROJ + (size_t)(row_) * IN_WP; const int c0_ = part == 2 ? C_AK : C_AQ + 512 * part; _Pragma("unroll") for (int h_ = 0; h_ < 4; ++h_) dst[h_] = *(const unsigned*)(pr_ + c0_ + 128 * h_ + 2 * lane); \
        gb_ = pr_[C_B + (lane & 15)]; ga_ = pr_[C_A + (lane & 15)]; } while (0)
    for (int item = gw; item < 3 * NRUN; item += NGW) {
        const int part = item / NRUN, run = item % NRUN;
        const int rowb = run * RUN; const bool lat = rowb >= M_CTX;
        int seq0, tb, T, bidx;
        if (!lat) { seq0 = rowb & ~(SEQ - 1); tb = rowb & (SEQ - 1); T = SEQ; bidx = rowb >> 8; } else { const int r = rowb - M_CTX; seq0 = M_CTX + (r & ~(LSEQ - 1)); tb = r & (LSEQ - 1); T = LSEQ; bidx = r >> 10; }
        unsigned w0[8], w1[8], w2[8], w3[8], w4[8], nx[8], an[4]; bf16 gbn, gan;
        PREP_LOADROW(w0, tb - 2); PREP_LOADROW(w1, tb - 1); PREP_LOADROW(w2, tb); PREP_LOADROW(w3, tb + 1); PREP_LOADROW(w4, tb + 2);
        PREP_LOADATT(an, gbn, gan, rowb);
        bf16* gdst = (part == 0 ? WSP(bf16, WS_QG) : part == 1 ? WSP(bf16, WS_KG) : WSP(bf16, WS_VG)) + 2 * lane;
        const LAS float* cwp = cw + 1024 * part + 2 * lane;
#pragma unroll 1
        for (int tk = 0; tk < RUN; ++tk) {
            const int row = rowb + tk, t = tb + tk;
            unsigned ac[4]; const bf16 gbc = gbn, gac = gan;
#pragma unroll
            for (int h = 0; h < 4; ++h) ac[h] = an[h];
            if (tk + 1 < RUN) { PREP_LOADROW(nx, t + 3); PREP_LOADATT(an, gbn, gan, row + 1); }
#pragma unroll
            for (int i = 0; i < 8; ++i) { const LAS float* c = cwp + 128 * i;
                const f32x2 c0 = *(const LAS f32x2*)(c), c1 = *(const LAS f32x2*)(c + QKV_W), c2 = *(const LAS f32x2*)(c + 2 * QKV_W), c3 = *(const LAS f32x2*)(c + 3 * QKV_W), c4 = *(const LAS f32x2*)(c + 4 * QKV_W);
                float y0 = c0[0] * bf_lo(w0[i]) + c1[0] * bf_lo(w1[i]) + c2[0] * bf_lo(w2[i]) + c3[0] * bf_lo(w3[i]) + c4[0] * bf_lo(w4[i]);
                float y1 = c0[1] * bf_hi(w0[i]) + c1[1] * bf_hi(w1[i]) + c2[1] * bf_hi(w2[i]) + c3[1] * bf_hi(w3[i]) + c4[1] * bf_hi(w4[i]);
                y0 = silu(y0); y1 = silu(y1);
                if (part < 2) { const float ss = wave_sum(y0 * y0 + y1 * y1); float sc = frsq(ss + RMS_EPS); if (part == 0) sc *= 0.08838834764831845f; y0 *= sc; y1 *= sc; }
                *(GAS unsigned*)(gdst + (size_t)row * GDN_W + 128 * i) = pg8::cvt_pk_bf16(y0, y1); if ((i & 3) == 3) __builtin_amdgcn_sched_barrier(0); }
            const size_t krow = lat ? (size_t)M_CTX + (size_t)bidx * (LSEQ + PAST) + t : (size_t)row;
            float rc0 = 1.f, rs0 = 0.f, rc1 = 1.f, rs1 = 0.f;
            if (lat) { const f32x4 rt = *(const f32x4*)(WSP(float, WS_ROPE) + ((size_t)t * 64 + lane) * 4); rc0 = rt[0]; rs0 = rt[1]; rc1 = rt[2]; rs1 = rt[3]; }
            if (part < 2) {
#pragma unroll
                for (int h = 0; h < 4; ++h) { float x0 = bf_lo(ac[h]), x1 = bf_hi(ac[h]);
                    const float r = frsq(wave_sum(x0 * x0 + x1 * x1) * (1.f / HD) + RMS_EPS); x0 = x0 * r * qw[0]; x1 = x1 * r * qw[1];
                    if (lat) { const float o0 = __shfl_xor(x0, 16), o1 = __shfl_xor(x1, 16); x0 = x0 * rc0 + sgn * o0 * rs0; x1 = x1 * rc1 + sgn * o1 * rs1; }
                    *(GAS unsigned*)(WSP(bf16, WS_QA) + (size_t)row * ATT_W + 128 * (4 * part + h) + 2 * lane) = pg8::cvt_pk_bf16(x0, x1); }
            } else {
#pragma unroll
                for (int h = 0; h < 2; ++h) { float x0 = bf_lo(ac[h]), x1 = bf_hi(ac[h]);
                    const float r = frsq(wave_sum(x0 * x0 + x1 * x1) * (1.f / HD) + RMS_EPS); x0 = x0 * r * kw[0]; x1 = x1 * r * kw[1];
                    if (!lat) *(f32x2*)(F.out + OUT_CK + ((size_t)(bidx * DEPTH + l) * SEQ + t) * 256 + 128 * h + 2 * lane) = (f32x2){x0, x1};
                    else { const float o0 = __shfl_xor(x0, 16), o1 = __shfl_xor(x1, 16); x0 = x0 * rc0 + sgn * o0 * rs0; x1 = x1 * rc1 + sgn * o1 * rs1; }
                    *(GAS unsigned*)(WSP(bf16, WS_KA) + krow * 256 + 128 * h + 2 * lane) = pg8::cvt_pk_bf16(x0, x1); }
#pragma unroll
                for (int h = 0; h < 2; ++h) { const unsigned w = ac[2 + h];
                    *(GAS unsigned*)(WSP(bf16, WS_VA) + krow * 256 + 128 * h + 2 * lane) = w;
                    if (!lat) *(f32x2*)(F.out + OUT_CV + ((size_t)(bidx * DEPTH + l) * SEQ + t) * 256 + 128 * h + 2 * lane) = (f32x2){bf_lo(w), bf_hi(w)}; }
                if (lane < 16) { const float bv = bf1(gbc), av = bf1(gac) + dtb;
                    const float sp = fmaxf(av, 0.f) + __logf(1.f + fexp(-fabsf(av)));
                    WSP(float, WS_GG)[(size_t)row * 16 + lane] = nealog * sp;
                    WSP(float, WS_BB)[(size_t)row * 16 + lane] = frcp(1.f + fexp(-bv)); }
            }
#pragma unroll
            for (int i = 0; i < 8; ++i) { w0[i] = w1[i]; w1[i] = w2[i]; w2[i] = w3[i]; w3[i] = w4[i]; w4[i] = nx[i]; }
        }
    }
#undef PREP_LOADROW
#undef PREP_LOADATT
}

constexpr int GDN_ITEMS_CTX = NB_CTX * HG * 2 / 4, GDN_ITEMS = GDN_ITEMS_CTX + NB_LAT * HG * 2 / 4;
__device__ __forceinline__ void gdn_rec_item(ARGS_T& A, Frame& F, int l, int it) {
    const bool lat = it >= GDN_ITEMS_CTX; const int cbase = lat ? (it - GDN_ITEMS_CTX) * 4 : it * 4;
    const int slot = F.tid >> 7, e = F.tid & 127, c = cbase + slot, b = c >> 4, h = (c >> 1) & 7, dir = c & 1;
    const int T = lat ? LSEQ : SEQ, row0 = lat ? M_CTX + b * LSEQ : b * SEQ;
    float S[128];
    if (lat) { const float* s0 = A.in[I_ST] + ((((size_t)b * DEPTH + l) * 2 + dir) * HG + h) * (size_t)(DKV * DKV) + e;
#pragma unroll
        for (int d = 0; d < 128; ++d) S[d] = s0[(size_t)d * DKV]; }
    else {
#pragma unroll
        for (int d = 0; d < 128; ++d) S[d] = 0.f; }
    constexpr int NBS = 16, SLOTF = NBS * 384 + 64;
    LAS float* kq = (LAS float*)(F.lds) + slot * SLOTF;
    const bf16 *KG = WSP(bf16, WS_KG), *QG = WSP(bf16, WS_QG), *VG = WSP(bf16, WS_VG);
    float* OD = dir ? WSP(float, WS_OB) : WSP(float, WS_OF);
    for (int i0 = 0; i0 < T; i0 += NBS) {
        __syncthreads();
#pragma unroll 4
        for (int j = 0; j < NBS; ++j) { const int t = dir ? T - 1 - (i0 + j) : i0 + j; const size_t off = (size_t)(row0 + t) * GDN_W + h * 128 + e;
            kq[j * 384 + e] = bf1(KG[off]); kq[j * 384 + 128 + e] = bf1(QG[off]); kq[j * 384 + 256 + e] = bf1(VG[off]); }
        if (e < NBS) { const int t = dir ? T - 1 - (i0 + e) : i0 + e; const size_t off = (size_t)(row0 + t) * 16 + dir * 8 + h;
            kq[NBS * 384 + e] = WSP(float, WS_GG)[off]; kq[NBS * 384 + 16 + e] = WSP(float, WS_BB)[off]; }
        __syncthreads();
        for (int j = 0; j < NBS; ++j) {
            const LAS float* kp = kq + j * 384; const float decay = __expf(kq[NBS * 384 + j]), beta = kq[NBS * 384 + 16 + j], v = kp[256 + e];
            float kv0 = 0.f, kv1 = 0.f;
#pragma unroll
            for (int dc = 0; dc < 128; dc += 16) {
#pragma unroll
                for (int d = dc; d < dc + 16; d += 4) { const f32x4 k4 = *(const LAS f32x4*)(kp + d); kv0 += k4[0] * S[d] + k4[2] * S[d + 2]; kv1 += k4[1] * S[d + 1] + k4[3] * S[d + 3]; }
                __builtin_amdgcn_sched_barrier(0); }
            const float delta = beta * (v - decay * (kv0 + kv1));
            float o0 = 0.f, o1 = 0.f;
#pragma unroll
            for (int dc = 0; dc < 128; dc += 8) {
#pragma unroll
                for (int d = dc; d < dc + 8; d += 4) { const f32x4 k4 = *(const LAS f32x4*)(kp + d), q4 = *(const LAS f32x4*)(kp + 128 + d);
                    S[d] = decay * S[d] + k4[0] * delta; S[d + 1] = decay * S[d + 1] + k4[1] * delta; S[d + 2] = decay * S[d + 2] + k4[2] * delta; S[d + 3] = decay * S[d + 3] + k4[3] * delta;
                    o0 += q4[0] * S[d] + q4[2] * S[d + 2]; o1 += q4[1] * S[d + 1] + q4[3] * S[d + 3]; }
                __builtin_amdgcn_sched_barrier(0); }
            const int t = dir ? T - 1 - (i0 + j) : i0 + j;
            OD[(size_t)(row0 + t) * GDN_W + h * 128 + e] = o0 + o1;
        }
    }
    if (!lat) { float* so = F.out + OUT_ST + ((((size_t)b * DEPTH + l) * 2 + dir) * HG + h) * (size_t)(DKV * DKV) + e;
#pragma unroll
        for (int d = 0; d < 128; ++d) so[(size_t)d * DKV] = S[d]; }
    __syncthreads();
}
constexpr int ATT_UNITS_LAT = NB_LAT * NQ * (LSEQ / 256), ATT_UNITS = ATT_UNITS_LAT + NB_CTX * NQ;
__device__ __forceinline__ void attn_unit(Frame& F, int u, char* lds) {
    const att::bf16* QA = (const att::bf16*)WSP(bf16, WS_QA); const att::bf16* KA = (const att::bf16*)WSP(bf16, WS_KA); const att::bf16* VA = (const att::bf16*)WSP(bf16, WS_VA);
    att::bf16* MIX = (att::bf16*)WSP(bf16, WS_MIX);
    int qrow0, krow0, h, seq;
    if (u < ATT_UNITS_LAT) { const int b = u / (NQ * 4), r = u % (NQ * 4); h = r >> 2; const int qb = r & 3; qrow0 = M_CTX + b * LSEQ + qb * 256; krow0 = M_CTX + b * (LSEQ + PAST); seq = LSEQ + PAST; }
    else { const int v = u - ATT_UNITS_LAT, b = v >> 3; h = v & 7; qrow0 = b * SEQ; krow0 = b * SEQ; seq = SEQ; }
    const int kvh = h >> 2;
    att::attn_dense_body<att::bf16>(QA + (size_t)qrow0 * ATT_W + h * HD, KA + (size_t)krow0 * 256 + kvh * HD, VA + (size_t)krow0 * 256 + kvh * HD, MIX + (size_t)qrow0 * DM + GDN_W + h * HD, seq, lds);
    __syncthreads();
}
__device__ __forceinline__ void combine_phase(ARGS_T& A, Frame& F, int l) {
    const int gw = F.vcu * NWAVES + F.wave, NGW = F.G * NWAVES, lane = F.lane;
    const f32x2 nw = *(const f32x2*)(A.in[I_GNW] + l * DKV + 2 * lane);
    for (int row = gw; row < M; row += NGW) {
        const float* of = WSP(float, WS_OF) + (size_t)row * GDN_W + 2 * lane; const float* ob = WSP(float, WS_OB) + (size_t)row * GDN_W + 2 * lane;
        const bf16* z = WSP(bf16, WS_PROJ) + (size_t)row * IN_WP + C_Z + 2 * lane; bf16* mx = WSP(bf16, WS_MIX) + (size_t)row * DM + 2 * lane;
#pragma unroll
        for (int h = 0; h < HG; ++h) { const f32x2 a = *(const f32x2*)(of + 128 * h), b = *(const f32x2*)(ob + 128 * h); const float o0 = a[0] + b[0], o1 = a[1] + b[1];
            const float r = frsq(wave_sum(o0 * o0 + o1 * o1) * (1.f / DKV) + RMS_EPS); const unsigned zw = *(const unsigned*)(z + 128 * h);
            *(GAS unsigned*)(mx + 128 * h) = pk2(o0 * r * nw[0] * silu(bf_lo(zw)), o1 * r * nw[1] * silu(bf_hi(zw))); }
    }
}

namespace gdn {
typedef short bf16x8 __attribute__((ext_vector_type(8)));
typedef short s16x4 __attribute__((ext_vector_type(4)));
typedef float f32x16 __attribute__((ext_vector_type(16)));
constexpr int O_QR = 0, O_KR = 17408, O_KT = 34816, O_VT = 53248, O_ST = 71680, O_LR = 106496, O_LT = 115712, O_PR = 124928, O_AT = 134144, O_VEC = 143360, O_VTMP = 145408, O_END = 162816;
constexpr int O_WR = O_KR, O_VNT = O_VT, O_VST = O_LR;
constexpr int SW = 272, SN = 144;
constexpr int V_GC = 0, V_BE = 256, V_EGC = 512, V_BW = 768, V_SF = 1024, V_EG63 = 1280;
constexpr int NCHAIN_LAT = NB_LAT * HG * 2, NCHAIN = NCHAIN_LAT + NB_CTX * HG * 2;
static_assert(O_END + 512 <= LDS_BYTES && O_END <= LDSCTL_OFF, "gdn LDS map");

__device__ __forceinline__ int crow(int r, int hi) { return (r & 3) + 8 * (r >> 2) + 4 * hi; }
__device__ __forceinline__ unsigned cvt2(float lo, float hi) { return pg8::cvt_pk_bf16(lo, hi); }
template <int KS> __device__ __forceinline__ void mma(f32x16& acc, LAS const unsigned char* A, int sa, LAS const unsigned char* B, int sb, int lane) {
    LAS const unsigned char* pa = A + (lane & 31) * sa + (lane >> 5) * 16; LAS const unsigned char* pb = B + (lane & 31) * sb + (lane >> 5) * 16;
#pragma unroll
    for (int ks = 0; ks < KS; ++ks) { const bf16x8 a = *(LAS const bf16x8*)(pa + ks * 32), b = *(LAS const bf16x8*)(pb + ks * 32); acc = __builtin_amdgcn_mfma_f32_32x32x16_bf16(a, b, acc, 0, 0, 0);
        if ((ks & 3) == 3) __builtin_amdgcn_sched_barrier(0); }
}
template <int KS> __device__ __forceinline__ void ldfrag(bf16x8 (&f)[KS], LAS const unsigned char* A, int sa, int lane) {
    LAS const unsigned char* pa = A + (lane & 31) * sa + (lane >> 5) * 16;
#pragma unroll
    for (int ks = 0; ks < KS; ++ks) f[ks] = *(LAS const bf16x8*)(pa + ks * 32);
}
__device__ __forceinline__ void st_T(LAS unsigned char* dst, int sd, const f32x16& v, int lane) {
    LAS unsigned char* p = dst + (lane & 31) * sd + (lane >> 5) * 8;
#pragma unroll
    for (int rg = 0; rg < 4; ++rg) *(LAS v2u*)(p + rg * 16) = (v2u){cvt2(v[4 * rg], v[4 * rg + 1]), cvt2(v[4 * rg + 2], v[4 * rg + 3])};
}
__device__ __forceinline__ void st_R(LAS unsigned char* dst, int sd, const f32x16& v, int lane) {
    const int hi = lane >> 5; LAS unsigned char* p = dst + (lane & 31) * 2;
#pragma unroll
    for (int r = 0; r < 16; r += 2) { const unsigned w = cvt2(v[r], v[r + 1]);
        *(LAS unsigned short*)(p + crow(r, hi) * sd) = (unsigned short)(w & 0xffffu); *(LAS unsigned short*)(p + crow(r + 1, hi) * sd) = (unsigned short)(w >> 16); }
}
__device__ __forceinline__ void ldrow16(float (&o)[16], LAS const unsigned char* vec, int m0, int hi) {
#pragma unroll
    for (int rg = 0; rg < 4; ++rg) { const f32x4 t = *(LAS const f32x4*)(vec + 4 * (m0 + 8 * rg + 4 * hi)); o[4 * rg] = t[0]; o[4 * rg + 1] = t[1]; o[4 * rg + 2] = t[2]; o[4 * rg + 3] = t[3]; }
}

__device__ __forceinline__ void chain(ARGS_T& A, Frame& F, int l, int cid) {
    const bool lat = cid < NCHAIN_LAT; const int c2 = lat ? cid : cid - NCHAIN_LAT; const int b = c2 >> 4, h = (c2 >> 1) & 7, dir = c2 & 1;
    const int T = lat ? LSEQ : SEQ, NC = T / 64, row0 = lat ? M_CTX + b * LSEQ : b * SEQ;
    LAS unsigned char* L = F.lds; LAS unsigned char* VEC = L + O_VEC;
    const int tid0 = F.tid, w0 = F.wave;
    const bf16* QG = WSP(bf16, WS_QG) + h * 128; const bf16* KG = WSP(bf16, WS_KG) + h * 128; const bf16* VG = WSP(bf16, WS_VG) + h * 128;
    const float* GGp = WSP(float, WS_GG) + dir * 8 + h; const float* BBp = WSP(float, WS_BB) + dir * 8 + h;
    float* OD = (dir ? WSP(float, WS_OB) : WSP(float, WS_OF)) + h * 128;
    f32x16 S0t, S1t;
    { const int w = w0, lane = tid0 & 63, hi = lane >> 5, c31 = lane & 31, te_s = w & 3, td0 = w >> 2, td1 = 2 + (w >> 2);
    if (lat) { const float* s0 = A.in[I_ST] + ((((size_t)b * DEPTH + l) * 2 + dir) * HG + h) * (size_t)(DKV * DKV);
        const float* p0 = s0 + (32 * td0 + 4 * hi) * DKV + 32 * te_s + c31; const float* p1 = s0 + (32 * td1 + 4 * hi) * DKV + 32 * te_s + c31;
#pragma unroll
        for (int rg = 0; rg < 4; ++rg) {
#pragma unroll
            for (int x = 0; x < 4; ++x) { S0t[4 * rg + x] = p0[(8 * rg + x) * DKV]; S1t[4 * rg + x] = p1[(8 * rg + x) * DKV]; }
            asm volatile("" ::: "memory"); } }
    else {
#pragma unroll
        for (int r = 0; r < 16; ++r) { S0t[r] = 0.f; S1t[r] = 0.f; } }
    st_T(L + O_ST + 32 * te_s * SW + 32 * td0 * 2, SW, S0t, lane); st_T(L + O_ST + 32 * te_s * SW + 32 * td1 * 2, SW, S1t, lane); }
    v4u pq[2], pk[2], pv[2]; float pg = 0.f, pb = 0.f;
#define GDN_LOAD(c) do { _Pragma("unroll") for (int i_ = 0; i_ < 2; ++i_) { const int p_ = tid + 512 * i_, tl_ = 64 * (c) + (p_ >> 4), t_ = dir ? T - 1 - tl_ : tl_; const size_t off_ = (size_t)(row0 + t_) * GDN_W + 8 * (p_ & 15); \
        pq[i_] = *(const v4u*)(QG + off_); pk[i_] = *(const v4u*)(KG + off_); pv[i_] = *(const v4u*)(VG + off_); } \
        if (w == 0) { const int tl_ = 64 * (c) + lane, t_ = dir ? T - 1 - tl_ : tl_; pg = GGp[(size_t)(row0 + t_) * 16]; pb = BBp[(size_t)(row0 + t_) * 16]; } } while (0)
    { const int tid = tid0, w = w0, lane = tid0 & 63; GDN_LOAD(0); }
    for (int c = 0; c < NC; ++c) {
        int tid = tid0, w = w0; asm volatile("" : "+v"(tid)); asm volatile("" : "+s"(w));
        const int lane = tid & 63, hi = lane >> 5, c31 = lane & 31, te_s = w & 3, td0 = w >> 2, td1 = 2 + (w >> 2);
#pragma unroll
        for (int i = 0; i < 2; ++i) { const int p = tid + 512 * i, row = p >> 4, cb = p & 15;
            *(LAS v4u*)(L + O_QR + row * SW + cb * 16) = pq[i]; *(LAS v4u*)(L + O_KR + row * SW + cb * 16) = pk[i]; *(LAS v4u*)(L + O_VTMP + row * SW + cb * 16) = pv[i]; }
        if (w == 0) { float s = pg;
#pragma unroll
            for (int o = 1; o < 64; o <<= 1) { const float t = __shfl_up(s, o); if (lane >= o) s += t; }
            const float g63 = __shfl(s, 63), eg = __expf(s);
            *(LAS float*)(VEC + V_GC + 4 * lane) = s; *(LAS float*)(VEC + V_BE + 4 * lane) = pb; *(LAS float*)(VEC + V_EGC + 4 * lane) = eg; *(LAS float*)(VEC + V_BW + 4 * lane) = pb * eg;
            *(LAS float*)(VEC + V_SF + 4 * lane) = __expf(g63 - s); if (lane == 0) *(LAS float*)(VEC + V_EG63) = __expf(g63); }
        __syncthreads();
        if (c + 1 < NC) GDN_LOAD(c + 1);
#pragma unroll
        for (int n = 0; n < 4; ++n) { const int idx = 4 * n + (lane >> 4), rb = 2 * w + (idx >> 3), cbk = idx & 7, i16 = lane & 15, q = i16 >> 2, p = i16 & 3;
            const int so = (4 * rb + q) * SW + (16 * cbk + 4 * p) * 2, dof = (16 * cbk + i16) * SN + (4 * rb) * 2;
            const s16x4 kx = __builtin_bit_cast(s16x4, __builtin_amdgcn_ds_read_tr16_b64_v4i16((LAS s16x4*)(L + O_KR + so)));
            const s16x4 vx = __builtin_bit_cast(s16x4, __builtin_amdgcn_ds_read_tr16_b64_v4i16((LAS s16x4*)(L + O_VTMP + so)));
            *(LAS s16x4*)(L + O_KT + dof) = kx; *(LAS s16x4*)(L + O_VT + dof) = vx; }
        f32x16 Tt;
        constexpr int SB = 80;
        LAS unsigned char* W = L + O_LR + (w & 1) * 10240;
        LAS unsigned char* CRb = L + O_LR + 20480; LAS unsigned char* A32T = L + O_LR + 23040;
#pragma unroll
        for (int r = 0; r < 16; ++r) Tt[r] = 0.f;
        if (w < 3) {
            const int ti = (w == 0) ? 0 : 1, tj = (w == 1) ? 1 : 0; f32x16 acc;
#pragma unroll
            for (int r = 0; r < 16; ++r) acc[r] = 0.f;
            mma<8>(acc, L + O_KR + 32 * ti * SW, SW, L + O_KR + 32 * tj * SW, SW, lane);
            float gi[16], bi[16]; ldrow16(gi, VEC + V_GC, 32 * ti, hi); ldrow16(bi, VEC + V_BE, 32 * ti, hi);
            const float gj = *(LAS const float*)(VEC + V_GC + 4 * (32 * tj + c31)); const int j = 32 * tj + c31; f32x16 lv;
#pragma unroll
            for (int r = 0; r < 16; ++r) { const int i = 32 * ti + crow(r, hi); lv[r] = (i > j) ? bi[r] * acc[r] * __expf(gi[r] - gj) : 0.f; }
            if (w == 2) st_R(CRb, SB, lv, lane);
            else { const int jb = (lane >> 4) & 1; f32x16 ld, lo, z;
#pragma unroll
                for (int r = 0; r < 16; ++r) { const int ib = r >> 3; ld[r] = (ib == jb) ? lv[r] : 0.f; lo[r] = (ib == 1 && jb == 0) ? lv[r] : 0.f; Tt[r] = ((crow(r, hi) == c31) ? 1.f : 0.f) - ld[r]; }
                st_R(W, SB, ld, lane); st_T(W + 2560, SB, ld, lane); st_R(W + 5120, SB, Tt, lane); st_R(W + 7680, SB, lo, lane); LDS_WAIT();
#pragma unroll
                for (int r = 0; r < 16; ++r) z[r] = 0.f;
                mma<2>(z, W, SB, W + 2560, SB, lane); st_R(W, SB, z, lane); st_T(W + 2560, SB, z, lane); LDS_WAIT();
#pragma unroll
                for (int s2 = 0; s2 < 2; ++s2) { f32x16 z2;
#pragma unroll
                    for (int r = 0; r < 16; ++r) z2[r] = 0.f;
                    mma<2>(Tt, W + 5120, SB, W + 2560, SB, lane); mma<2>(z2, W, SB, W + 2560, SB, lane);
                    st_R(W + 5120, SB, Tt, lane); st_R(W, SB, z2, lane); st_T(W + 2560, SB, z2, lane); LDS_WAIT(); }
                mma<2>(Tt, W + 5120, SB, W + 2560, SB, lane); st_R(W + 5120, SB, Tt, lane); st_T(W + 2560, SB, Tt, lane); LDS_WAIT();
#pragma unroll
                for (int r = 0; r < 16; ++r) z[r] = 0.f;
                mma<2>(z, W + 7680, SB, W + 2560, SB, lane);
#pragma unroll
                for (int r = 0; r < 16; ++r) z[r] = -z[r];
                st_T(W, SB, z, lane); LDS_WAIT();
                mma<2>(Tt, W + 5120, SB, W, SB, lane);
                if (w == 0) st_T(A32T, SB, Tt, lane); else st_R(W + 5120, SB, Tt, lane); }
        } else if (w >= 4) { const int ti = (w >> 1) & 1, tj = w & 1; f32x16 acc;
#pragma unroll
            for (int r = 0; r < 16; ++r) acc[r] = 0.f;
            mma<8>(acc, L + O_QR + 32 * ti * SW, SW, L + O_KR + 32 * tj * SW, SW, lane);
            float gi[16]; ldrow16(gi, VEC + V_GC, 32 * ti, hi); const float gj = *(LAS const float*)(VEC + V_GC + 4 * (32 * tj + c31)); const int j = 32 * tj + c31; f32x16 av;
#pragma unroll
            for (int r = 0; r < 16; ++r) { const int i = 32 * ti + crow(r, hi); av[r] = (i >= j) ? acc[r] * __expf(gi[r] - gj) : 0.f; }
            st_R(L + O_AT + 32 * ti * SN + 32 * tj * 2, SN, av, lane); }
        __syncthreads();
        if (w == 2) { f32x16 y;
#pragma unroll
            for (int r = 0; r < 16; ++r) y[r] = 0.f;
            mma<2>(y, CRb, SB, A32T, SB, lane);
#pragma unroll
            for (int r = 0; r < 16; ++r) y[r] = -y[r];
            st_T(CRb, SB, y, lane); LDS_WAIT();
            mma<2>(Tt, L + O_LR + 10240 + 5120, SB, CRb, SB, lane); }
        __syncthreads();
        if (w < 4) { const int ti = (w == 0 || w == 3) ? 0 : 1, tj = (w == 1 || w == 3) ? 1 : 0;
            const float bj = *(LAS const float*)(VEC + V_BE + 4 * (32 * tj + c31)), bwj = *(LAS const float*)(VEC + V_BW + 4 * (32 * tj + c31)); f32x16 tu, tw;
#pragma unroll
            for (int r = 0; r < 16; ++r) { tu[r] = Tt[r] * bj; tw[r] = Tt[r] * bwj; }
            st_R(L + O_LR + 32 * ti * SN + 32 * tj * 2, SN, tu, lane); st_R(L + O_LR + 10240 + 32 * ti * SN + 32 * tj * 2, SN, tw, lane); }
        __syncthreads();
        const int ti = w >> 2, te = w & 3;
        f32x16 au, aw;
#pragma unroll
        for (int r = 0; r < 16; ++r) { au[r] = 0.f; aw[r] = 0.f; }
        mma<4>(au, L + O_LR + 32 * ti * SN, SN, L + O_VT + 32 * te * SN, SN, lane);
        mma<4>(aw, L + O_LR + 10240 + 32 * ti * SN, SN, L + O_KT + 32 * te * SN, SN, lane);
#pragma unroll
        for (int r = 0; r < 16; ++r) aw[r] = -aw[r];
        st_R(L + O_WR + 32 * ti * SW + 32 * te * 2, SW, aw, lane);
        __syncthreads();
        f32x16 aq;
#pragma unroll
        for (int r = 0; r < 16; ++r) aq[r] = 0.f;
        mma<8>(au, L + O_WR + 32 * ti * SW, SW, L + O_ST + 32 * te * SW, SW, lane);
        mma<8>(aq, L + O_QR + 32 * ti * SW, SW, L + O_ST + 32 * te * SW, SW, lane);
        { float sf[16]; ldrow16(sf, VEC + V_SF, 32 * ti, hi); f32x16 vs;
#pragma unroll
            for (int r = 0; r < 16; ++r) vs[r] = au[r] * sf[r];
            st_T(L + O_VNT + 32 * te * SN + 32 * ti * 2, SN, au, lane); st_T(L + O_VST + 32 * te * SN + 32 * ti * 2, SN, vs, lane); }
        __syncthreads();
        { float eg[16]; ldrow16(eg, VEC + V_EGC, 32 * ti, hi);
#pragma unroll
            for (int r = 0; r < 16; ++r) aq[r] *= eg[r];
            mma<4>(aq, L + O_AT + 32 * ti * SN, SN, L + O_VNT + 32 * te * SN, SN, lane);
#pragma unroll
            for (int r = 0; r < 16; ++r) { const int tl = 64 * c + 32 * ti + crow(r, hi), t = dir ? T - 1 - tl : tl; OD[(size_t)(row0 + t) * GDN_W + 32 * te + c31] = aq[r]; } }
        { const float e63 = *(LAS const float*)(VEC + V_EG63);
#pragma unroll
            for (int r = 0; r < 16; ++r) { S0t[r] *= e63; S1t[r] *= e63; }
            mma<4>(S0t, L + O_KT + 32 * td0 * SN, SN, L + O_VST + 32 * te_s * SN, SN, lane);
            mma<4>(S1t, L + O_KT + 32 * td1 * SN, SN, L + O_VST + 32 * te_s * SN, SN, lane);
            st_T(L + O_ST + 32 * te_s * SW + 32 * td0 * 2, SW, S0t, lane); st_T(L + O_ST + 32 * te_s * SW + 32 * td1 * 2, SW, S1t, lane); }
        __syncthreads();
    }
#undef GDN_LOAD
    int tid2 = tid0, w = w0; asm volatile("" : "+v"(tid2)); asm volatile("" : "+s"(w));
    const int lane = tid2 & 63, hi = lane >> 5, c31 = lane & 31, te_s = w & 3, td0 = w >> 2, td1 = 2 + (w >> 2);
    if (!lat) { float* so = F.out + OUT_ST + ((((size_t)b * DEPTH + l) * 2 + dir) * HG + h) * (size_t)(DKV * DKV);
        float* p0 = so + (32 * td0 + 4 * hi) * DKV + 32 * te_s + c31; float* p1 = so + (32 * td1 + 4 * hi) * DKV + 32 * te_s + c31;
#pragma unroll
        for (int rg = 0; rg < 4; ++rg) {
#pragma unroll
            for (int x = 0; x < 4; ++x) { p0[(8 * rg + x) * DKV] = S0t[4 * rg + x]; p1[(8 * rg + x) * DKV] = S1t[4 * rg + x]; }
            asm volatile("" ::: "memory"); } }
}
__device__ __forceinline__ void phase(ARGS_T& A, Frame& F, int l) {
    if (F.G > 2 * NCHAIN_LAT) { if (F.bx < NCHAIN_LAT) chain(A, F, l, F.bx); else for (int c = NCHAIN_LAT + (F.bx - NCHAIN_LAT); c < NCHAIN; c += F.G - NCHAIN_LAT) chain(A, F, l, c); }
    else for (int c = F.bx; c < NCHAIN; c += F.G) chain(A, F, l, c);
}
}

constexpr int PH_PER_LAYER = 10, N_PHASES = 2 + DEPTH * PH_PER_LAYER;
extern __shared__ __attribute__((aligned(16))) unsigned char lds[];
__device__ __forceinline__ void frame_init(Frame& F, ARGS_T& A) {
    F.lds = (LAS unsigned char*)lds; F.MISC = (volatile LAS unsigned*)(F.lds + MISC_OFF);
    F.tid = fresh_tid(); F.lane = F.tid & 63; F.wave = __builtin_amdgcn_readfirstlane(F.tid >> 6);
    F.G = gridDim.x; F.bx = fresh_bx(); F.vcu = (F.G % 8 == 0) ? (F.bx % 8) * (F.G / 8) + F.bx / 8 : F.bx;
    F.out = A.out; F.ws = A.ws; F.ctl = (gu32*)(A.ws + WS_CTL);
}
template <int LO, int HI>
__global__ void __launch_bounds__(NWAVES * 64, 2) trunk_fwd(Args args_unused) {
    { const int t0 = fresh_tid(); for (int u = t0; u < (LDS_BYTES - LDSCTL_OFF) / 4; u += NWAVES * 64) ((LAS unsigned*)((LAS unsigned char*)lds + LDSCTL_OFF))[u] = 0u; }
    __syncthreads();
    if (HI - LO > 1) { ARGS_T& A = *fresh_args(); (void)xcd_barrier_post((unsigned*)(A.ws + WS_CTL) + CW_BAR, (volatile LAS unsigned*)((LAS unsigned char*)lds + MISC_OFF) + 8); }
#define IN(k) (LO <= (k) && (k) < HI)
#define SEAM(k) do { if (IN(k) && IN((k) + 1)) { ARGS_T& A_ = *fresh_args(); XcdBarrier bar_; bar_.bar = (unsigned*)(A_.ws + WS_CTL) + CW_BAR; bar_.x = xb_xcc_id(); bar_.st = (volatile LAS unsigned*)((LAS unsigned char*)lds + MISC_OFF) + 8; xcd_barrier(bar_); } } while (0)
#define PHASE_BEGIN ARGS_T& A = *fresh_args(); Frame F; frame_init(F, A);
#if MK_DIAG
#define STAMP(k) do { if (blockIdx.x == 0 && threadIdx.x == 0) ((volatile LAS unsigned long long*)((LAS unsigned char*)lds + LDSCTL_OFF))[(k) + 1] = __builtin_amdgcn_s_memrealtime(); } while (0)
    if (blockIdx.x == 0 && threadIdx.x == 0) ((volatile LAS unsigned long long*)((LAS unsigned char*)lds + LDSCTL_OFF))[0] = __builtin_amdgcn_s_memrealtime();
#else
#define STAMP(k) do { } while (0)
#endif

    if (IN(0)) { PHASE_BEGIN p0a_phase(A, F); } SEAM(0); STAMP(0);
    if (IN(1)) { PHASE_BEGIN p0b_phase(A, F); } SEAM(1); STAMP(1);
#pragma unroll
    for (int l = 0; l < DEPTH; ++l) {
        const int pb = 2 + l * PH_PER_LAYER;
        constexpr size_t MODL = 3 * 12288;
        if (IN(pb + 0)) { PHASE_BEGIN pg8::Gemm g{WSP(bf16, WS_H), WSP(bf16, WS_WIN) + (size_t)l * IN_WP * DM, M, IN_WP, DM}; pg8::StaticOrder S; S.init(M, IN_WP, F.G, F.bx, DM);
            pg8::EpiBf16 E{WSP(bf16, WS_PROJ), IN_WP};
            pg8::gemm_phase<DM, pg8::EpiBf16, pg8::StaticOrder, true, true>(F.lds + RING_OFF, g, S, E); }
        SEAM(pb + 0); STAMP(pb + 0);
        if (IN(pb + 1)) { PHASE_BEGIN prep_phase(A, F, l); } SEAM(pb + 1); STAMP(pb + 1);
#if MK_GDN_REC
        if (IN(pb + 2)) { PHASE_BEGIN for (int it = F.bx; it < GDN_ITEMS; it += F.G) gdn_rec_item(A, F, l, it < 8 ? GDN_ITEMS_CTX + it : it - 8); }
#else
        if (IN(pb + 2)) { PHASE_BEGIN gdn::phase(A, F, l); }
#endif
        SEAM(pb + 2); STAMP(pb + 2);
        if (IN(pb + 3)) { PHASE_BEGIN for (int it = F.bx; it < ATT_UNITS; it += F.G) attn_unit(F, it, (char*)lds + RING_OFF); }
        SEAM(pb + 3); STAMP(pb + 3);
        if (IN(pb + 4)) { PHASE_BEGIN combine_phase(A, F, l); } SEAM(pb + 4); STAMP(pb + 4);
        if (IN(pb + 5)) { PHASE_BEGIN pg8::Gemm g{WSP(bf16, WS_MIX), WSP(bf16, WS_WO) + (size_t)l * DM * DM, M, DM, DM}; pg8::TailOrder S; S.init(F.G, F.bx, DM);
            const float* mod = WSP(float, WS_MOD) + (size_t)l * MODL;
            pg8::EpiResid E{l == 0 ? A.in[I_XP] : F.out, F.out, mod + 2 * DM, DN_ALPHA, WSP(float, WS_PART)};
            pg8::gemm_phase<DM, pg8::EpiResid, pg8::TailOrder, true, true>(F.lds + RING_OFF, g, S, E); }
        SEAM(pb + 5); STAMP(pb + 5);
        if (IN(pb + 6)) { PHASE_BEGIN const float* mod = WSP(float, WS_MOD) + (size_t)l * MODL; ln_phase(A, F, A.in[I_LN1G] + l * DM, A.in[I_LN1B] + l * DM, mod + 3 * DM, mod + 4 * DM, true, WSP(float, WS_PART), l == 0 ? A.in[I_XS] : F.out + (size_t)M_CTX * DM, mod + 2 * DM, DN_ALPHA); } SEAM(pb + 6); STAMP(pb + 6);
        if (IN(pb + 7)) { PHASE_BEGIN pg8::Gemm g{WSP(bf16, WS_H), WSP(bf16, WS_WGU) + (size_t)l * 2 * DFF * DM, M, 2 * DFF, DM}; pg8::StaticOrder S; S.init(M, 2 * DFF, F.G, F.bx, DM);
            pg8::EpiSwiGLU E{WSP(bf16, WS_PROJ), DFF};
            pg8::gemm_phase<DM, pg8::EpiSwiGLU, pg8::StaticOrder, true, true>(F.lds + RING_OFF, g, S, E); }
        SEAM(pb + 7); STAMP(pb + 7);
        if (IN(pb + 8)) { PHASE_BEGIN pg8::Gemm g{WSP(bf16, WS_PROJ), WSP(bf16, WS_WD) + (size_t)l * DM * DFF, M, DM, DFF}; pg8::TailOrder S; S.init(F.G, F.bx, DFF);
            const float* mod = WSP(float, WS_MOD) + (size_t)l * MODL;
            pg8::EpiResid E{F.out, F.out, mod + 5 * DM, DN_ALPHA, WSP(float, WS_PART)};
            pg8::gemm_phase<DFF, pg8::EpiResid, pg8::TailOrder, true, true>(F.lds + RING_OFF, g, S, E); }
        SEAM(pb + 8); STAMP(pb + 8);
        if (IN(pb + 9)) { PHASE_BEGIN const float* modn = WSP(float, WS_MOD) + (size_t)(l + 1) * MODL; const float* mod = WSP(float, WS_MOD) + (size_t)l * MODL;
            ln_phase(A, F, A.in[I_LN2G] + l * DM, A.in[I_LN2B] + l * DM, modn, modn + DM, l + 1 < DEPTH, WSP(float, WS_PART), F.out + (size_t)M_CTX * DM, mod + 5 * DM, DN_ALPHA); }
        if (l + 1 < DEPTH) SEAM(pb + 9);
        STAMP(pb + 9);
    }
#if MK_DIAG
    if (blockIdx.x == 0 && threadIdx.x == 0) {
        volatile LAS unsigned long long* st = (volatile LAS unsigned long long*)((LAS unsigned char*)lds + LDSCTL_OFF);
        unsigned long long tot = 0;
        for (int k = 0; k < N_PHASES; ++k) { const int ty = k < 2 ? k : 2 + (k - 2) % PH_PER_LAYER; if (ty == MK_DIAG_A || MK_DIAG_A == 99) tot += st[k + 1] - st[k]; }
        const unsigned long long t0 = __builtin_amdgcn_s_memrealtime();
        while (__builtin_amdgcn_s_memrealtime() - t0 < 4 * tot) __builtin_amdgcn_s_sleep(8);
    }
#endif
#undef IN
#undef SEAM
#undef PHASE_BEGIN
}

typedef void (*kfn_t)(Args);
template <int... P> static void fill_fns(kfn_t* f, std::integer_sequence<int, P...>) { ((f[P] = trunk_fwd<P, P + 1>), ...); }
extern "C" void kernel_launch(void* const* d_in, const int* in_sizes, int n_in, void* d_out, int out_size, void* d_ws, size_t ws_size, hipStream_t stream) {
    static int grid = 0; static kfn_t fns[N_PHASES + 1];
    if (grid == 0) {
        if (n_in != N_IN || in_sizes[I_XP] != M_CTX * DM || in_sizes[I_XS] != M_LAT * DM || (size_t)out_size != OUT_TOTAL || ws_size < WS_END) {
            fprintf(stderr, "kernel_launch: shape mismatch n_in %d out %d ws %zu (need %zu)\n", n_in, out_size, ws_size, (size_t)WS_END); grid = -1; return; }
        int dev = 0, cus = 0;
        if (hipGetDevice(&dev) != hipSuccess || hipDeviceGetAttribute(&cus, hipDeviceAttributeMultiprocessorCount, dev) != hipSuccess) { grid = -1; return; }
#if MK_PER_PHASE
        fill_fns(fns, std::make_integer_sequence<int, N_PHASES>{});
        for (int p = 0; p < N_PHASES; ++p)
            if (hipFuncSetAttribute((const void*)fns[p], hipFuncAttributeMaxDynamicSharedMemorySize, LDS_BYTES) != hipSuccess) { fprintf(stderr, "kernel_launch: hipFuncSetAttribute failed (phase %d)\n", p); grid = -1; return; }
#else
        fns[N_PHASES] = trunk_fwd<0, N_PHASES>;
        if (hipFuncSetAttribute((const void*)fns[N_PHASES], hipFuncAttributeMaxDynamicSharedMemorySize, LDS_BYTES) != hipSuccess) { fprintf(stderr, "kernel_launch: hipFuncSetAttribute failed\n"); grid = -1; return; }
#endif
        (void)hipGetLastError();
        grid = cus;
    }
    if (grid < 0) return;
    if (hipMemsetAsync((char*)d_ws + WS_CTL, 0, CTL_ZERO_BYTES, stream) != hipSuccess) { fprintf(stderr, "kernel_launch: hipMemsetAsync failed\n"); return; }
    Args a{};
    for (int i = 0; i < N_IN; ++i) a.in[i] = (const float*)d_in[i];
    a.out = (float*)d_out; a.ws = (unsigned char*)d_ws;
#if MK_PER_PHASE
    for (int p = 0; p < N_PHASES; ++p) {
        hipLaunchKernelGGL(fns[p], dim3(grid), dim3(NWAVES * 64), LDS_BYTES, stream, a);
        const hipError_t le = hipPeekAtLastError(); if (le != hipSuccess) { fprintf(stderr, "kernel_launch: launch %d failed: %s\n", p, hipGetErrorName(le)); break; } }
#else
    hipLaunchKernelGGL(fns[N_PHASES], dim3(grid), dim3(NWAVES * 64), LDS_BYTES, stream, a);
    { const hipError_t le = hipPeekAtLastError(); if (le != hipSuccess) fprintf(stderr, "kernel_launch: launch failed: %s\n", hipGetErrorName(le)); }
#endif
}
```

```cpp
#include <hip/hip_runtime.h>
#include <hip/hip_bf16.h>
#include <cstdio>
#include <cstdint>
#include <cmath>
#include <utility>
namespace pg8 {
#define PG8_LAS __attribute__((address_space(3)))
typedef unsigned short bf16_t;
typedef short bf16x8 __attribute__((ext_vector_type(8)));
typedef float f32x4 __attribute__((ext_vector_type(4)));
typedef unsigned u32x4 __attribute__((ext_vector_type(4)));
constexpr int BM = 256, BK = 64, HALF = 128, HTB = HALF * BK * 2  , STAGE_BYTES = 8 * HTB, NXCD = 8, WGM = 8;

__host__ __device__ __forceinline__ int lds_byte(int r, int c) { const int st = (r >> 4) * 2 + (c >> 5), rr = r & 15, cc = c & 31, ob = rr * 64 + cc * 2; return st * 1024 + (ob ^ (((ob >> 9) & 1) << 5)); }
__host__ __device__ __forceinline__ void stage_rc(int b, int& R, int& C) { const int st = b / 1024, sb = b % 1024, swz = sb ^ (((sb >> 9) & 1) << 5); R = (st >> 1) * 16 + swz / 64; C = (st & 1) * 32 + (swz % 64) / 2; }
__host__ __device__ __forceinline__ int perm32(int rho) { const int n = rho >> 4, i = rho & 15; return 8 * (i >> 2) + 4 * n + (i & 3); }

struct Unit { int pm, pn, k0, nt, sp; };
struct Gemm { const bf16_t* A; const bf16_t* Bt; int M, N, K; };

struct StaticOrder {
    int nM, nN, nwg, G, c, ntk;
    __host__ __device__ void init(int M, int N, int G_, int c_, int K) { nM = M / BM; nN = N / BM; nwg = nM * nN; G = G_; c = c_; ntk = K / BK; }
    __host__ __device__ bool next(int i, Unit& u) const {
        const long L = (long)i * G + c; if (L >= nwg) return false;
        int wgid = (int)L; { const int q = nwg / NXCD, r = nwg % NXCD, xcd = wgid % NXCD, off = wgid / NXCD; wgid = (xcd < r ? xcd * (q + 1) : r * (q + 1) + (xcd - r) * q) + off; }
        const int nig = WGM * nN, gid = wgid / nig, fm = gid * WGM, gsz = (nM - fm) < WGM ? (nM - fm) : WGM;
        u.pm = fm + ((wgid % nig) % gsz); u.pn = (wgid % nig) / gsz; u.k0 = 0; u.nt = ntk; u.sp = -1; return true;
    }
    __device__ __forceinline__ void a_ready(const Unit&) const {}
    __device__ __forceinline__ void done(const Unit&) const {}
};
struct TailOrder {
    int G, c, ntk;
    __host__ __device__ void init(int G_, int c_, int K) { G = G_; c = c_; ntk = K / BK; }
    __host__ __device__ bool next(int i, Unit& u) const {
        const int L = i * G + c; if (L >= 512) return false;
        const int f = L & 255, xcd = f & 7, idx = f >> 3;
        const bool whole = L < 256; const int q = ntk >> 2, sp = idx >> 3;
        u.pm = whole ? 4 * xcd + (idx & 3) : 32 + xcd; u.pn = whole ? (idx >> 2) : (idx & 7); u.sp = whole ? -1 : sp; u.nt = whole ? ntk : q; u.k0 = whole ? 0 : sp * q * BK;
        return true;
    }
    __device__ __forceinline__ void a_ready(const Unit&) const {}
    __device__ __forceinline__ void done(const Unit&) const {}
};


__device__ __forceinline__ unsigned cvt_pk_bf16(float lo, float hi) { unsigned r; asm volatile("v_cvt_pk_bf16_f32 %0, %1, %2" : "=v"(r) : "v"(lo), "v"(hi)); return r; }
__device__ __forceinline__ float silu_f(float x) { return x * __builtin_amdgcn_rcpf(1.0f + __builtin_amdgcn_exp2f(-1.4426950408889634f * x)); }

struct EpiBf16 {
    static constexpr bool PERM = true, AFTER_DRAIN = false;
    bf16_t* O; int ldc;
    __device__ __forceinline__ void operator()(const f32x4 (&acc)[2][2][4][2], const Unit& u, int wr, int wc, int fr, int fq) const {
        const int row0 = u.pm * BM + wr * 64 + fr; const int col0 = u.pn * BM + wc * 32 + 8 * fq;
#pragma unroll
        for (int ai = 0; ai < 2; ++ai)
#pragma unroll
            for (int m = 0; m < 4; ++m) { bf16_t* rowp = O + (size_t)(row0 + ai * HALF + m * 16) * ldc + col0;
#pragma unroll
                for (int bj = 0; bj < 2; ++bj) { const f32x4 v0 = acc[ai][bj][m][0], v1 = acc[ai][bj][m][1];
                    u32x4 w; w.x = cvt_pk_bf16(v0[0], v0[1]); w.y = cvt_pk_bf16(v0[2], v0[3]); w.z = cvt_pk_bf16(v1[0], v1[1]); w.w = cvt_pk_bf16(v1[2], v1[3]);
                    *(u32x4*)(rowp + bj * HALF) = w; } }
    }
};
struct EpiSwiGLU {
    static constexpr bool PERM = true, AFTER_DRAIN = false;
    bf16_t* O; int ldc;
    __device__ __forceinline__ void operator()(const f32x4 (&acc)[2][2][4][2], const Unit& u, int wr, int wc, int fr, int fq) const {
        const int row0 = u.pm * BM + wr * 64 + fr; const int col0 = u.pn * HALF + wc * 32 + 8 * fq;
#pragma unroll
        for (int ai = 0; ai < 2; ++ai)
#pragma unroll
            for (int m = 0; m < 4; ++m) { bf16_t* rowp = O + (size_t)(row0 + ai * HALF + m * 16) * ldc + col0;
                const f32x4 g0 = acc[ai][0][m][0], g1 = acc[ai][0][m][1], u0 = acc[ai][1][m][0], u1 = acc[ai][1][m][1];
                u32x4 w;
                w.x = cvt_pk_bf16(silu_f(g0[0]) * u0[0], silu_f(g0[1]) * u0[1]); w.y = cvt_pk_bf16(silu_f(g0[2]) * u0[2], silu_f(g0[3]) * u0[3]);
                w.z = cvt_pk_bf16(silu_f(g1[0]) * u1[0], silu_f(g1[1]) * u1[1]); w.w = cvt_pk_bf16(silu_f(g1[2]) * u1[2], silu_f(g1[3]) * u1[3]);
                *(u32x4*)rowp = w; }
    }
};
struct EpiResid {
    static constexpr bool PERM = false, AFTER_DRAIN = false;
    const float* xp; float* X; const float* gate; float alpha; float* part;
    __device__ __forceinline__ void operator()(const f32x4 (&acc)[2][2][4][2], const Unit& u, int wr, int wc, int fr, int fq) const {
        const int col0 = u.pn * BM + wc * 32 + 4 * fq;
        if (u.sp >= 0) {
#pragma unroll
            for (int ai = 0; ai < 2; ++ai)
#pragma unroll
                for (int m = 0; m < 4; ++m) { const int row = (u.pm - 32) * BM + ai * HALF + wr * 64 + m * 16 + fr; float* dst = part + ((size_t)u.sp * 2048 + row) * 2048 + col0;
#pragma unroll
                    for (int bj = 0; bj < 2; ++bj)
#pragma unroll
                        for (int n = 0; n < 2; ++n) *(f32x4*)(dst + bj * HALF + n * 16) = acc[ai][bj][m][n]; }
            return; }
        f32x4 gv[2][2];
#pragma unroll
        for (int bj = 0; bj < 2; ++bj)
#pragma unroll
            for (int n = 0; n < 2; ++n) gv[bj][n] = *(const f32x4*)(gate + col0 + bj * HALF + n * 16);
#pragma unroll
        for (int ai = 0; ai < 2; ++ai)
#pragma unroll
            for (int m = 0; m < 4; ++m) { const int row = u.pm * BM + ai * HALF + wr * 64 + m * 16 + fr;
                const float* src = xp + (size_t)row * 2048 + col0; float* dst = X + (size_t)row * 2048 + col0;
#pragma unroll
                for (int bj = 0; bj < 2; ++bj)
#pragma unroll
                    for (int n = 0; n < 2; ++n) { const f32x4 xin = *(const f32x4*)(src + bj * HALF + n * 16);
                        *(f32x4*)(dst + bj * HALF + n * 16) = xin * alpha + gv[bj][n] * acc[ai][bj][m][n]; } }
    }
};

template <int KK, class Epi, class Sched, bool ALIGN_EPI = false, bool SP2 = false>
__device__ __forceinline__ void gemm_phase(PG8_LAS unsigned char* lds, const Gemm g, const Sched& S, const Epi& E) {
    int tid_ = threadIdx.x; asm volatile("" : "+v"(tid_)); const int tid = tid_, wid = __builtin_amdgcn_readfirstlane(tid >> 6), lane = tid & 63, wr = wid >> 2, wc = wid & 3, fr = lane & 15, fq = lane >> 4;
    constexpr int K = KK;
    unsigned voffA[2], voffB[2];
#pragma unroll
    for (int i = 0; i < 2; ++i) { int R, C; stage_rc(tid * 16 + i * 8192, R, C); const int Rb = Epi::PERM ? ((R & ~31) + perm32(R & 31)) : R;
        voffA[i] = (unsigned)(R * K + C) * 2u; voffB[i] = (unsigned)(Rb * K + C) * 2u; }
    const size_t kstep = (size_t)(BK * 2);
    const size_t hstep = (size_t)HALF * K * 2;
    const size_t tstep = 2 * hstep;
    const unsigned ldsw = (unsigned)wid * 1024u;
    const int aoff = lds_byte(wr * 64 + fr, fq * 8), boff = lds_byte(wc * 32 + fr, fq * 8);
#define PG8_SA(b, h) (((b) * 2 + (h)) * HTB)
#define PG8_SB(b, h) ((4 + (b) * 2 + (h)) * HTB)
#define PG8_STAGE(bufoff, gbase, voff) do { _Pragma("unroll") for (int _i = 0; _i < 2; ++_i) \
        __builtin_amdgcn_global_load_lds((const unsigned*)((const char*)(gbase) + (voff)[_i]), (PG8_LAS unsigned*)(lds + (bufoff) + ldsw + _i * 8192), 16, 0, 0); } while (0)
#define PG8_LDA(dst, b, h) do { _Pragma("unroll") for (int m = 0; m < 4; ++m) _Pragma("unroll") for (int k = 0; k < 2; ++k) dst[m][k] = *(const PG8_LAS bf16x8*)(lds + PG8_SA(b, h) + aoff + m * 2048 + k * 1024); } while (0)
#define PG8_LDB(dst, b, h) do { _Pragma("unroll") for (int n = 0; n < 2; ++n) _Pragma("unroll") for (int k = 0; k < 2; ++k) dst[n][k] = *(const PG8_LAS bf16x8*)(lds + PG8_SB(b, h) + boff + n * 2048 + k * 1024); } while (0)
#define PG8_MMA(ai, bj, At, Bt) do { __builtin_amdgcn_s_setprio(1); _Pragma("unroll") for (int m = 0; m < 4; ++m) _Pragma("unroll") for (int n = 0; n < 2; ++n) _Pragma("unroll") for (int k = 0; k < 2; ++k) \
        acc[ai][bj][m][n] = __builtin_amdgcn_mfma_f32_16x16x32_bf16(Bt[n][k], At[m][k], acc[ai][bj][m][n], 0, 0, 0); __builtin_amdgcn_s_setprio(0); } while (0)
#define PG8_WAIT_V(n) asm volatile("s_waitcnt vmcnt(" #n ")" ::: "memory")
#define PG8_WAIT_L(n) asm volatile("s_waitcnt lgkmcnt(" #n ")" ::: "memory")
#define PG8_BAR __builtin_amdgcn_s_barrier()
#define PG8_SCHED __builtin_amdgcn_sched_barrier(0)
    Unit cur, nxt; int ui = 0;
    if (!S.next(0, cur)) return;
    f32x4 acc[2][2][4][2];
#pragma unroll
    for (int a = 0; a < 2; ++a)
#pragma unroll
        for (int b = 0; b < 2; ++b)
#pragma unroll
            for (int m = 0; m < 4; ++m)
#pragma unroll
                for (int n = 0; n < 2; ++n) acc[a][b][m][n] = (f32x4){0.f, 0.f, 0.f, 0.f};
    bf16x8 At[4][2], B0[2][2], B1[2][2];
    const char* cA = (const char*)g.A + (size_t)cur.pm * tstep + (size_t)cur.k0 * 2; const char* cB = (const char*)g.Bt + (size_t)cur.pn * tstep + (size_t)cur.k0 * 2;
    S.a_ready(cur);
    if constexpr (SP2) {
        PG8_STAGE(PG8_SB(0, 0), cB, voffB); PG8_STAGE(PG8_SB(0, 1), cB + hstep, voffB); PG8_STAGE(PG8_SA(0, 0), cA, voffA); PG8_STAGE(PG8_SA(0, 1), cA + hstep, voffA);
        if (wr == 1) PG8_BAR;
        PG8_WAIT_V(2); PG8_BAR;
        PG8_STAGE(PG8_SB(1, 0), cB + kstep, voffB); PG8_STAGE(PG8_SA(1, 0), cA + kstep, voffA); PG8_STAGE(PG8_SB(1, 1), cB + hstep + kstep, voffB);
        PG8_WAIT_V(6); PG8_BAR;
    } else {
        PG8_STAGE(PG8_SB(0, 0), cB, voffB); PG8_STAGE(PG8_SA(0, 0), cA, voffA); PG8_STAGE(PG8_SB(0, 1), cB + hstep, voffB); PG8_STAGE(PG8_SA(0, 1), cA + hstep, voffA);
        if (wr == 1) PG8_BAR;
        PG8_WAIT_V(4); PG8_BAR;
        PG8_STAGE(PG8_SB(1, 0), cB + kstep, voffB); PG8_STAGE(PG8_SA(1, 0), cA + kstep, voffA); PG8_STAGE(PG8_SB(1, 1), cB + hstep + kstep, voffB);
        PG8_WAIT_V(6); PG8_BAR;
    }
    for (;;) {
        const bool has_next = S.next(ui + 1, nxt);
        const char* nA = has_next ? (const char*)g.A + (size_t)nxt.pm * tstep + (size_t)nxt.k0 * 2 : cA; const char* nB = has_next ? (const char*)g.Bt + (size_t)nxt.pn * tstep + (size_t)nxt.k0 * 2 : cB;
        const int nt = cur.nt;
        for (int t = 0; t < nt; t += 2) {
            const bool last = (t == nt - 2);
            const char* a1 = cA + (size_t)(t + 1) * kstep;
            const char* a2 = last ? nA : cA + (size_t)(t + 2) * kstep; const char* b2 = last ? nB : cB + (size_t)(t + 2) * kstep;
            const char* a3 = a2 + kstep; const char* b3 = b2 + kstep;
            if (last && has_next) S.a_ready(nxt);
            if constexpr (SP2) {
            PG8_LDB(B0, 0, 0); PG8_LDB(B1, 0, 1); PG8_SCHED; PG8_LDA(At, 0, 0); PG8_STAGE(PG8_SA(1, 1), a1 + hstep, voffA);
            PG8_WAIT_V(8); PG8_WAIT_L(0); PG8_BAR; PG8_MMA(0, 0, At, B0); PG8_MMA(0, 1, At, B1); PG8_BAR; PG8_SCHED;
            PG8_LDA(At, 0, 1); PG8_STAGE(PG8_SB(0, 0), b2, voffB); PG8_STAGE(PG8_SB(0, 1), b2 + hstep, voffB); PG8_STAGE(PG8_SA(0, 0), a2, voffA);
            PG8_WAIT_V(8); PG8_WAIT_L(0); PG8_BAR; PG8_MMA(1, 0, At, B0); PG8_MMA(1, 1, At, B1); PG8_BAR; PG8_SCHED;
            PG8_LDB(B0, 1, 0); PG8_LDB(B1, 1, 1); PG8_SCHED; PG8_LDA(At, 1, 0); PG8_STAGE(PG8_SA(0, 1), a2 + hstep, voffA);
            PG8_WAIT_V(8); PG8_WAIT_L(0); PG8_BAR; PG8_MMA(0, 0, At, B0); PG8_MMA(0, 1, At, B1); PG8_BAR; PG8_SCHED;
            PG8_LDA(At, 1, 1); PG8_STAGE(PG8_SB(1, 0), b3, voffB); PG8_STAGE(PG8_SB(1, 1), b3 + hstep, voffB); PG8_STAGE(PG8_SA(1, 0), a3, voffA);
            PG8_WAIT_V(8); PG8_WAIT_L(0); PG8_BAR; PG8_MMA(1, 0, At, B0); PG8_MMA(1, 1, At, B1); PG8_BAR; PG8_SCHED;
            } else {
            PG8_LDB(B0, 0, 0); PG8_SCHED; PG8_LDA(At, 0, 0); PG8_STAGE(PG8_SA(1, 1), a1 + hstep, voffA);
            PG8_WAIT_L(8); PG8_BAR; PG8_WAIT_L(0); PG8_MMA(0, 0, At, B0); PG8_BAR; PG8_SCHED;
            PG8_LDB(B1, 0, 1); PG8_STAGE(PG8_SB(0, 0), b2, voffB);
            PG8_BAR; PG8_WAIT_L(0); PG8_MMA(0, 1, At, B1); PG8_BAR;
            PG8_LDA(At, 0, 1); PG8_STAGE(PG8_SA(0, 0), a2, voffA);
            PG8_BAR; PG8_WAIT_L(0); PG8_MMA(1, 0, At, B0); PG8_BAR; PG8_SCHED;
            PG8_STAGE(PG8_SB(0, 1), b2 + hstep, voffB);
            PG8_WAIT_V(6); PG8_BAR; PG8_MMA(1, 1, At, B1); PG8_BAR;
            PG8_LDB(B0, 1, 0); PG8_SCHED; PG8_LDA(At, 1, 0); PG8_STAGE(PG8_SA(0, 1), a2 + hstep, voffA);
            PG8_WAIT_L(8); PG8_BAR; PG8_WAIT_L(0); PG8_MMA(0, 0, At, B0); PG8_BAR; PG8_SCHED;
            PG8_LDB(B1, 1, 1); PG8_STAGE(PG8_SB(1, 0), b3, voffB);
            PG8_BAR; PG8_WAIT_L(0); PG8_MMA(0, 1, At, B1); PG8_BAR;
            PG8_LDA(At, 1, 1); PG8_STAGE(PG8_SA(1, 0), a3, voffA);
            PG8_BAR; PG8_WAIT_L(0); PG8_MMA(1, 0, At, B0); PG8_BAR; PG8_SCHED;
            PG8_STAGE(PG8_SB(1, 1), b3 + hstep, voffB);
            PG8_WAIT_V(6); PG8_BAR; PG8_MMA(1, 1, At, B1); PG8_BAR;
            }
        }
        if constexpr (ALIGN_EPI) { if (wr == 0) PG8_BAR; }
        if constexpr (!Epi::AFTER_DRAIN) { E(acc, cur, wr, wc, fr, fq); S.done(cur); }
        if (!has_next) break;
#pragma unroll
        for (int a = 0; a < 2; ++a)
#pragma unroll
            for (int b = 0; b < 2; ++b)
#pragma unroll
                for (int m = 0; m < 4; ++m)
#pragma unroll
                    for (int n = 0; n < 2; ++n) acc[a][b][m][n] = (f32x4){0.f, 0.f, 0.f, 0.f};
        cur = nxt; cA = nA; cB = nB; ++ui;
        if constexpr (ALIGN_EPI) { if (wr == 1) PG8_BAR; }
    }
    PG8_WAIT_V(0);
    if constexpr (!ALIGN_EPI) { if (wr == 0) PG8_BAR; }
    PG8_BAR;
    if constexpr (Epi::AFTER_DRAIN) { E.fused(acc, cur, wr, wc, fr, fq, lds, wid, lane); S.done(cur); }
#undef PG8_SA
#undef PG8_SB
#undef PG8_STAGE
#undef PG8_LDA
#undef PG8_LDB
#undef PG8_MMA
#undef PG8_WAIT_V
#undef PG8_WAIT_L
#undef PG8_BAR
#undef PG8_SCHED
}
}

namespace att {
using bf16 = __hip_bfloat16;
constexpr int   D = 128, NW = 8, QBLK = 32, KVBLK = 64;
constexpr float SCALE = 0.088388347648318440f;
constexpr float THR = 8.f;
constexpr int SDEPTH = 2;
constexpr int LDQ = 1024, LDK = 256, LDO = 2048;
using bf16x8 = __attribute__((ext_vector_type(8))) short;
using s16x4  = __attribute__((ext_vector_type(4))) short;
using f32x16 = __attribute__((ext_vector_type(16))) float;
using f32x8  = __attribute__((ext_vector_type(8))) float;
using u32x4  = __attribute__((ext_vector_type(4))) unsigned;
constexpr size_t SHM_V = KVBLK * D * 2, SHM_K = KVBLK * D * 2, SHM_ATTN = 2 * SHM_V + 2 * SHM_K + NW * 64 * 4;
#define KSWZ(row, colB) ((row) * 256 + ((colB) ^ (((row) & 7) << 4)))
#define SBAR() __builtin_amdgcn_sched_barrier(0)
__device__ __forceinline__ int crow(int r, int hi) { return (r & 3) + 8 * (r >> 2) + 4 * hi; }
__device__ __forceinline__ unsigned cvtpk(float lo, float hi) {
  unsigned r; asm volatile("v_cvt_pk_bf16_f32 %0, %1, %2" : "=v"(r) : "v"(lo), "v"(hi)); return r;
}
template <typename TIn> struct Stage;
template <> struct Stage<bf16>  { using T = bf16x8;
  __device__ static __forceinline__ T ld8(const bf16* p) { return *reinterpret_cast<const bf16x8*>(p); }
  __device__ static __forceinline__ bf16x8 tobf(T x) { return x; } };
template <> struct Stage<float> { using T = f32x8;
  __device__ static __forceinline__ T ld8(const float* p) { return *reinterpret_cast<const f32x8*>(p); }
  __device__ static __forceinline__ bf16x8 tobf(T x) {
    u32x4 w = {cvtpk(x[0], x[1]), cvtpk(x[2], x[3]), cvtpk(x[4], x[5]), cvtpk(x[6], x[7])}; return *reinterpret_cast<bf16x8*>(&w); } };

__device__ __forceinline__ void partialSM(f32x16& p0, f32x16& p1, float& m_reg, float& mn, float& alpha) {
  constexpr float C = SCALE * 1.4426950408889634f;
  float pmax = p0[0]; for (int r = 1; r < 16; ++r) pmax = fmaxf(pmax, p0[r]); for (int r = 0; r < 16; ++r) pmax = fmaxf(pmax, p1[r]);
  { auto rr = __builtin_amdgcn_permlane32_swap(__float_as_uint(pmax), __float_as_uint(pmax), false, false);
    pmax = fmaxf(__uint_as_float(rr[0]), __uint_as_float(rr[1])); }
  if (__builtin_expect(__all(pmax - m_reg <= THR / SCALE), 1)) { mn = m_reg; alpha = 1.f; }
  else { mn = fmaxf(m_reg, pmax); alpha = __builtin_amdgcn_exp2f((m_reg - mn) * C); m_reg = mn; }
  float mnC = -mn * C;
  for (int r = 0; r < 16; ++r) p0[r] = fmaf(p0[r], C, mnC); for (int r = 0; r < 16; ++r) p1[r] = fmaf(p1[r], C, mnC);
  for (int r = 0; r < 16; ++r) p0[r] = __builtin_amdgcn_exp2f(p0[r]);
}
__device__ __forceinline__ void finishSM(f32x16& p0, f32x16& p1, float alpha, float& l_reg, bf16x8& pa0, bf16x8& pa1, bf16x8& pa2, bf16x8& pa3) {
  for (int r = 0; r < 16; ++r) p1[r] = __builtin_amdgcn_exp2f(p1[r]);
  float ps = 0; for (int r = 0; r < 16; ++r) ps += p0[r]; for (int r = 0; r < 16; ++r) ps += p1[r];
  { auto rr = __builtin_amdgcn_permlane32_swap(__float_as_uint(ps), __float_as_uint(ps), false, false);
    ps = __uint_as_float(rr[0]) + __uint_as_float(rr[1]); }
  l_reg = l_reg * alpha + ps;
#define PK4(P, BASE, OUT) do { unsigned a0 = cvtpk(P[BASE + 0], P[BASE + 1]), a1 = cvtpk(P[BASE + 2], P[BASE + 3]);   \
    unsigned b0 = cvtpk(P[BASE + 4], P[BASE + 5]), b1 = cvtpk(P[BASE + 6], P[BASE + 7]);                              \
    auto r0 = __builtin_amdgcn_permlane32_swap(a0, b0, false, false); auto r1 = __builtin_amdgcn_permlane32_swap(a1, b1, false, false); \
    u32x4 w = {r0[0], r1[0], r0[1], r1[1]}; OUT = *reinterpret_cast<bf16x8*>(&w); } while (0)
  PK4(p0, 0, pa0); PK4(p0, 8, pa1); PK4(p1, 0, pa2); PK4(p1, 8, pa3);
#undef PK4
}
__device__ __forceinline__ void qkt(f32x16& p0, f32x16& p1, const bf16* Ks, const bf16x8* qr, int r32, int hi) {
  p0 = f32x16{}; p1 = f32x16{};
  for (int d0 = 0; d0 < 8; ++d0) { int cb = (d0 * 16 + hi * 8) * 2;
    bf16x8 b0 = *reinterpret_cast<const bf16x8*>((const char*)Ks + KSWZ(r32, cb));
    bf16x8 b1 = *reinterpret_cast<const bf16x8*>((const char*)Ks + KSWZ(32 + r32, cb));
    p0 = __builtin_amdgcn_mfma_f32_32x32x16_bf16(b0, qr[d0], p0, 0, 0, 0);
    p1 = __builtin_amdgcn_mfma_f32_32x32x16_bf16(b1, qr[d0], p1, 0, 0, 0); }
}
__device__ __forceinline__ int v_st(int k, int c) { const int kk = (k & ~0xC) | ((k & 4) << 1) | ((k & 8) >> 1); return ((kk >> 3) * 4 + (c >> 5)) * 512 + ((kk & 7) * 32 + (c & 31)) * 2; }
__device__ __forceinline__ int v_rd_base(int lane) { return ((lane & 3) << 3) | (((lane >> 2) & 3) << 6) | (((lane >> 4) & 1) << 5) | (((lane >> 5) & 1) << 8); }
constexpr int v_rd_off(int d0, int ks, int half) { return d0 * 512 + ks * 4096 + half * 2048; }
template <int OFF> __device__ __forceinline__ s16x4 tr_read(int vb) {
  s16x4 r; asm volatile("ds_read_b64_tr_b16 %0, %1 offset:%2" : "=&v"(r) : "v"(vb), "i"(OFF) : "memory"); return r;
}
template <int D0> __device__ __forceinline__ void pv_one(f32x16& od, int vb, bf16x8 pa0, bf16x8 pa1, bf16x8 pa2, bf16x8 pa3) {
  const s16x4 l0 = tr_read<v_rd_off(D0, 0, 0)>(vb), h0 = tr_read<v_rd_off(D0, 0, 1)>(vb), l1 = tr_read<v_rd_off(D0, 1, 0)>(vb), h1 = tr_read<v_rd_off(D0, 1, 1)>(vb);
  const s16x4 l2 = tr_read<v_rd_off(D0, 2, 0)>(vb), h2 = tr_read<v_rd_off(D0, 2, 1)>(vb), l3 = tr_read<v_rd_off(D0, 3, 0)>(vb), h3 = tr_read<v_rd_off(D0, 3, 1)>(vb);
  asm volatile("s_waitcnt lgkmcnt(0)" ::: "memory"); SBAR();
#define PK(L, H) (bf16x8){L[0], L[1], L[2], L[3], H[0], H[1], H[2], H[3]}
  od = __builtin_amdgcn_mfma_f32_32x32x16_bf16(pa0, PK(l0, h0), od, 0, 0, 0);
  od = __builtin_amdgcn_mfma_f32_32x32x16_bf16(pa1, PK(l1, h1), od, 0, 0, 0);
  od = __builtin_amdgcn_mfma_f32_32x32x16_bf16(pa2, PK(l2, h2), od, 0, 0, 0);
  od = __builtin_amdgcn_mfma_f32_32x32x16_bf16(pa3, PK(l3, h3), od, 0, 0, 0);
#undef PK
}
__device__ __forceinline__ void pv_d0(f32x16* o, int vb, bf16x8 pa0, bf16x8 pa1, bf16x8 pa2, bf16x8 pa3) {
  pv_one<0>(o[0], vb, pa0, pa1, pa2, pa3); pv_one<1>(o[1], vb, pa0, pa1, pa2, pa3); pv_one<2>(o[2], vb, pa0, pa1, pa2, pa3); pv_one<3>(o[3], vb, pa0, pa1, pa2, pa3);
}

template <typename TQ>
__device__ __forceinline__ void attn_dense_body(const TQ* __restrict__ Qb, const bf16* __restrict__ Kh, const bf16* __restrict__ Vh,
                                                bf16* __restrict__ Ob, int seq, char* lds) {
  using St = Stage<bf16>; using SQ = Stage<TQ>;
  int tid_ = threadIdx.x; asm volatile("" : "+v"(tid_)); const int tid = tid_, wid = tid >> 6, lane = tid & 63, r32 = lane & 31, hi = lane >> 5;
  bf16* V_lds = (bf16*)lds; bf16* K_lds = (bf16*)(lds + 2 * SHM_V);
  float* ws = (float*)(lds + 2 * SHM_V + 2 * SHM_K) + wid * 64; float* li_l = ws; float* al_l = ws + 32;
  float m_reg = -1e30f, l_reg = 0; f32x16 o[4] = {}; bf16x8 qr[8];
  const TQ* Qw = Qb + (long)(wid * QBLK + r32) * LDQ + hi * 8;
#pragma unroll
  for (int d0 = 0; d0 < 8; ++d0) qr[d0] = SQ::tobf(SQ::ld8(Qw + d0 * 16));
  const int sr = tid >> 4, sc = (tid & 15) * 8, vst0 = v_st(sr, sc), vst1 = v_st(32 + sr, sc);
  const int vb0 = (int)(uintptr_t)V_lds + v_rd_base(lane);
  struct { typename St::T vs0, vs1, ks0, ks1; } sr_[SDEPTH];
#define SLOAD(i, k0) do { sr_[i].vs0 = St::ld8(&Vh[(long)((k0) + sr) * LDK + sc]); sr_[i].vs1 = St::ld8(&Vh[(long)((k0) + 32 + sr) * LDK + sc]); \
    sr_[i].ks0 = St::ld8(&Kh[(long)((k0) + sr) * LDK + sc]); sr_[i].ks1 = St::ld8(&Kh[(long)((k0) + 32 + sr) * LDK + sc]); } while (0)
#define SWRITE(b, i) do { *(bf16x8*)((char*)V_lds + (b) * SHM_V + vst0) = St::tobf(sr_[i].vs0);          \
    *(bf16x8*)((char*)V_lds + (b) * SHM_V + vst1) = St::tobf(sr_[i].vs1); int kc = sc * 2;               \
    *(bf16x8*)((char*)K_lds + (b) * SHM_K + KSWZ(sr, kc)) = St::tobf(sr_[i].ks0);                       \
    *(bf16x8*)((char*)K_lds + (b) * SHM_K + KSWZ(32 + sr, kc)) = St::tobf(sr_[i].ks1); } while (0)
#define SWAIT() do { if constexpr (SDEPTH == 2) asm volatile("s_waitcnt vmcnt(4)" ::: "memory"); else asm volatile("s_waitcnt vmcnt(0)" ::: "memory"); } while (0)
#define RESC(a) do { if (__any((a) < 1.f)) { if (hi == 0) al_l[r32] = (a); asm volatile("s_waitcnt lgkmcnt(0)" ::: "memory"); \
    for (int d = 0; d < 4; ++d) for (int r = 0; r < 16; ++r) o[d][r] *= al_l[crow(r, hi)]; } } while (0)
  f32x16 pA0, pA1, pB0, pB1; float mnA, mnB, alA, alB; bf16x8 pa0, pa1, pa2, pa3; const int NT = seq / KVBLK;
  constexpr int SE = 0, SO = SDEPTH - 1;
  SLOAD(SE, 0); asm volatile("s_waitcnt vmcnt(0)" ::: "memory"); SWRITE(0, SE); __syncthreads();
  qkt(pA0, pA1, K_lds, qr, r32, hi); partialSM(pA0, pA1, m_reg, mnA, alA);
  SLOAD(SO, KVBLK); if constexpr (SDEPTH == 2) { if (2 < NT) SLOAD(SE, 2 * KVBLK); }
  SWAIT(); SWRITE(1, SO); __syncthreads();
  for (int j = 1; j + 1 < NT; j += 2) {
    SBAR(); qkt(pB0, pB1, (bf16*)((char*)K_lds + SHM_K), qr, r32, hi);
    finishSM(pA0, pA1, alA, l_reg, pa0, pa1, pa2, pa3); SBAR();
    SLOAD(SO, (j + SDEPTH) * KVBLK); SBAR();
    pv_d0(o, vb0, pa0, pa1, pa2, pa3); partialSM(pB0, pB1, m_reg, mnB, alB);
    __syncthreads(); SWAIT(); SWRITE(0, SE);
    RESC(alB); __syncthreads();
    SBAR(); qkt(pA0, pA1, K_lds, qr, r32, hi);
    finishSM(pB0, pB1, alB, l_reg, pa0, pa1, pa2, pa3); SBAR();
    if (SDEPTH == 1 || j + 3 < NT) SLOAD(SE, (j + 1 + SDEPTH) * KVBLK); SBAR();
    pv_d0(o, vb0 + (int)SHM_V, pa0, pa1, pa2, pa3); partialSM(pA0, pA1, m_reg, mnA, alA);
    __syncthreads(); SWAIT(); SWRITE(1, SO);
    RESC(alA); __syncthreads();
  }
  SBAR(); qkt(pB0, pB1, (bf16*)((char*)K_lds + SHM_K), qr, r32, hi);
  finishSM(pA0, pA1, alA, l_reg, pa0, pa1, pa2, pa3); SBAR();
  pv_d0(o, vb0, pa0, pa1, pa2, pa3); partialSM(pB0, pB1, m_reg, mnB, alB);
  __syncthreads(); RESC(alB);
  finishSM(pB0, pB1, alB, l_reg, pa0, pa1, pa2, pa3); SBAR();
  pv_d0(o, vb0 + (int)SHM_V, pa0, pa1, pa2, pa3);
  if (hi == 0) li_l[r32] = l_reg; asm volatile("s_waitcnt lgkmcnt(0)" ::: "memory");
  float rli[16];
#pragma unroll
  for (int r = 0; r < 16; ++r) rli[r] = __builtin_amdgcn_rcpf(li_l[crow(r, hi)]);
  bf16* Ow = Ob + (long)(wid * QBLK) * LDO;
#pragma unroll
  for (int r = 0; r < 16; ++r) { int orow = crow(r, hi);
    for (int d0 = 0; d0 < 4; ++d0) Ow[(long)orow * LDO + d0 * 32 + r32] = __float2bfloat16(o[d0][r] * rli[r]); }
#undef SLOAD
#undef SWRITE
#undef SWAIT
#undef RESC
}

}

#ifndef MK_PER_PHASE
#define MK_PER_PHASE 0
#endif
#ifndef MK_GDN_REC
#define MK_GDN_REC 0
#endif
#ifndef MK_DIAG
#define MK_DIAG 0
#endif
#ifndef MK_DIAG_A
#define MK_DIAG_A 0
#endif
#ifndef MK_DIAG_B
#define MK_DIAG_B 1
#endif
constexpr int NWAVES = 8;

constexpr int DM = 2048, NB_CTX = 32, SEQ = 256, DEPTH = 2, NB_LAT = 2, LSEQ = 1024, PAST = 512;
constexpr int M_CTX = NB_CTX * SEQ, M_LAT = NB_LAT * LSEQ, M = M_CTX + M_LAT;
constexpr int HG = 8, DKV = 128, GDN_W = 1024, NQ = 8, NKV = 2, HD = 128, ATT_W = 1024;
constexpr int QKV_W = 3072, IN_W = 5664, IN_WP = 5888, DFF = 5632, CONVK = 5;
constexpr int C_Z = 3072, C_B = 4096, C_A = 4112, C_AQ = 4128, C_AK = 5152, C_AV = 5408;
constexpr int KROWS = M_CTX + NB_LAT * (LSEQ + PAST);
constexpr float RMS_EPS = 1e-6f, LN_EPS = 1e-5f;
constexpr float DN_ALPHA = 1.4142135623730951f;
constexpr size_t OUT_YP = 0, OUT_YS = 16777216, OUT_CK = 20971520, OUT_CV = 25165824, OUT_ST = 29360128, OUT_TOTAL = 46137344;
enum { I_XP = 0, I_XS, I_CK, I_CV, I_ST, I_C, I_CCTX, I_WADA, I_BADA, I_WIN, I_CONVW, I_ALOG, I_DTB, I_GNW, I_QNW, I_KNW, I_WO, I_LN1G, I_LN1B, I_LN2G, I_LN2B, I_WGU, I_WD, N_IN };

constexpr size_t MiB = 1u << 20;
constexpr size_t WS_CTL = 0, CTL_ZERO_BYTES = 1 * MiB;
constexpr size_t WS_MOD = 1 * MiB;
constexpr size_t WS_WIN = 2 * MiB;
constexpr size_t WS_WO  = WS_WIN + (size_t)DEPTH * IN_WP * DM * 2;
constexpr size_t WS_WGU = WS_WO + (size_t)DEPTH * DM * DM * 2;
constexpr size_t WS_WD  = WS_WGU + (size_t)DEPTH * 2 * DFF * DM * 2;
constexpr size_t WS_H   = WS_WD + (size_t)DEPTH * DM * DFF * 2;
constexpr size_t WS_MIX = WS_H + (size_t)M * DM * 2;
constexpr size_t WS_PROJ = WS_MIX + (size_t)M * DM * 2;
constexpr size_t WS_QG  = WS_PROJ + (size_t)M * IN_WP * 2;
constexpr size_t WS_KG  = WS_QG + (size_t)M * GDN_W * 2;
constexpr size_t WS_VG  = WS_KG + (size_t)M * GDN_W * 2;
constexpr size_t WS_GG  = WS_VG + (size_t)M * GDN_W * 2;
constexpr size_t WS_BB  = WS_GG + (size_t)M * 16 * 4;
constexpr size_t WS_OF  = WS_BB + (size_t)M * 16 * 4;
constexpr size_t WS_OB  = WS_OF + (size_t)M * GDN_W * 4;
constexpr size_t WS_QA  = WS_OB + (size_t)M * GDN_W * 4;
constexpr size_t WS_KA  = WS_QA + (size_t)M * ATT_W * 2;
constexpr size_t WS_VA  = WS_KA + (size_t)KROWS * 256 * 2;
constexpr size_t WS_ROPE = WS_VA + (size_t)KROWS * 256 * 2;
constexpr size_t WS_PART = WS_ROPE + (size_t)LSEQ * 64 * 16;
constexpr size_t WS_END = WS_PART + (size_t)4 * M_LAT * DM * 4;
static_assert(WS_WIN % 256 == 0 && WS_WO % 256 == 0 && WS_WGU % 256 == 0 && WS_WD % 256 == 0 && WS_H % 256 == 0 && WS_MIX % 256 == 0 && WS_PROJ % 256 == 0 && WS_QG % 256 == 0 && WS_GG % 256 == 0 && WS_OF % 256 == 0 && WS_QA % 256 == 0 && WS_KA % 256 == 0 && WS_VA % 256 == 0, "ws alignment");
static_assert(WS_MOD + (size_t)DEPTH * 3 * 12288 * 4 <= WS_WIN, "mod table");
constexpr int CW_TMO = 0, CW_CODE = 1, CW_BAR = 4096;

constexpr int RING_OFF = 0, RING_BYTES = 131072;
constexpr int LDS_BYTES = 163840;
constexpr int LDSCTL_OFF = LDS_BYTES - 512, MISC_OFF = LDSCTL_OFF + 320;

#define GAS __attribute__((address_space(1)))
#define LAS __attribute__((address_space(3)))
typedef unsigned short bf16;
typedef unsigned v4u __attribute__((ext_vector_type(4)));
typedef unsigned v2u __attribute__((ext_vector_type(2)));
typedef float f32x4 __attribute__((ext_vector_type(4)));
typedef float f32x2 __attribute__((ext_vector_type(2)));
typedef GAS unsigned gu32;
#define RLX_AGENT __ATOMIC_RELAXED, __HIP_MEMORY_SCOPE_AGENT
#define LDS_WAIT() asm volatile("s_waitcnt lgkmcnt(0)" ::: "memory")
#define VM_WAIT() asm volatile("s_waitcnt vmcnt(0)" ::: "memory")
__device__ __forceinline__ unsigned f2bf(float f) { unsigned u = __builtin_bit_cast(unsigned, f); return (u + 0x7fffu + ((u >> 16) & 1u)) >> 16; }
__device__ __forceinline__ unsigned pk2(float lo, float hi) { return f2bf(lo) | (f2bf(hi) << 16); }
__device__ __forceinline__ float bf_lo(unsigned w) { return __builtin_bit_cast(float, w << 16); }
__device__ __forceinline__ float bf_hi(unsigned w) { return __builtin_bit_cast(float, w & 0xffff0000u); }
__device__ __forceinline__ float bf1(bf16 h) { return __builtin_bit_cast(float, (unsigned)h << 16); }
template <int CTRL> __device__ __forceinline__ float dppf(float v) { return __builtin_bit_cast(float, __builtin_amdgcn_update_dpp(0, __builtin_bit_cast(int, v), CTRL, 0xF, 0xF, true)); }
__device__ __forceinline__ float wave_sum(float v) {
    v += dppf<0xB1>(v);
    v += dppf<0x4E>(v);
    v += dppf<0x141>(v);
    v += dppf<0x140>(v);
    return ((__builtin_bit_cast(float, __builtin_amdgcn_readlane(__builtin_bit_cast(int, v), 15)) + __builtin_bit_cast(float, __builtin_amdgcn_readlane(__builtin_bit_cast(int, v), 31))) +
            (__builtin_bit_cast(float, __builtin_amdgcn_readlane(__builtin_bit_cast(int, v), 47)) + __builtin_bit_cast(float, __builtin_amdgcn_readlane(__builtin_bit_cast(int, v), 63))));
}
__device__ __forceinline__ float frcp(float x) { return __builtin_amdgcn_rcpf(x); }
__device__ __forceinline__ float frsq(float x) { return __builtin_amdgcn_rsqf(x); }
__device__ __forceinline__ float fexp(float x) { return __builtin_amdgcn_exp2f(1.4426950408889634f * x); }
__device__ __forceinline__ float silu(float x) { return x * frcp(1.0f + fexp(-x)); }
#define XB_TMO      128
#define XB_XCNT(j)  (256  + 64 * (j))
#define XB_XSUB(j)  (1280 + 64 * (j))
#define XB_XGEN(j)  (2304 + 64 * (j))
#define XB_TOP      3328
#define XB_TOPGEN   3392
#define XCD_BAR_WORDS 3456
#define XB_SPIN_CAP (1u << 18)

__device__ __forceinline__ unsigned xb_ld(unsigned* p)              { return __hip_atomic_load(p, __ATOMIC_RELAXED, __HIP_MEMORY_SCOPE_AGENT); }
__device__ __forceinline__ unsigned xb_add(unsigned* p, unsigned v) { return __hip_atomic_fetch_add(p, v, __ATOMIC_RELAXED, __HIP_MEMORY_SCOPE_AGENT); }
__device__ __forceinline__ unsigned xb_xcc_id() { return (unsigned)__builtin_amdgcn_s_getreg((3 << 11) | 20) & 0xFu; }
#define XB_SPIN(cond, bar) do { unsigned _sp = 0; while (cond) { __builtin_amdgcn_s_sleep(1); \
    if ((++_sp & 255u) == 0u) { if (xb_ld(&(bar)[XB_TMO])) break; if (_sp > XB_SPIN_CAP) { atomicAdd(&(bar)[XB_TMO], 1u); break; } } } } while (0)

struct XcdBarrier {
    unsigned* bar; unsigned x;
    volatile LAS unsigned* st;
};

__device__ __forceinline__ XcdBarrier xcd_barrier_post(unsigned* bar, volatile LAS unsigned* st) {
    XcdBarrier b; b.bar = bar; b.x = xb_xcc_id(); b.st = st;
    if (threadIdx.x == 0) (void)xb_add(&bar[XB_XCNT(b.x)], 1u);
    return b;
}
__device__ __forceinline__ void xcd_barrier_complete(unsigned* bar, unsigned x, unsigned& nloc, unsigned& nx) {
    const unsigned G = gridDim.x * gridDim.y * gridDim.z;
    unsigned sum, cnt, mine, sp = 0u;
    for (;;) {
        sum = 0u; cnt = 0u; mine = 0u;
#pragma unroll
        for (unsigned j = 0; j < 16; ++j) { const unsigned c = xb_ld(&bar[XB_XCNT(j)]); sum += c; cnt += (c > 0u) ? 1u : 0u; mine = (j == x) ? c : mine; }
        if (sum == G) break;
        __builtin_amdgcn_s_sleep(1);
        if ((++sp & 255u) == 0u) { if (xb_ld(&bar[XB_TMO])) break; if (sp > XB_SPIN_CAP) { atomicAdd(&bar[XB_TMO], 1u); break; } }
    }
    nloc = mine > 0u ? mine : 1u; nx = cnt > 0u ? cnt : 1u;
}

__device__ __forceinline__ void xcd_barrier(const XcdBarrier& b) {
    asm volatile("s_waitcnt vmcnt(0)" ::: "memory");
    __syncthreads();
    if (threadIdx.x == 0) {
        unsigned* bar = b.bar;
        __builtin_amdgcn_s_waitcnt(0);
        unsigned nloc = b.st[0], nx = b.st[1];
        if (nloc == 0u) { xcd_barrier_complete(bar, b.x, nloc, nx); b.st[0] = nloc; b.st[1] = nx; }
        const unsigned old = xb_add(&bar[XB_XSUB(b.x)], 1u);
        const unsigned gen = old / nloc;
        if (old + 1u == (gen + 1u) * nloc) {
            __builtin_amdgcn_fence(__ATOMIC_RELEASE, "agent");
            asm volatile("s_waitcnt vmcnt(0)" ::: "memory");
            const unsigned og = xb_add(&bar[XB_TOP], 1u);
            const unsigned tg = og / nx;
            if (og + 1u == (tg + 1u) * nx) xb_add(&bar[XB_TOPGEN], 1u);
            else XB_SPIN(xb_ld(&bar[XB_TOPGEN]) == tg, bar);
            __builtin_amdgcn_fence(__ATOMIC_ACQUIRE, "agent");
            xb_add(&bar[XB_XGEN(b.x)], 1u);
            asm volatile("s_waitcnt vmcnt(0)" ::: "memory");
        } else {
            XB_SPIN(xb_ld(&bar[XB_XGEN(b.x)]) == gen, bar);
            __builtin_amdgcn_fence(__ATOMIC_ACQUIRE, "agent");
            asm volatile("s_waitcnt vmcnt(0)" ::: "memory");
        }
    }
    __syncthreads();
}

struct Args { const float* in[N_IN]; float* out; unsigned char* ws; int ph_lo, ph_hi; };
static_assert(sizeof(Args) == 8 * (N_IN + 2) + 8, "Args has no padding");
#define CAS __attribute__((address_space(4)))
#define ARGS_T const CAS Args
__device__ __forceinline__ ARGS_T* fresh_args() { const CAS char* p = (const CAS char*)__builtin_amdgcn_kernarg_segment_ptr(); asm volatile("" : "+s"(p)); return (ARGS_T*)p; }
__device__ __forceinline__ int fresh_tid() { int t = threadIdx.x; asm volatile("" : "+v"(t)); return t; }
__device__ __forceinline__ int fresh_bx() { int b = blockIdx.x; asm volatile("" : "+s"(b)); return b; }

struct Frame {
    LAS unsigned char* lds;
    volatile LAS unsigned* MISC;
    gu32* ctl;
    int tid, lane, wave;
    int vcu, G, bx;
    float* out;
    unsigned char* ws;
};
#define WSP(T, off) ((T*)(F.ws + (off)))

__device__ __forceinline__ void p0_transpose_item(const float* W, int K, int N, bf16* WT, int k0, int n0, int drow0, LAS float* scr, int lane) {
#pragma unroll 8
    for (int i = 0; i < 32; ++i) { const int kk = 2 * i + (lane >> 5); scr[kk * 33 + (lane & 31)] = W[(size_t)(k0 + kk) * N + n0 + (lane & 31)]; }
    LDS_WAIT(); asm volatile("" ::: "memory");
    const int c = lane & 7;
#pragma unroll
    for (int j = 0; j < 4; ++j) { const int n = (lane >> 3) + 8 * j; const LAS float* s = scr + (8 * c) * 33 + n;
        v4u o; o.x = pk2(s[0 * 33], s[1 * 33]); o.y = pk2(s[2 * 33], s[3 * 33]); o.z = pk2(s[4 * 33], s[5 * 33]); o.w = pk2(s[6 * 33], s[7 * 33]);
        *(GAS v4u*)(WT + (size_t)(drow0 + n) * K + k0 + 8 * c) = o; }
    LDS_WAIT(); asm volatile("" ::: "memory");
}
__device__ __forceinline__ void p0a_phase(ARGS_T& A, Frame& F) {
    LAS float* sl = (LAS float*)(F.lds);
    LAS float* red = (LAS float*)(F.lds + 32768);
    for (int i = F.tid; i < 3 * DM; i += NWAVES * 64) { const int ci = i / DM, k = i % DM; const float c = ci == 0 ? A.in[I_CCTX][k] : A.in[I_C][(ci - 1) * DM + k]; sl[i] = silu(c); }
    __syncthreads();
    for (int grp = F.bx; grp < 256; grp += F.G) {
        const int l = grp >> 7, n0 = (grp & 127) * 96;
        const int cg = F.tid % 24, kg = F.tid / 24;
        float a[3][4];
#pragma unroll
        for (int ci = 0; ci < 3; ++ci)
#pragma unroll
            for (int j = 0; j < 4; ++j) a[ci][j] = 0.f;
        if (kg < 21) {
            const float* wp = A.in[I_WADA] + (size_t)l * DM * 12288 + n0 + 4 * cg;
#pragma unroll 4
            for (int k = kg; k < DM; k += 21) { const f32x4 w = *(const f32x4*)(wp + (size_t)k * 12288); const float s0 = sl[k], s1 = sl[DM + k], s2 = sl[2 * DM + k];
#pragma unroll
                for (int j = 0; j < 4; ++j) { a[0][j] += s0 * w[j]; a[1][j] += s1 * w[j]; a[2][j] += s2 * w[j]; } }
#pragma unroll
            for (int ci = 0; ci < 3; ++ci)
#pragma unroll
                for (int j = 0; j < 4; ++j) red[(kg * 24 + cg) * 12 + ci * 4 + j] = a[ci][j];
        }
        __syncthreads();
        if (F.tid < 288) { const int c2 = F.tid / 12, j = F.tid % 12, ci = j >> 2, cc = j & 3; float s = 0.f;
            for (int q = 0; q < 21; ++q) s += red[(q * 24 + c2) * 12 + j];
            const int n = n0 + 4 * c2 + cc;
            WSP(float, WS_MOD)[((size_t)l * 3 + ci) * 12288 + n] = s + A.in[I_BADA][(size_t)l * 12288 + n]; }
        __syncthreads();
    }
    LAS float* scr = (LAS float*)(F.lds + RING_OFF + F.wave * 16384);
    const int gw = F.vcu * NWAVES + F.wave, NGW = F.G * NWAVES;
    constexpr int I_IN = (DM / 64) * (IN_W / 32), I_O = (DM / 64) * (DM / 32), I_GU = (DM / 64) * (2 * DFF / 32), I_D = (DFF / 64) * (DM / 32), I_LAYER = I_IN + I_O + I_GU + I_D;
    for (int it = gw; it < DEPTH * I_LAYER; it += NGW) {
        const int l = it / I_LAYER; int r = it % I_LAYER;
        if (r < I_IN) { const int nblk = IN_W / 32, kb = r / nblk, nb = r % nblk;
            p0_transpose_item(A.in[I_WIN] + (size_t)l * DM * IN_W, DM, IN_W, WSP(bf16, WS_WIN) + (size_t)l * IN_WP * DM, 64 * kb, 32 * nb, 32 * nb, scr, F.lane); continue; } r -= I_IN;
        if (r < I_O) { const int nblk = DM / 32, kb = r / nblk, nb = r % nblk;
            p0_transpose_item(A.in[I_WO] + (size_t)l * DM * DM, DM, DM, WSP(bf16, WS_WO) + (size_t)l * DM * DM, 64 * kb, 32 * nb, 32 * nb, scr, F.lane); continue; } r -= I_O;
        if (r < I_GU) { const int nblk = 2 * DFF / 32, kb = r / nblk, nb = r % nblk, n0 = 32 * nb, s = n0 / DFF, j = n0 % DFF, p = j / 128, rr = j % 128;
            p0_transpose_item(A.in[I_WGU] + (size_t)l * DM * 2 * DFF, DM, 2 * DFF, WSP(bf16, WS_WGU) + (size_t)l * 2 * DFF * DM, 64 * kb, n0, 256 * p + 128 * s + rr, scr, F.lane); continue; } r -= I_GU;
        { const int nblk = DM / 32, kb = r / nblk, nb = r % nblk;
            p0_transpose_item(A.in[I_WD] + (size_t)l * DFF * DM, DFF, DM, WSP(bf16, WS_WD) + (size_t)l * DM * DFF, 64 * kb, 32 * nb, 32 * nb, scr, F.lane); }
    }
    { const int gt = F.vcu * NWAVES * 64 + F.tid, NGT = F.G * NWAVES * 64; constexpr int PADV = (IN_WP - IN_W) * DM * 2 / 16;
        for (int i = gt; i < DEPTH * PADV; i += NGT) { const int l = i / PADV, r = i % PADV; ((GAS v4u*)(WSP(bf16, WS_WIN) + (size_t)l * IN_WP * DM + (size_t)IN_W * DM))[r] = (v4u){0u, 0u, 0u, 0u}; } }
}

__device__ __forceinline__ int cond_of_row(int row) { return row < M_CTX ? 0 : 1 + ((row - M_CTX) >> 10); }
__device__ __forceinline__ void p0b_phase(ARGS_T& A, Frame& F) {
    const int gw = F.vcu * NWAVES + F.wave, NGW = F.G * NWAVES;
    for (int t = gw; t < LSEQ; t += NGW) { const int lane = F.lane; const float pos = (float)(lane < 32 ? (t >> 6) : (t & 63)); const int i0 = 2 * (lane & 15);
        const float f0 = powf(10000.f, -(float)(2 * i0) / 64.f), f1 = powf(10000.f, -(float)(2 * i0 + 2) / 64.f); float s0, c0, s1, c1;
        sincosf(pos * f0, &s0, &c0); sincosf(pos * f1, &s1, &c1);
        *(f32x4*)(WSP(float, WS_ROPE) + ((size_t)t * 64 + lane) * 4) = (f32x4){c0, s0, c1, s1}; }
    for (int row = gw; row < M; row += NGW) {
        const float* xr = row < M_CTX ? A.in[I_XP] + (size_t)row * DM : A.in[I_XS] + (size_t)(row - M_CTX) * DM;
        const float* mod = WSP(float, WS_MOD) + (size_t)cond_of_row(row) * 12288;
        GAS v2u* o8 = (GAS v2u*)(WSP(bf16, WS_H) + (size_t)row * DM) + F.lane;
#pragma unroll
        for (int j = 0; j < 8; ++j) { const int c = 4 * F.lane + 256 * j; const f32x4 x = *(const f32x4*)(xr + c), sh = *(const f32x4*)(mod + c), sc = *(const f32x4*)(mod + DM + c);
            const f32x4 h = x * (sc + 1.0f) + sh; o8[64 * j] = (v2u){pk2(h[0], h[1]), pk2(h[2], h[3])}; }
    }
}
__device__ __forceinline__ void ln_phase(ARGS_T& A, Frame& F, const float* lg, const float* lb, const float* modsh, const float* modsc, bool write_h, const float* part, const float* xin_lat, const float* gate, float alpha) {
    const int gw = F.vcu * NWAVES + F.wave, NGW = F.G * NWAVES;
    float* X = F.out;
    for (int row = gw; row < M; row += NGW) {
        float* xr = X + (size_t)row * DM;
        f32x4 v[8]; float s = 0.f;
#pragma unroll
        for (int j = 0; j < 8; ++j) v[j] = *(const f32x4*)((part && row >= M_CTX ? xin_lat + (size_t)(row - M_CTX) * DM : xr) + 4 * F.lane + 256 * j);
        if (part && row >= M_CTX) { const float* pr = part + (size_t)(row - M_CTX) * DM + 4 * F.lane; const float* gr = gate + (size_t)cond_of_row(row) * 12288 + 4 * F.lane;
#pragma unroll
            for (int j = 0; j < 8; ++j) { const f32x4 p0 = *(const f32x4*)(pr + 256 * j), p1 = *(const f32x4*)(pr + (size_t)M_LAT * DM + 256 * j), p2 = *(const f32x4*)(pr + (size_t)2 * M_LAT * DM + 256 * j), p3 = *(const f32x4*)(pr + (size_t)3 * M_LAT * DM + 256 * j);
                v[j] = v[j] * alpha + *(const f32x4*)(gr + 256 * j) * ((p0 + p1) + (p2 + p3)); } }
#pragma unroll
        for (int j = 0; j < 8; ++j) s += (v[j][0] + v[j][1]) + (v[j][2] + v[j][3]);
        const float mean = wave_sum(s) * (1.f / DM); float s2 = 0.f;
#pragma unroll
        for (int j = 0; j < 8; ++j) { v[j] = v[j] - mean; s2 += (v[j][0] * v[j][0] + v[j][1] * v[j][1]) + (v[j][2] * v[j][2] + v[j][3] * v[j][3]); }
        const float rstd = frsq(wave_sum(s2) * (1.f / DM) + LN_EPS);
        const int ci = cond_of_row(row);
        GAS v2u* o8 = (GAS v2u*)(WSP(bf16, WS_H) + (size_t)row * DM) + F.lane;
#pragma unroll
        for (int j = 0; j < 8; ++j) { const int c = 4 * F.lane + 256 * j; const f32x4 g = *(const f32x4*)(lg + c), b = *(const f32x4*)(lb + c);
            const f32x4 y = v[j] * rstd * g + b; *(f32x4*)(xr + c) = y;
            if (write_h) { const f32x4 sh = *(const f32x4*)(modsh + (size_t)ci * 12288 + c), sc = *(const f32x4*)(modsc + (size_t)ci * 12288 + c);
                const f32x4 h = y * (sc + 1.0f) + sh; o8[64 * j] = (v2u){pk2(h[0], h[1]), pk2(h[2], h[3])}; } }
    }
}

__device__ __forceinline__ void prep_phase(ARGS_T& A, Frame& F, int l) {
    LAS float* cw = (LAS float*)(F.lds);
    { const float* cwg = A.in[I_CONVW] + (size_t)l * CONVK * QKV_W;
      for (int i = F.tid; i < CONVK * QKV_W / 4; i += NWAVES * 64) ((LAS f32x4*)cw)[i] = ((const f32x4*)cwg)[i]; }
    __syncthreads();
    const int gw = F.vcu * NWAVES + F.wave, NGW = F.G * NWAVES, lane = F.lane;
    const bf16* PROJ = WSP(bf16, WS_PROJ);
    for (int r = gw; r < NB_LAT * PAST; r += NGW) {
        const int b = r / PAST, j = r % PAST; const size_t src = ((size_t)(b * DEPTH + l) * PAST + j) * 256 + 4 * lane; const size_t krow = (size_t)M_CTX + (size_t)b * (LSEQ + PAST) + LSEQ + j;
        const f32x4 kv = *(const f32x4*)(A.in[I_CK] + src), vv = *(const f32x4*)(A.in[I_CV] + src);
        *(GAS v2u*)(WSP(bf16, WS_KA) + krow * 256 + 4 * lane) = (v2u){pk2(kv[0], kv[1]), pk2(kv[2], kv[3])};
        *(GAS v2u*)(WSP(bf16, WS_VA) + krow * 256 + 4 * lane) = (v2u){pk2(vv[0], vv[1]), pk2(vv[2], vv[3])}; }
    constexpr int RUN = 8, NRUN = M / RUN;
    const float sgn = (lane & 16) ? 1.f : -1.f;
    const f32x2 qw = *(const f32x2*)(A.in[I_QNW] + l * HD + 2 * lane), kw = *(const f32x2*)(A.in[I_KNW] + l * HD + 2 * lane);
    const float dtb = A.in[I_DTB][l * 16 + (lane & 15)], nealog = -fexp(A.in[I_ALOG][l * 16 + (lane & 15)]);
#define PREP_LOADROW(dst, tt) do { if ((tt) >= 0 && (tt) < T) { const bf16* pr_ = PROJ + (size_t)(seq0 + (tt)) * IN_WP + 1024 * part + 2 * lane; _Pragma("unroll") for (int i_ = 0; i_ < 8; ++i_) dst[i_] = *(const unsigned*)(pr_ + 128 * i_); } \
        else { _Pragma("unroll") for (int i_ = 0; i_ < 8; ++i_) dst[i_] = 0u; } } while (0)
#define PREP_LOADATT(dst, gb_, ga_, row_) do { const bf16* pr_ = PROJ + (size_t)(row_) * IN_WP; const int c0_ = part == 2 ? C_AK : C_AQ + 512 * part; _Pragma("unroll") for (int h_ = 0; h_ < 4; ++h_) dst[h_] = *(const unsigned*)(pr_ + c0_ + 128 * h_ + 2 * lane); \
        gb_ = pr_[C_B + (lane & 15)]; ga_ = pr_[C_A + (lane & 15)]; } while (0)
    for (int item = gw; item < 3 * NRUN; item += NGW) {
        const int part = item / NRUN, run = item % NRUN;
        const int rowb = run * RUN; const bool lat = rowb >= M_CTX;
        int seq0, tb, T, bidx;
        if (!lat) { seq0 = rowb & ~(SEQ - 1); tb = rowb & (SEQ - 1); T = SEQ; bidx = rowb >> 8; } else { const int r = rowb - M_CTX; seq0 = M_CTX + (r & ~(LSEQ - 1)); tb = r & (LSEQ - 1); T = LSEQ; bidx = r >> 10; }
        unsigned w0[8], w1[8], w2[8], w3[8], w4[8], nx[8], an[4]; bf16 gbn, gan;
        PREP_LOADROW(w0, tb - 2); PREP_LOADROW(w1, tb - 1); PREP_LOADROW(w2, tb); PREP_LOADROW(w3, tb + 1); PREP_LOADROW(w4, tb + 2);
        PREP_LOADATT(an, gbn, gan, rowb);
        bf16* gdst = (part == 0 ? WSP(bf16, WS_QG) : part == 1 ? WSP(bf16, WS_KG) : WSP(bf16, WS_VG)) + 2 * lane;
        const LAS float* cwp = cw + 1024 * part + 2 * lane;
#pragma unroll 1
        for (int tk = 0; tk < RUN; ++tk) {
            const int row = rowb + tk, t = tb + tk;
            unsigned ac[4]; const bf16 gbc = gbn, gac = gan;
#pragma unroll
            for (int h = 0; h < 4; ++h) ac[h] = an[h];
            if (tk + 1 < RUN) { PREP_LOADROW(nx, t + 3); PREP_LOADATT(an, gbn, gan, row + 1); }
#pragma unroll
            for (int i = 0; i < 8; ++i) { const LAS float* c = cwp + 128 * i;
                const f32x2 c0 = *(const LAS f32x2*)(c), c1 = *(const LAS f32x2*)(c + QKV_W), c2 = *(const LAS f32x2*)(c + 2 * QKV_W), c3 = *(const LAS f32x2*)(c + 3 * QKV_W), c4 = *(const LAS f32x2*)(c + 4 * QKV_W);
                float y0 = c0[0] * bf_lo(w0[i]) + c1[0] * bf_lo(w1[i]) + c2[0] * bf_lo(w2[i]) + c3[0] * bf_lo(w3[i]) + c4[0] * bf_lo(w4[i]);
                float y1 = c0[1] * bf_hi(w0[i]) + c1[1] * bf_hi(w1[i]) + c2[1] * bf_hi(w2[i]) + c3[1] * bf_hi(w3[i]) + c4[1] * bf_hi(w4[i]);
                y0 = silu(y0); y1 = silu(y1);
                if (part < 2) { const float ss = wave_sum(y0 * y0 + y1 * y1); float sc = frsq(ss + RMS_EPS); if (part == 0) sc *= 0.08838834764831845f; y0 *= sc; y1 *= sc; }
                *(GAS unsigned*)(gdst + (size_t)row * GDN_W + 128 * i) = pg8::cvt_pk_bf16(y0, y1); if ((i & 3) == 3) __builtin_amdgcn_sched_barrier(0); }
            const size_t krow = lat ? (size_t)M_CTX + (size_t)bidx * (LSEQ + PAST) + t : (size_t)row;
            float rc0 = 1.f, rs0 = 0.f, rc1 = 1.f, rs1 = 0.f;
            if (lat) { const f32x4 rt = *(const f32x4*)(WSP(float, WS_ROPE) + ((size_t)t * 64 + lane) * 4); rc0 = rt[0]; rs0 = rt[1]; rc1 = rt[2]; rs1 = rt[3]; }
            if (part < 2) {
#pragma unroll
                for (int h = 0; h < 4; ++h) { float x0 = bf_lo(ac[h]), x1 = bf_hi(ac[h]);
                    const float r = frsq(wave_sum(x0 * x0 + x1 * x1) * (1.f / HD) + RMS_EPS); x0 = x0 * r * qw[0]; x1 = x1 * r * qw[1];
                    if (lat) { const float o0 = __shfl_xor(x0, 16), o1 = __shfl_xor(x1, 16); x0 = x0 * rc0 + sgn * o0 * rs0; x1 = x1 * rc1 + sgn * o1 * rs1; }
                    *(GAS unsigned*)(WSP(bf16, WS_QA) + (size_t)row * ATT_W + 128 * (4 * part + h) + 2 * lane) = pg8::cvt_pk_bf16(x0, x1); }
            } else {
#pragma unroll
                for (int h = 0; h < 2; ++h) { float x0 = bf_lo(ac[h]), x1 = bf_hi(ac[h]);
                    const float r = frsq(wave_sum(x0 * x0 + x1 * x1) * (1.f / HD) + RMS_EPS); x0 = x0 * r * kw[0]; x1 = x1 * r * kw[1];
                    if (!lat) *(f32x2*)(F.out + OUT_CK + ((size_t)(bidx * DEPTH + l) * SEQ + t) * 256 + 128 * h + 2 * lane) = (f32x2){x0, x1};
                    else { const float o0 = __shfl_xor(x0, 16), o1 = __shfl_xor(x1, 16); x0 = x0 * rc0 + sgn * o0 * rs0; x1 = x1 * rc1 + sgn * o1 * rs1; }
                    *(GAS unsigned*)(WSP(bf16, WS_KA) + krow * 256 + 128 * h + 2 * lane) = pg8::cvt_pk_bf16(x0, x1); }
#pragma unroll
                for (int h = 0; h < 2; ++h) { const unsigned w = ac[2 + h];
                    *(GAS unsigned*)(WSP(bf16, WS_VA) + krow * 256 + 128 * h + 2 * lane) = w;
                    if (!lat) *(f32x2*)(F.out + OUT_CV + ((size_t)(bidx * DEPTH + l) * SEQ + t) * 256 + 128 * h + 2 * lane) = (f32x2){bf_lo(w), bf_hi(w)}; }
                if (lane < 16) { const float bv = bf1(gbc), av = bf1(gac) + dtb;
                    const float sp = fmaxf(av, 0.f) + __logf(1.f + fexp(-fabsf(av)));
                    WSP(float, WS_GG)[(size_t)row * 16 + lane] = nealog * sp;
                    WSP(float, WS_BB)[(size_t)row * 16 + lane] = frcp(1.f + fexp(-bv)); }
            }
#pragma unroll
            for (int i = 0; i < 8; ++i) { w0[i] = w1[i]; w1[i] = w2[i]; w2[i] = w3[i]; w3[i] = w4[i]; w4[i] = nx[i]; }
        }
    }
#undef PREP_LOADROW
#undef PREP_LOADATT
}

constexpr int GDN_ITEMS_CTX = NB_CTX * HG * 2 / 4, GDN_ITEMS = GDN_ITEMS_CTX + NB_LAT * HG * 2 / 4;
__device__ __forceinline__ void gdn_rec_item(ARGS_T& A, Frame& F, int l, int it) {
    const bool lat = it >= GDN_ITEMS_CTX; const int cbase = lat ? (it - GDN_ITEMS_CTX) * 4 : it * 4;
    const int slot = F.tid >> 7, e = F.tid & 127, c = cbase + slot, b = c >> 4, h = (c >> 1) & 7, dir = c & 1;
    const int T = lat ? LSEQ : SEQ, row0 = lat ? M_CTX + b * LSEQ : b * SEQ;
    float S[128];
    if (lat) { const float* s0 = A.in[I_ST] + ((((size_t)b * DEPTH + l) * 2 + dir) * HG + h) * (size_t)(DKV * DKV) + e;
#pragma unroll
        for (int d = 0; d < 128; ++d) S[d] = s0[(size_t)d * DKV]; }
    else {
#pragma unroll
        for (int d = 0; d < 128; ++d) S[d] = 0.f; }
    constexpr int NBS = 16, SLOTF = NBS * 384 + 64;
    LAS float* kq = (LAS float*)(F.lds) + slot * SLOTF;
    const bf16 *KG = WSP(bf16, WS_KG), *QG = WSP(bf16, WS_QG), *VG = WSP(bf16, WS_VG);
    float* OD = dir ? WSP(float, WS_OB) : WSP(float, WS_OF);
    for (int i0 = 0; i0 < T; i0 += NBS) {
        __syncthreads();
#pragma unroll 4
        for (int j = 0; j < NBS; ++j) { const int t = dir ? T - 1 - (i0 + j) : i0 + j; const size_t off = (size_t)(row0 + t) * GDN_W + h * 128 + e;
            kq[j * 384 + e] = bf1(KG[off]); kq[j * 384 + 128 + e] = bf1(QG[off]); kq[j * 384 + 256 + e] = bf1(VG[off]); }
        if (e < NBS) { const int t = dir ? T - 1 - (i0 + e) : i0 + e; const size_t off = (size_t)(row0 + t) * 16 + dir * 8 + h;
            kq[NBS * 384 + e] = WSP(float, WS_GG)[off]; kq[NBS * 384 + 16 + e] = WSP(float, WS_BB)[off]; }
        __syncthreads();
        for (int j = 0; j < NBS; ++j) {
            const LAS float* kp = kq + j * 384; const float decay = __expf(kq[NBS * 384 + j]), beta = kq[NBS * 384 + 16 + j], v = kp[256 + e];
            float kv0 = 0.f, kv1 = 0.f;
#pragma unroll
            for (int dc = 0; dc < 128; dc += 16) {
#pragma unroll
                for (int d = dc; d < dc + 16; d += 4) { const f32x4 k4 = *(const LAS f32x4*)(kp + d); kv0 += k4[0] * S[d] + k4[2] * S[d + 2]; kv1 += k4[1] * S[d + 1] + k4[3] * S[d + 3]; }
                __builtin_amdgcn_sched_barrier(0); }
            const float delta = beta * (v - decay * (kv0 + kv1));
            float o0 = 0.f, o1 = 0.f;
#pragma unroll
            for (int dc = 0; dc < 128; dc += 8) {
#pragma unroll
                for (int d = dc; d < dc + 8; d += 4) { const f32x4 k4 = *(const LAS f32x4*)(kp + d), q4 = *(const LAS f32x4*)(kp + 128 + d);
                    S[d] = decay * S[d] + k4[0] * delta; S[d + 1] = decay * S[d + 1] + k4[1] * delta; S[d + 2] = decay * S[d + 2] + k4[2] * delta; S[d + 3] = decay * S[d + 3] + k4[3] * delta;
                    o0 += q4[0] * S[d] + q4[2] * S[d + 2]; o1 += q4[1] * S[d + 1] + q4[3] * S[d + 3]; }
                __builtin_amdgcn_sched_barrier(0); }
            const int t = dir ? T - 1 - (i0 + j) : i0 + j;
            OD[(size_t)(row0 + t) * GDN_W + h * 128 + e] = o0 + o1;
        }
    }
    if (!lat) { float* so = F.out + OUT_ST + ((((size_t)b * DEPTH + l) * 2 + dir) * HG + h) * (size_t)(DKV * DKV) + e;
#pragma unroll
        for (int d = 0; d < 128; ++d) so[(size_t)d * DKV] = S[d]; }
    __syncthreads();
}
constexpr int ATT_UNITS_LAT = NB_LAT * NQ * (LSEQ / 256), ATT_UNITS = ATT_UNITS_LAT + NB_CTX * NQ;
__device__ __forceinline__ void attn_unit(Frame& F, int u, char* lds) {
    const att::bf16* QA = (const att::bf16*)WSP(bf16, WS_QA); const att::bf16* KA = (const att::bf16*)WSP(bf16, WS_KA); const att::bf16* VA = (const att::bf16*)WSP(bf16, WS_VA);
    att::bf16* MIX = (att::bf16*)WSP(bf16, WS_MIX);
    int qrow0, krow0, h, seq;
    if (u < ATT_UNITS_LAT) { const int b = u / (NQ * 4), r = u % (NQ * 4); h = r >> 2; const int qb = r & 3; qrow0 = M_CTX + b * LSEQ + qb * 256; krow0 = M_CTX + b * (LSEQ + PAST); seq = LSEQ + PAST; }
    else { const int v = u - ATT_UNITS_LAT, b = v >> 3; h = v & 7; qrow0 = b * SEQ; krow0 = b * SEQ; seq = SEQ; }
    const int kvh = h >> 2;
    att::attn_dense_body<att::bf16>(QA + (size_t)qrow0 * ATT_W + h * HD, KA + (size_t)krow0 * 256 + kvh * HD, VA + (size_t)krow0 * 256 + kvh * HD, MIX + (size_t)qrow0 * DM + GDN_W + h * HD, seq, lds);
    __syncthreads();
}
__device__ __forceinline__ void combine_phase(ARGS_T& A, Frame& F, int l) {
    const int gw = F.vcu * NWAVES + F.wave, NGW = F.G * NWAVES, lane = F.lane;
    const f32x2 nw = *(const f32x2*)(A.in[I_GNW] + l * DKV + 2 * lane);
    for (int row = gw; row < M; row += NGW) {
        const float* of = WSP(float, WS_OF) + (size_t)row * GDN_W + 2 * lane; const float* ob = WSP(float, WS_OB) + (size_t)row * GDN_W + 2 * lane;
        const bf16* z = WSP(bf16, WS_PROJ) + (size_t)row * IN_WP + C_Z + 2 * lane; bf16* mx = WSP(bf16, WS_MIX) + (size_t)row * DM + 2 * lane;
#pragma unroll
        for (int h = 0; h < HG; ++h) { const f32x2 a = *(const f32x2*)(of + 128 * h), b = *(const f32x2*)(ob + 128 * h); const float o0 = a[0] + b[0], o1 = a[1] + b[1];
            const float r = frsq(wave_sum(o0 * o0 + o1 * o1) * (1.f / DKV) + RMS_EPS); const unsigned zw = *(const unsigned*)(z + 128 * h);
            *(GAS unsigned*)(mx + 128 * h) = pk2(o0 * r * nw[0] * silu(bf_lo(zw)), o1 * r * nw[1] * silu(bf_hi(zw))); }
    }
}

namespace gdn {
typedef short bf16x8 __attribute__((ext_vector_type(8)));
typedef short s16x4 __attribute__((ext_vector_type(4)));
typedef float f32x16 __attribute__((ext_vector_type(16)));
constexpr int O_QR = 0, O_KR = 17408, O_KT = 34816, O_VT = 53248, O_ST = 71680, O_LR = 106496, O_LT = 115712, O_PR = 124928, O_AT = 134144, O_VEC = 143360, O_VTMP = 145408, O_END = 162816;
constexpr int O_WR = O_KR, O_VNT = O_VT, O_VST = O_LR;
constexpr int SW = 272, SN = 144;
constexpr int V_GC = 0, V_BE = 256, V_EGC = 512, V_BW = 768, V_SF = 1024, V_EG63 = 1280;
constexpr int NCHAIN_LAT = NB_LAT * HG * 2, NCHAIN = NCHAIN_LAT + NB_CTX * HG * 2;
static_assert(O_END + 512 <= LDS_BYTES && O_END <= LDSCTL_OFF, "gdn LDS map");

__device__ __forceinline__ int crow(int r, int hi) { return (r & 3) + 8 * (r >> 2) + 4 * hi; }
__device__ __forceinline__ unsigned cvt2(float lo, float hi) { return pg8::cvt_pk_bf16(lo, hi); }
template <int KS> __device__ __forceinline__ void mma(f32x16& acc, LAS const unsigned char* A, int sa, LAS const unsigned char* B, int sb, int lane) {
    LAS const unsigned char* pa = A + (lane & 31) * sa + (lane >> 5) * 16; LAS const unsigned char* pb = B + (lane & 31) * sb + (lane >> 5) * 16;
#pragma unroll
    for (int ks = 0; ks < KS; ++ks) { const bf16x8 a = *(LAS const bf16x8*)(pa + ks * 32), b = *(LAS const bf16x8*)(pb + ks * 32); acc = __builtin_amdgcn_mfma_f32_32x32x16_bf16(a, b, acc, 0, 0, 0);
        if ((ks & 3) == 3) __builtin_amdgcn_sched_barrier(0); }
}
template <int KS> __device__ __forceinline__ void ldfrag(bf16x8 (&f)[KS], LAS const unsigned char* A, int sa, int lane) {
    LAS const unsigned char* pa = A + (lane & 31) * sa + (lane >> 5) * 16;
#pragma unroll
    for (int ks = 0; ks < KS; ++ks) f[ks] = *(LAS const bf16x8*)(pa + ks * 32);
}
__device__ __forceinline__ void st_T(LAS unsigned char* dst, int sd, const f32x16& v, int lane) {
    LAS unsigned char* p = dst + (lane & 31) * sd + (lane >> 5) * 8;
#pragma unroll
    for (int rg = 0; rg < 4; ++rg) *(LAS v2u*)(p + rg * 16) = (v2u){cvt2(v[4 * rg], v[4 * rg + 1]), cvt2(v[4 * rg + 2], v[4 * rg + 3])};
}
__device__ __forceinline__ void st_R(LAS unsigned char* dst, int sd, const f32x16& v, int lane) {
    const int hi = lane >> 5; LAS unsigned char* p = dst + (lane & 31) * 2;
#pragma unroll
    for (int r = 0; r < 16; r += 2) { const unsigned w = cvt2(v[r], v[r + 1]);
        *(LAS unsigned short*)(p + crow(r, hi) * sd) = (unsigned short)(w & 0xffffu); *(LAS unsigned short*)(p + crow(r + 1, hi) * sd) = (unsigned short)(w >> 16); }
}
__device__ __forceinline__ void ldrow16(float (&o)[16], LAS const unsigned char* vec, int m0, int hi) {
#pragma unroll
    for (int rg = 0; rg < 4; ++rg) { const f32x4 t = *(LAS const f32x4*)(vec + 4 * (m0 + 8 * rg + 4 * hi)); o[4 * rg] = t[0]; o[4 * rg + 1] = t[1]; o[4 * rg + 2] = t[2]; o[4 * rg + 3] = t[3]; }
}

__device__ __forceinline__ void chain(ARGS_T& A, Frame& F, int l, int cid) {
    const bool lat = cid < NCHAIN_LAT; const int c2 = lat ? cid : cid - NCHAIN_LAT; const int b = c2 >> 4, h = (c2 >> 1) & 7, dir = c2 & 1;
    const int T = lat ? LSEQ : SEQ, NC = T / 64, row0 = lat ? M_CTX + b * LSEQ : b * SEQ;
    LAS unsigned char* L = F.lds; LAS unsigned char* VEC = L + O_VEC;
    const int tid0 = F.tid, w0 = F.wave;
    const bf16* QG = WSP(bf16, WS_QG) + h * 128; const bf16* KG = WSP(bf16, WS_KG) + h * 128; const bf16* VG = WSP(bf16, WS_VG) + h * 128;
    const float* GGp = WSP(float, WS_GG) + dir * 8 + h; const float* BBp = WSP(float, WS_BB) + dir * 8 + h;
    float* OD = (dir ? WSP(float, WS_OB) : WSP(float, WS_OF)) + h * 128;
    f32x16 S0t, S1t;
    { const int w = w0, lane = tid0 & 63, hi = lane >> 5, c31 = lane & 31, te_s = w & 3, td0 = w >> 2, td1 = 2 + (w >> 2);
    if (lat) { const float* s0 = A.in[I_ST] + ((((size_t)b * DEPTH + l) * 2 + dir) * HG + h) * (size_t)(DKV * DKV);
        const float* p0 = s0 + (32 * td0 + 4 * hi) * DKV + 32 * te_s + c31; const float* p1 = s0 + (32 * td1 + 4 * hi) * DKV + 32 * te_s + c31;
#pragma unroll
        for (int rg = 0; rg < 4; ++rg) {
#pragma unroll
            for (int x = 0; x < 4; ++x) { S0t[4 * rg + x] = p0[(8 * rg + x) * DKV]; S1t[4 * rg + x] = p1[(8 * rg + x) * DKV]; }
            asm volatile("" ::: "memory"); } }
    else {
#pragma unroll
        for (int r = 0; r < 16; ++r) { S0t[r] = 0.f; S1t[r] = 0.f; } }
    st_T(L + O_ST + 32 * te_s * SW + 32 * td0 * 2, SW, S0t, lane); st_T(L + O_ST + 32 * te_s * SW + 32 * td1 * 2, SW, S1t, lane); }
    v4u pq[2], pk[2], pv[2]; float pg = 0.f, pb = 0.f;
#define GDN_LOAD(c) do { _Pragma("unroll") for (int i_ = 0; i_ < 2; ++i_) { const int p_ = tid + 512 * i_, tl_ = 64 * (c) + (p_ >> 4), t_ = dir ? T - 1 - tl_ : tl_; const size_t off_ = (size_t)(row0 + t_) * GDN_W + 8 * (p_ & 15); \
        pq[i_] = *(const v4u*)(QG + off_); pk[i_] = *(const v4u*)(KG + off_); pv[i_] = *(const v4u*)(VG + off_); } \
        if (w == 0) { const int tl_ = 64 * (c) + lane, t_ = dir ? T - 1 - tl_ : tl_; pg = GGp[(size_t)(row0 + t_) * 16]; pb = BBp[(size_t)(row0 + t_) * 16]; } } while (0)
    { const int tid = tid0, w = w0, lane = tid0 & 63; GDN_LOAD(0); }
    for (int c = 0; c < NC; ++c) {
        int tid = tid0, w = w0; asm volatile("" : "+v"(tid)); asm volatile("" : "+s"(w));
        const int lane = tid & 63, hi = lane >> 5, c31 = lane & 31, te_s = w & 3, td0 = w >> 2, td1 = 2 + (w >> 2);
#pragma unroll
        for (int i = 0; i < 2; ++i) { const int p = tid + 512 * i, row = p >> 4, cb = p & 15;
            *(LAS v4u*)(L + O_QR + row * SW + cb * 16) = pq[i]; *(LAS v4u*)(L + O_KR + row * SW + cb * 16) = pk[i]; *(LAS v4u*)(L + O_VTMP + row * SW + cb * 16) = pv[i]; }
        if (w == 0) { float s = pg;
#pragma unroll
            for (int o = 1; o < 64; o <<= 1) { const float t = __shfl_up(s, o); if (lane >= o) s += t; }
            const float g63 = __shfl(s, 63), eg = __expf(s);
            *(LAS float*)(VEC + V_GC + 4 * lane) = s; *(LAS float*)(VEC + V_BE + 4 * lane) = pb; *(LAS float*)(VEC + V_EGC + 4 * lane) = eg; *(LAS float*)(VEC + V_BW + 4 * lane) = pb * eg;
            *(LAS float*)(VEC + V_SF + 4 * lane) = __expf(g63 - s); if (lane == 0) *(LAS float*)(VEC + V_EG63) = __expf(g63); }
        __syncthreads();
        if (c + 1 < NC) GDN_LOAD(c + 1);
#pragma unroll
        for (int n = 0; n < 4; ++n) { const int idx = 4 * n + (lane >> 4), rb = 2 * w + (idx >> 3), cbk = idx & 7, i16 = lane & 15, q = i16 >> 2, p = i16 & 3;
            const int so = (4 * rb + q) * SW + (16 * cbk + 4 * p) * 2, dof = (16 * cbk + i16) * SN + (4 * rb) * 2;
            const s16x4 kx = __builtin_bit_cast(s16x4, __builtin_amdgcn_ds_read_tr16_b64_v4i16((LAS s16x4*)(L + O_KR + so)));
            const s16x4 vx = __builtin_bit_cast(s16x4, __builtin_amdgcn_ds_read_tr16_b64_v4i16((LAS s16x4*)(L + O_VTMP + so)));
            *(LAS s16x4*)(L + O_KT + dof) = kx; *(LAS s16x4*)(L + O_VT + dof) = vx; }
        f32x16 Tt;
        constexpr int SB = 80;
        LAS unsigned char* W = L + O_LR + (w & 1) * 10240;
        LAS unsigned char* CRb = L + O_LR + 20480; LAS unsigned char* A32T = L + O_LR + 23040;
#pragma unroll
        for (int r = 0; r < 16; ++r) Tt[r] = 0.f;
        if (w < 3) {
            const int ti = (w == 0) ? 0 : 1, tj = (w == 1) ? 1 : 0; f32x16 acc;
#pragma unroll
            for (int r = 0; r < 16; ++r) acc[r] = 0.f;
            mma<8>(acc, L + O_KR + 32 * ti * SW, SW, L + O_KR + 32 * tj * SW, SW, lane);
            float gi[16], bi[16]; ldrow16(gi, VEC + V_GC, 32 * ti, hi); ldrow16(bi, VEC + V_BE, 32 * ti, hi);
            const float gj = *(LAS const float*)(VEC + V_GC + 4 * (32 * tj + c31)); const int j = 32 * tj + c31; f32x16 lv;
#pragma unroll
            for (int r = 0; r < 16; ++r) { const int i = 32 * ti + crow(r, hi); lv[r] = (i > j) ? bi[r] * acc[r] * __expf(gi[r] - gj) : 0.f; }
            if (w == 2) st_R(CRb, SB, lv, lane);
            else { const int jb = (lane >> 4) & 1; f32x16 ld, lo, z;
#pragma unroll
                for (int r = 0; r < 16; ++r) { const int ib = r >> 3; ld[r] = (ib == jb) ? lv[r] : 0.f; lo[r] = (ib == 1 && jb == 0) ? lv[r] : 0.f; Tt[r] = ((crow(r, hi) == c31) ? 1.f : 0.f) - ld[r]; }
                st_R(W, SB, ld, lane); st_T(W + 2560, SB, ld, lane); st_R(W + 5120, SB, Tt, lane); st_R(W + 7680, SB, lo, lane); LDS_WAIT();
#pragma unroll
                for (int r = 0; r < 16; ++r) z[r] = 0.f;
                mma<2>(z, W, SB, W + 2560, SB, lane); st_R(W, SB, z, lane); st_T(W + 2560, SB, z, lane); LDS_WAIT();
#pragma unroll
                for (int s2 = 0; s2 < 2; ++s2) { f32x16 z2;
#pragma unroll
                    for (int r = 0; r < 16; ++r) z2[r] = 0.f;
                    mma<2>(Tt, W + 5120, SB, W + 2560, SB, lane); mma<2>(z2, W, SB, W + 2560, SB, lane);
                    st_R(W + 5120, SB, Tt, lane); st_R(W, SB, z2, lane); st_T(W + 2560, SB, z2, lane); LDS_WAIT(); }
                mma<2>(Tt, W + 5120, SB, W + 2560, SB, lane); st_R(W + 5120, SB, Tt, lane); st_T(W + 2560, SB, Tt, lane); LDS_WAIT();
#pragma unroll
                for (int r = 0; r < 16; ++r) z[r] = 0.f;
                mma<2>(z, W + 7680, SB, W + 2560, SB, lane);
#pragma unroll
                for (int r = 0; r < 16; ++r) z[r] = -z[r];
                st_T(W, SB, z, lane); LDS_WAIT();
                mma<2>(Tt, W + 5120, SB, W, SB, lane);
                if (w == 0) st_T(A32T, SB, Tt, lane); else st_R(W + 5120, SB, Tt, lane); }
        } else if (w >= 4) { const int ti = (w >> 1) & 1, tj = w & 1; f32x16 acc;
#pragma unroll
            for (int r = 0; r < 16; ++r) acc[r] = 0.f;
            mma<8>(acc, L + O_QR + 32 * ti * SW, SW, L + O_KR + 32 * tj * SW, SW, lane);
            float gi[16]; ldrow16(gi, VEC + V_GC, 32 * ti, hi); const float gj = *(LAS const float*)(VEC + V_GC + 4 * (32 * tj + c31)); const int j = 32 * tj + c31; f32x16 av;
#pragma unroll
            for (int r = 0; r < 16; ++r) { const int i = 32 * ti + crow(r, hi); av[r] = (i >= j) ? acc[r] * __expf(gi[r] - gj) : 0.f; }
            st_R(L + O_AT + 32 * ti * SN + 32 * tj * 2, SN, av, lane); }
        __syncthreads();
        if (w == 2) { f32x16 y;
#pragma unroll
            for (int r = 0; r < 16; ++r) y[r] = 0.f;
            mma<2>(y, CRb, SB, A32T, SB, lane);
#pragma unroll
            for (int r = 0; r < 16; ++r) y[r] = -y[r];
            st_T(CRb, SB, y, lane); LDS_WAIT();
            mma<2>(Tt, L + O_LR + 10240 + 5120, SB, CRb, SB, lane); }
        __syncthreads();
        if (w < 4) { const int ti = (w == 0 || w == 3) ? 0 : 1, tj = (w == 1 || w == 3) ? 1 : 0;
            const float bj = *(LAS const float*)(VEC + V_BE + 4 * (32 * tj + c31)), bwj = *(LAS const float*)(VEC + V_BW + 4 * (32 * tj + c31)); f32x16 tu, tw;
#pragma unroll
            for (int r = 0; r < 16; ++r) { tu[r] = Tt[r] * bj; tw[r] = Tt[r] * bwj; }
            st_R(L + O_LR + 32 * ti * SN + 32 * tj * 2, SN, tu, lane); st_R(L + O_LR + 10240 + 32 * ti * SN + 32 * tj * 2, SN, tw, lane); }
        __syncthreads();
        const int ti = w >> 2, te = w & 3;
        f32x16 au, aw;
#pragma unroll
        for (int r = 0; r < 16; ++r) { au[r] = 0.f; aw[r] = 0.f; }
        mma<4>(au, L + O_LR + 32 * ti * SN, SN, L + O_VT + 32 * te * SN, SN, lane);
        mma<4>(aw, L + O_LR + 10240 + 32 * ti * SN, SN, L + O_KT + 32 * te * SN, SN, lane);
#pragma unroll
        for (int r = 0; r < 16; ++r) aw[r] = -aw[r];
        st_R(L + O_WR + 32 * ti * SW + 32 * te * 2, SW, aw, lane);
        __syncthreads();
        f32x16 aq;
#pragma unroll
        for (int r = 0; r < 16; ++r) aq[r] = 0.f;
        mma<8>(au, L + O_WR + 32 * ti * SW, SW, L + O_ST + 32 * te * SW, SW, lane);
        mma<8>(aq, L + O_QR + 32 * ti * SW, SW, L + O_ST + 32 * te * SW, SW, lane);
        { float sf[16]; ldrow16(sf, VEC + V_SF, 32 * ti, hi); f32x16 vs;
#pragma unroll
            for (int r = 0; r < 16; ++r) vs[r] = au[r] * sf[r];
            st_T(L + O_VNT + 32 * te * SN + 32 * ti * 2, SN, au, lane); st_T(L + O_VST + 32 * te * SN + 32 * ti * 2, SN, vs, lane); }
        __syncthreads();
        { float eg[16]; ldrow16(eg, VEC + V_EGC, 32 * ti, hi);
#pragma unroll
            for (int r = 0; r < 16; ++r) aq[r] *= eg[r];
            mma<4>(aq, L + O_AT + 32 * ti * SN, SN, L + O_VNT + 32 * te * SN, SN, lane);
#pragma unroll
            for (int r = 0; r < 16; ++r) { const int tl = 64 * c + 32 * ti + crow(r, hi), t = dir ? T - 1 - tl : tl; OD[(size_t)(row0 + t) * GDN_W + 32 * te + c31] = aq[r]; } }
        { const float e63 = *(LAS const float*)(VEC + V_EG63);
#pragma unroll
            for (int r = 0; r < 16; ++r) { S0t[r] *= e63; S1t[r] *= e63; }
            mma<4>(S0t, L + O_KT + 32 * td0 * SN, SN, L + O_VST + 32 * te_s * SN, SN, lane);
            mma<4>(S1t, L + O_KT + 32 * td1 * SN, SN, L + O_VST + 32 * te_s * SN, SN, lane);
            st_T(L + O_ST + 32 * te_s * SW + 32 * td0 * 2, SW, S0t, lane); st_T(L + O_ST + 32 * te_s * SW + 32 * td1 * 2, SW, S1t, lane); }
        __syncthreads();
    }
#undef GDN_LOAD
    int tid2 = tid0, w = w0; asm volatile("" : "+v"(tid2)); asm volatile("" : "+s"(w));
    const int lane = tid2 & 63, hi = lane >> 5, c31 = lane & 31, te_s = w & 3, td0 = w >> 2, td1 = 2 + (w >> 2);
    if (!lat) { float* so = F.out + OUT_ST + ((((size_t)b * DEPTH + l) * 2 + dir) * HG + h) * (size_t)(DKV * DKV);
        float* p0 = so + (32 * td0 + 4 * hi) * DKV + 32 * te_s + c31; float* p1 = so + (32 * td1 + 4 * hi) * DKV + 32 * te_s + c31;
#pragma unroll
        for (int rg = 0; rg < 4; ++rg) {
#pragma unroll
            for (int x = 0; x < 4; ++x) { p0[(8 * rg + x) * DKV] = S0t[4 * rg + x]; p1[(8 * rg + x) * DKV] = S1t[4 * rg + x]; }
            asm volatile("" ::: "memory"); } }
}
}
__device__ __forceinline__ void mixer_phase(ARGS_T& A, Frame& F, int l, char* lds_generic) {
    using namespace gdn;
    if (F.G == 256) {
        if (F.bx < NCHAIN_LAT) { chain(A, F, l, F.bx); return; }
        for (int c = NCHAIN_LAT + (F.bx - NCHAIN_LAT); c < NCHAIN; c += 256 - NCHAIN_LAT) chain(A, F, l, c);
        if (F.bx >= 96 && F.bx < 160) attn_unit(F, F.bx - 96, lds_generic);
        else if (F.bx >= 160) for (int u = ATT_UNITS_LAT + (F.bx - 160); u < ATT_UNITS; u += 96) attn_unit(F, u, lds_generic);
    } else {
        for (int c = F.bx; c < NCHAIN; c += F.G) chain(A, F, l, c);
        for (int u = F.bx; u < ATT_UNITS; u += F.G) attn_unit(F, u, lds_generic);
    }
}

constexpr int PH_PER_LAYER = 9, N_PHASES = 2 + DEPTH * PH_PER_LAYER;
extern __shared__ __attribute__((aligned(16))) unsigned char lds[];
__device__ __forceinline__ void frame_init(Frame& F, ARGS_T& A) {
    F.lds = (LAS unsigned char*)lds; F.MISC = (volatile LAS unsigned*)(F.lds + MISC_OFF);
    F.tid = fresh_tid(); F.lane = F.tid & 63; F.wave = __builtin_amdgcn_readfirstlane(F.tid >> 6);
    F.G = gridDim.x; F.bx = fresh_bx(); F.vcu = (F.G % 8 == 0) ? (F.bx % 8) * (F.G / 8) + F.bx / 8 : F.bx;
    F.out = A.out; F.ws = A.ws; F.ctl = (gu32*)(A.ws + WS_CTL);
}
template <int LO, int HI>
__global__ void __launch_bounds__(NWAVES * 64, 2) trunk_fwd(Args args_unused) {
    { const int t0 = fresh_tid(); for (int u = t0; u < (LDS_BYTES - LDSCTL_OFF) / 4; u += NWAVES * 64) ((LAS unsigned*)((LAS unsigned char*)lds + LDSCTL_OFF))[u] = 0u; }
    __syncthreads();
    if (HI - LO > 1) { ARGS_T& A = *fresh_args(); (void)xcd_barrier_post((unsigned*)(A.ws + WS_CTL) + CW_BAR, (volatile LAS unsigned*)((LAS unsigned char*)lds + MISC_OFF) + 8); }
#define IN(k) (LO <= (k) && (k) < HI)
#define SEAM(k) do { if (IN(k) && IN((k) + 1)) { ARGS_T& A_ = *fresh_args(); XcdBarrier bar_; bar_.bar = (unsigned*)(A_.ws + WS_CTL) + CW_BAR; bar_.x = xb_xcc_id(); bar_.st = (volatile LAS unsigned*)((LAS unsigned char*)lds + MISC_OFF) + 8; xcd_barrier(bar_); } } while (0)
#define PHASE_BEGIN ARGS_T& A = *fresh_args(); Frame F; frame_init(F, A);
#if MK_DIAG
#define STAMP(k) do { if (blockIdx.x == 0 && threadIdx.x == 0) ((volatile LAS unsigned long long*)((LAS unsigned char*)lds + LDSCTL_OFF))[(k) + 1] = __builtin_amdgcn_s_memrealtime(); } while (0)
    if (blockIdx.x == 0 && threadIdx.x == 0) ((volatile LAS unsigned long long*)((LAS unsigned char*)lds + LDSCTL_OFF))[0] = __builtin_amdgcn_s_memrealtime();
#else
#define STAMP(k) do { } while (0)
#endif

    if (IN(0)) { PHASE_BEGIN p0a_phase(A, F); } SEAM(0); STAMP(0);
    if (IN(1)) { PHASE_BEGIN p0b_phase(A, F); } SEAM(1); STAMP(1);
#pragma unroll
    for (int l = 0; l < DEPTH; ++l) {
        const int pb = 2 + l * PH_PER_LAYER;
        constexpr size_t MODL = 3 * 12288;
        if (IN(pb + 0)) { PHASE_BEGIN pg8::Gemm g{WSP(bf16, WS_H), WSP(bf16, WS_WIN) + (size_t)l * IN_WP * DM, M, IN_WP, DM}; pg8::StaticOrder S; S.init(M, IN_WP, F.G, F.bx, DM);
            pg8::EpiBf16 E{WSP(bf16, WS_PROJ), IN_WP};
            pg8::gemm_phase<DM, pg8::EpiBf16, pg8::StaticOrder, true, true>(F.lds + RING_OFF, g, S, E); }
        SEAM(pb + 0); STAMP(pb + 0);
        if (IN(pb + 1)) { PHASE_BEGIN prep_phase(A, F, l); } SEAM(pb + 1); STAMP(pb + 1);
        if (IN(pb + 2)) { PHASE_BEGIN mixer_phase(A, F, l, (char*)lds + RING_OFF); }
        SEAM(pb + 2); STAMP(pb + 2);
        if (IN(pb + 3)) { PHASE_BEGIN combine_phase(A, F, l); } SEAM(pb + 3); STAMP(pb + 3);
        if (IN(pb + 4)) { PHASE_BEGIN pg8::Gemm g{WSP(bf16, WS_MIX), WSP(bf16, WS_WO) + (size_t)l * DM * DM, M, DM, DM}; pg8::TailOrder S; S.init(F.G, F.bx, DM);
            const float* mod = WSP(float, WS_MOD) + (size_t)l * MODL;
            pg8::EpiResid E{l == 0 ? A.in[I_XP] : F.out, F.out, mod + 2 * DM, DN_ALPHA, WSP(float, WS_PART)};
            pg8::gemm_phase<DM, pg8::EpiResid, pg8::TailOrder, true, true>(F.lds + RING_OFF, g, S, E); }
        SEAM(pb + 4); STAMP(pb + 4);
        if (IN(pb + 5)) { PHASE_BEGIN const float* mod = WSP(float, WS_MOD) + (size_t)l * MODL; ln_phase(A, F, A.in[I_LN1G] + l * DM, A.in[I_LN1B] + l * DM, mod + 3 * DM, mod + 4 * DM, true, WSP(float, WS_PART), l == 0 ? A.in[I_XS] : F.out + (size_t)M_CTX * DM, mod + 2 * DM, DN_ALPHA); } SEAM(pb + 5); STAMP(pb + 5);
        if (IN(pb + 6)) { PHASE_BEGIN pg8::Gemm g{WSP(bf16, WS_H), WSP(bf16, WS_WGU) + (size_t)l * 2 * DFF * DM, M, 2 * DFF, DM}; pg8::StaticOrder S; S.init(M, 2 * DFF, F.G, F.bx, DM);
            pg8::EpiSwiGLU E{WSP(bf16, WS_PROJ), DFF};
            pg8::gemm_phase<DM, pg8::EpiSwiGLU, pg8::StaticOrder, true, true>(F.lds + RING_OFF, g, S, E); }
        SEAM(pb + 6); STAMP(pb + 6);
        if (IN(pb + 7)) { PHASE_BEGIN pg8::Gemm g{WSP(bf16, WS_PROJ), WSP(bf16, WS_WD) + (size_t)l * DM * DFF, M, DM, DFF}; pg8::TailOrder S; S.init(F.G, F.bx, DFF);
            const float* mod = WSP(float, WS_MOD) + (size_t)l * MODL;
            pg8::EpiResid E{F.out, F.out, mod + 5 * DM, DN_ALPHA, WSP(float, WS_PART)};
            pg8::gemm_phase<DFF, pg8::EpiResid, pg8::TailOrder, true, true>(F.lds + RING_OFF, g, S, E); }
        SEAM(pb + 7); STAMP(pb + 7);
        if (IN(pb + 8)) { PHASE_BEGIN const float* modn = WSP(float, WS_MOD) + (size_t)(l + 1) * MODL; const float* mod = WSP(float, WS_MOD) + (size_t)l * MODL;
            ln_phase(A, F, A.in[I_LN2G] + l * DM, A.in[I_LN2B] + l * DM, modn, modn + DM, l + 1 < DEPTH, WSP(float, WS_PART), F.out + (size_t)M_CTX * DM, mod + 5 * DM, DN_ALPHA); }
        if (l + 1 < DEPTH) SEAM(pb + 8);
        STAMP(pb + 8);
    }
#if MK_DIAG
    if (blockIdx.x == 0 && threadIdx.x == 0) {
        volatile LAS unsigned long long* st = (volatile LAS unsigned long long*)((LAS unsigned char*)lds + LDSCTL_OFF);
        unsigned long long tot = 0;
        for (int k = 0; k < N_PHASES; ++k) { const int ty = k < 2 ? k : 2 + (k - 2) % PH_PER_LAYER; if (ty == MK_DIAG_A || MK_DIAG_A == 99) tot += st[k + 1] - st[k]; }
        const unsigned long long t0 = __builtin_amdgcn_s_memrealtime();
        while (__builtin_amdgcn_s_memrealtime() - t0 < 4 * tot) __builtin_amdgcn_s_sleep(8);
    }
#endif
#undef IN
#undef SEAM
#undef PHASE_BEGIN
}

typedef void (*kfn_t)(Args);
template <int... P> static void fill_fns(kfn_t* f, std::integer_sequence<int, P...>) { ((f[P] = trunk_fwd<P, P + 1>), ...); }
extern "C" void kernel_launch(void* const* d_in, const int* in_sizes, int n_in, void* d_out, int out_size, void* d_ws, size_t ws_size, hipStream_t stream) {
    static int grid = 0; static kfn_t fns[N_PHASES + 1];
    if (grid == 0) {
        if (n_in != N_IN || in_sizes[I_XP] != M_CTX * DM || in_sizes[I_XS] != M_LAT * DM || (size_t)out_size != OUT_TOTAL || ws_size < WS_END) {
            fprintf(stderr, "kernel_launch: shape mismatch n_in %d out %d ws %zu (need %zu)\n", n_in, out_size, ws_size, (size_t)WS_END); grid = -1; return; }
        int dev = 0, cus = 0;
        if (hipGetDevice(&dev) != hipSuccess || hipDeviceGetAttribute(&cus, hipDeviceAttributeMultiprocessorCount, dev) != hipSuccess) { grid = -1; return; }
#if MK_PER_PHASE
        fill_fns(fns, std::make_integer_sequence<int, N_PHASES>{});
        for (int p = 0; p < N_PHASES; ++p)
            if (hipFuncSetAttribute((const void*)fns[p], hipFuncAttributeMaxDynamicSharedMemorySize, LDS_BYTES) != hipSuccess) { fprintf(stderr, "kernel_launch: hipFuncSetAttribute failed (phase %d)\n", p); grid = -1; return; }
#else
        fns[N_PHASES] = trunk_fwd<0, N_PHASES>;
        if (hipFuncSetAttribute((const void*)fns[N_PHASES], hipFuncAttributeMaxDynamicSharedMemorySize, LDS_BYTES) != hipSuccess) { fprintf(stderr, "kernel_launch: hipFuncSetAttribute failed\n"); grid = -1; return; }
#endif
        (void)hipGetLastError();
        grid = cus;
    }
    if (grid < 0) return;
    if (hipMemsetAsync((char*)d_ws + WS_CTL, 0, CTL_ZERO_BYTES, stream) != hipSuccess) { fprintf(stderr, "kernel_launch: hipMemsetAsync failed\n"); return; }
    Args a{};
    for (int i = 0; i < N_IN; ++i) a.in[i] = (const float*)d_in[i];
    a.out = (float*)d_out; a.ws = (unsigned char*)d_ws;
#if MK_PER_PHASE
    for (int p = 0; p < N_PHASES; ++p) {
        hipLaunchKernelGGL(fns[p], dim3(grid), dim3(NWAVES * 64), LDS_BYTES, stream, a);
        const hipError_t le = hipPeekAtLastError(); if (le != hipSuccess) { fprintf(stderr, "kernel_launch: launch %d failed: %s\n", p, hipGetErrorName(le)); break; } }
#else
    hipLaunchKernelGGL(fns[N_PHASES], dim3(grid), dim3(NWAVES * 64), LDS_BYTES, stream, a);
    { const hipError_t le = hipPeekAtLastError(); if (le != hipSuccess) fprintf(stderr, "kernel_launch: launch failed: %s\n", hipGetErrorName(le)); }
#endif
}
```

```cpp
#include <hip/hip_runtime.h>
#include <hip/hip_bf16.h>
#include <cstdio>
#include <cstdint>
#include <cmath>
#include <utility>
namespace pg8 {
#define PG8_LAS __attribute__((address_space(3)))
typedef unsigned short bf16_t;
typedef short bf16x8 __attribute__((ext_vector_type(8)));
typedef float f32x4 __attribute__((ext_vector_type(4)));
typedef unsigned u32x4 __attribute__((ext_vector_type(4)));
constexpr int BM = 256, BK = 64, HALF = 128, HTB = HALF * BK * 2  , STAGE_BYTES = 8 * HTB, NXCD = 8, WGM = 8;

__host__ __device__ __forceinline__ int lds_byte(int r, int c) { const int st = (r >> 4) * 2 + (c >> 5), rr = r & 15, cc = c & 31, ob = rr * 64 + cc * 2; return st * 1024 + (ob ^ (((ob >> 9) & 1) << 5)); }
__host__ __device__ __forceinline__ void stage_rc(int b, int& R, int& C) { const int st = b / 1024, sb = b % 1024, swz = sb ^ (((sb >> 9) & 1) << 5); R = (st >> 1) * 16 + swz / 64; C = (st & 1) * 32 + (swz % 64) / 2; }
__host__ __device__ __forceinline__ int perm32(int rho) { const int n = rho >> 4, i = rho & 15; return 8 * (i >> 2) + 4 * n + (i & 3); }

struct Unit { int pm, pn, k0, nt, sp; };
struct Gemm { const bf16_t* A; const bf16_t* Bt; int M, N, K; };

struct StaticOrder {
    int nM, nN, nwg, G, c, ntk;
    __host__ __device__ void init(int M, int N, int G_, int c_, int K) { nM = M / BM; nN = N / BM; nwg = nM * nN; G = G_; c = c_; ntk = K / BK; }
    __host__ __device__ bool next(int i, Unit& u) const {
        const long L = (long)i * G + c; if (L >= nwg) return false;
        int wgid = (int)L; { const int q = nwg / NXCD, r = nwg % NXCD, xcd = wgid % NXCD, off = wgid / NXCD; wgid = (xcd < r ? xcd * (q + 1) : r * (q + 1) + (xcd - r) * q) + off; }
        const int nig = WGM * nN, gid = wgid / nig, fm = gid * WGM, gsz = (nM - fm) < WGM ? (nM - fm) : WGM;
        u.pm = fm + ((wgid % nig) % gsz); u.pn = (wgid % nig) / gsz; u.k0 = 0; u.nt = ntk; u.sp = -1; return true;
    }
    __device__ __forceinline__ void a_ready(const Unit&) const {}
    __device__ __forceinline__ void done(const Unit&) const {}
};
struct TailOrder {
    int G, c, ntk;
    __host__ __device__ void init(int G_, int c_, int K) { G = G_; c = c_; ntk = K / BK; }
    __host__ __device__ bool next(int i, Unit& u) const {
        const int L = i * G + c; if (L >= 512) return false;
        const int f = L & 255, xcd = f & 7, idx = f >> 3;
        const bool whole = L < 256; const int q = ntk >> 2, sp = idx >> 3;
        u.pm = whole ? 4 * xcd + (idx & 3) : 32 + xcd; u.pn = whole ? (idx >> 2) : (idx & 7); u.sp = whole ? -1 : sp; u.nt = whole ? ntk : q; u.k0 = whole ? 0 : sp * q * BK;
        return true;
    }
    __device__ __forceinline__ void a_ready(const Unit&) const {}
    __device__ __forceinline__ void done(const Unit&) const {}
};


__device__ __forceinline__ unsigned cvt_pk_bf16(float lo, float hi) { unsigned r; asm volatile("v_cvt_pk_bf16_f32 %0, %1, %2" : "=v"(r) : "v"(lo), "v"(hi)); return r; }
__device__ __forceinline__ float silu_f(float x) { return x * __builtin_amdgcn_rcpf(1.0f + __builtin_amdgcn_exp2f(-1.4426950408889634f * x)); }

struct EpiBf16 {
    static constexpr bool PERM = true, AFTER_DRAIN = false;
    bf16_t* O; int ldc;
    __device__ __forceinline__ void operator()(const f32x4 (&acc)[2][2][4][2], const Unit& u, int wr, int wc, int fr, int fq) const {
        const int row0 = u.pm * BM + wr * 64 + fr; const int col0 = u.pn * BM + wc * 32 + 8 * fq;
#pragma unroll
        for (int ai = 0; ai < 2; ++ai)
#pragma unroll
            for (int m = 0; m < 4; ++m) { bf16_t* rowp = O + (size_t)(row0 + ai * HALF + m * 16) * ldc + col0;
#pragma unroll
                for (int bj = 0; bj < 2; ++bj) { const f32x4 v0 = acc[ai][bj][m][0], v1 = acc[ai][bj][m][1];
                    u32x4 w; w.x = cvt_pk_bf16(v0[0], v0[1]); w.y = cvt_pk_bf16(v0[2], v0[3]); w.z = cvt_pk_bf16(v1[0], v1[1]); w.w = cvt_pk_bf16(v1[2], v1[3]);
                    *(u32x4*)(rowp + bj * HALF) = w; } }
    }
};
struct EpiSwiGLU {
    static constexpr bool PERM = true, AFTER_DRAIN = false;
    bf16_t* O; int ldc;
    __device__ __forceinline__ void operator()(const f32x4 (&acc)[2][2][4][2], const Unit& u, int wr, int wc, int fr, int fq) const {
        const int row0 = u.pm * BM + wr * 64 + fr; const int col0 = u.pn * HALF + wc * 32 + 8 * fq;
#pragma unroll
        for (int ai = 0; ai < 2; ++ai)
#pragma unroll
            for (int m = 0; m < 4; ++m) { bf16_t* rowp = O + (size_t)(row0 + ai * HALF + m * 16) * ldc + col0;
                const f32x4 g0 = acc[ai][0][m][0], g1 = acc[ai][0][m][1], u0 = acc[ai][1][m][0], u1 = acc[ai][1][m][1];
                u32x4 w;
                w.x = cvt_pk_bf16(silu_f(g0[0]) * u0[0], silu_f(g0[1]) * u0[1]); w.y = cvt_pk_bf16(silu_f(g0[2]) * u0[2], silu_f(g0[3]) * u0[3]);
                w.z = cvt_pk_bf16(silu_f(g1[0]) * u1[0], silu_f(g1[1]) * u1[1]); w.w = cvt_pk_bf16(silu_f(g1[2]) * u1[2], silu_f(g1[3]) * u1[3]);
                *(u32x4*)rowp = w; }
    }
};
struct EpiResid {
    static constexpr bool PERM = false, AFTER_DRAIN = false;
    const float* xp; float* X; const float* gate; float alpha; float* part;
    __device__ __forceinline__ void operator()(const f32x4 (&acc)[2][2][4][2], const Unit& u, int wr, int wc, int fr, int fq) const {
        const int col0 = u.pn * BM + wc * 32 + 4 * fq;
        if (u.sp >= 0) {
#pragma unroll
            for (int ai = 0; ai < 2; ++ai)
#pragma unroll
                for (int m = 0; m < 4; ++m) { const int row = (u.pm - 32) * BM + ai * HALF + wr * 64 + m * 16 + fr; float* dst = part + ((size_t)u.sp * 2048 + row) * 2048 + col0;
#pragma unroll
                    for (int bj = 0; bj < 2; ++bj)
#pragma unroll
                        for (int n = 0; n < 2; ++n) *(f32x4*)(dst + bj * HALF + n * 16) = acc[ai][bj][m][n]; }
            return; }
        f32x4 gv[2][2];
#pragma unroll
        for (int bj = 0; bj < 2; ++bj)
#pragma unroll
            for (int n = 0; n < 2; ++n) gv[bj][n] = *(const f32x4*)(gate + col0 + bj * HALF + n * 16);
#pragma unroll
        for (int ai = 0; ai < 2; ++ai)
#pragma unroll
            for (int m = 0; m < 4; ++m) { const int row = u.pm * BM + ai * HALF + wr * 64 + m * 16 + fr;
                const float* src = xp + (size_t)row * 2048 + col0; float* dst = X + (size_t)row * 2048 + col0;
#pragma unroll
                for (int bj = 0; bj < 2; ++bj)
#pragma unroll
                    for (int n = 0; n < 2; ++n) { const f32x4 xin = *(const f32x4*)(src + bj * HALF + n * 16);
                        *(f32x4*)(dst + bj * HALF + n * 16) = xin * alpha + gv[bj][n] * acc[ai][bj][m][n]; } }
    }
};

template <int KK, class Epi, class Sched, bool ALIGN_EPI = false, bool SP2 = false>
__device__ __forceinline__ void gemm_phase(PG8_LAS unsigned char* lds, const Gemm g, const Sched& S, const Epi& E) {
    int tid_ = threadIdx.x; asm volatile("" : "+v"(tid_)); const int tid = tid_, wid = __builtin_amdgcn_readfirstlane(tid >> 6), lane = tid & 63, wr = wid >> 2, wc = wid & 3, fr = lane & 15, fq = lane >> 4;
    constexpr int K = KK;
    unsigned voffA[2], voffB[2];
#pragma unroll
    for (int i = 0; i < 2; ++i) { int R, C; stage_rc(tid * 16 + i * 8192, R, C); const int Rb = Epi::PERM ? ((R & ~31) + perm32(R & 31)) : R;
        voffA[i] = (unsigned)(R * K + C) * 2u; voffB[i] = (unsigned)(Rb * K + C) * 2u; }
    const size_t kstep = (size_t)(BK * 2);
    const size_t hstep = (size_t)HALF * K * 2;
    const size_t tstep = 2 * hstep;
    const unsigned ldsw = (unsigned)wid * 1024u;
    const int aoff = lds_byte(wr * 64 + fr, fq * 8), boff = lds_byte(wc * 32 + fr, fq * 8);
#define PG8_SA(b, h) (((b) * 2 + (h)) * HTB)
#define PG8_SB(b, h) ((4 + (b) * 2 + (h)) * HTB)
#define PG8_STAGE(bufoff, gbase, voff) do { _Pragma("unroll") for (int _i = 0; _i < 2; ++_i) \
        __builtin_amdgcn_global_load_lds((const unsigned*)((const char*)(gbase) + (voff)[_i]), (PG8_LAS unsigned*)(lds + (bufoff) + ldsw + _i * 8192), 16, 0, 0); } while (0)
#define PG8_LDA(dst, b, h) do { _Pragma("unroll") for (int m = 0; m < 4; ++m) _Pragma("unroll") for (int k = 0; k < 2; ++k) dst[m][k] = *(const PG8_LAS bf16x8*)(lds + PG8_SA(b, h) + aoff + m * 2048 + k * 1024); } while (0)
#define PG8_LDB(dst, b, h) do { _Pragma("unroll") for (int n = 0; n < 2; ++n) _Pragma("unroll") for (int k = 0; k < 2; ++k) dst[n][k] = *(const PG8_LAS bf16x8*)(lds + PG8_SB(b, h) + boff + n * 2048 + k * 1024); } while (0)
#define PG8_MMA(ai, bj, At, Bt) do { __builtin_amdgcn_s_setprio(1); _Pragma("unroll") for (int m = 0; m < 4; ++m) _Pragma("unroll") for (int n = 0; n < 2; ++n) _Pragma("unroll") for (int k = 0; k < 2; ++k) \
        acc[ai][bj][m][n] = __builtin_amdgcn_mfma_f32_16x16x32_bf16(Bt[n][k], At[m][k], acc[ai][bj][m][n], 0, 0, 0); __builtin_amdgcn_s_setprio(0); } while (0)
#define PG8_WAIT_V(n) asm volatile("s_waitcnt vmcnt(" #n ")" ::: "memory")
#define PG8_WAIT_L(n) asm volatile("s_waitcnt lgkmcnt(" #n ")" ::: "memory")
#define PG8_BAR __builtin_amdgcn_s_barrier()
#define PG8_SCHED __builtin_amdgcn_sched_barrier(0)
    Unit cur, nxt; int ui = 0;
    if (!S.next(0, cur)) return;
    f32x4 acc[2][2][4][2];
#pragma unroll
    for (int a = 0; a < 2; ++a)
#pragma unroll
        for (int b = 0; b < 2; ++b)
#pragma unroll
            for (int m = 0; m < 4; ++m)
#pragma unroll
                for (int n = 0; n < 2; ++n) acc[a][b][m][n] = (f32x4){0.f, 0.f, 0.f, 0.f};
    bf16x8 At[4][2], B0[2][2], B1[2][2];
    const char* cA = (const char*)g.A + (size_t)cur.pm * tstep + (size_t)cur.k0 * 2; const char* cB = (const char*)g.Bt + (size_t)cur.pn * tstep + (size_t)cur.k0 * 2;
    S.a_ready(cur);
    if constexpr (SP2) {
        PG8_STAGE(PG8_SB(0, 0), cB, voffB); PG8_STAGE(PG8_SB(0, 1), cB + hstep, voffB); PG8_STAGE(PG8_SA(0, 0), cA, voffA); PG8_STAGE(PG8_SA(0, 1), cA + hstep, voffA);
        if (wr == 1) PG8_BAR;
        PG8_WAIT_V(2); PG8_BAR;
        PG8_STAGE(PG8_SB(1, 0), cB + kstep, voffB); PG8_STAGE(PG8_SA(1, 0), cA + kstep, voffA); PG8_STAGE(PG8_SB(1, 1), cB + hstep + kstep, voffB);
        PG8_WAIT_V(6); PG8_BAR;
    } else {
        PG8_STAGE(PG8_SB(0, 0), cB, voffB); PG8_STAGE(PG8_SA(0, 0), cA, voffA); PG8_STAGE(PG8_SB(0, 1), cB + hstep, voffB); PG8_STAGE(PG8_SA(0, 1), cA + hstep, voffA);
        if (wr == 1) PG8_BAR;
        PG8_WAIT_V(4); PG8_BAR;
        PG8_STAGE(PG8_SB(1, 0), cB + kstep, voffB); PG8_STAGE(PG8_SA(1, 0), cA + kstep, voffA); PG8_STAGE(PG8_SB(1, 1), cB + hstep + kstep, voffB);
        PG8_WAIT_V(6); PG8_BAR;
    }
    for (;;) {
        const bool has_next = S.next(ui + 1, nxt);
        const char* nA = has_next ? (const char*)g.A + (size_t)nxt.pm * tstep + (size_t)nxt.k0 * 2 : cA; const char* nB = has_next ? (const char*)g.Bt + (size_t)nxt.pn * tstep + (size_t)nxt.k0 * 2 : cB;
        const int nt = cur.nt;
        for (int t = 0; t < nt; t += 2) {
            const bool last = (t == nt - 2);
            const char* a1 = cA + (size_t)(t + 1) * kstep;
            const char* a2 = last ? nA : cA + (size_t)(t + 2) * kstep; const char* b2 = last ? nB : cB + (size_t)(t + 2) * kstep;
            const char* a3 = a2 + kstep; const char* b3 = b2 + kstep;
            if (last && has_next) S.a_ready(nxt);
            if constexpr (SP2) {
            PG8_LDB(B0, 0, 0); PG8_LDB(B1, 0, 1); PG8_SCHED; PG8_LDA(At, 0, 0); PG8_STAGE(PG8_SA(1, 1), a1 + hstep, voffA);
            PG8_WAIT_V(8); PG8_WAIT_L(0); PG8_BAR; PG8_MMA(0, 0, At, B0); PG8_MMA(0, 1, At, B1); PG8_BAR; PG8_SCHED;
            PG8_LDA(At, 0, 1); PG8_STAGE(PG8_SB(0, 0), b2, voffB); PG8_STAGE(PG8_SB(0, 1), b2 + hstep, voffB); PG8_STAGE(PG8_SA(0, 0), a2, voffA);
            PG8_WAIT_V(8); PG8_WAIT_L(0); PG8_BAR; PG8_MMA(1, 0, At, B0); PG8_MMA(1, 1, At, B1); PG8_BAR; PG8_SCHED;
            PG8_LDB(B0, 1, 0); PG8_LDB(B1, 1, 1); PG8_SCHED; PG8_LDA(At, 1, 0); PG8_STAGE(PG8_SA(0, 1), a2 + hstep, voffA);
            PG8_WAIT_V(8); PG8_WAIT_L(0); PG8_BAR; PG8_MMA(0, 0, At, B0); PG8_MMA(0, 1, At, B1); PG8_BAR; PG8_SCHED;
            PG8_LDA(At, 1, 1); PG8_STAGE(PG8_SB(1, 0), b3, voffB); PG8_STAGE(PG8_SB(1, 1), b3 + hstep, voffB); PG8_STAGE(PG8_SA(1, 0), a3, voffA);
            PG8_WAIT_V(8); PG8_WAIT_L(0); PG8_BAR; PG8_MMA(1, 0, At, B0); PG8_MMA(1, 1, At, B1); PG8_BAR; PG8_SCHED;
            } else {
            PG8_LDB(B0, 0, 0); PG8_SCHED; PG8_LDA(At, 0, 0); PG8_STAGE(PG8_SA(1, 1), a1 + hstep, voffA);
            PG8_WAIT_L(8); PG8_BAR; PG8_WAIT_L(0); PG8_MMA(0, 0, At, B0); PG8_BAR; PG8_SCHED;
            PG8_LDB(B1, 0, 1); PG8_STAGE(PG8_SB(0, 0), b2, voffB);
            PG8_BAR; PG8_WAIT_L(0); PG8_MMA(0, 1, At, B1); PG8_BAR;
            PG8_LDA(At, 0, 1); PG8_STAGE(PG8_SA(0, 0), a2, voffA);
            PG8_BAR; PG8_WAIT_L(0); PG8_MMA(1, 0, At, B0); PG8_BAR; PG8_SCHED;
            PG8_STAGE(PG8_SB(0, 1), b2 + hstep, voffB);
            PG8_WAIT_V(6); PG8_BAR; PG8_MMA(1, 1, At, B1); PG8_BAR;
            PG8_LDB(B0, 1, 0); PG8_SCHED; PG8_LDA(At, 1, 0); PG8_STAGE(PG8_SA(0, 1), a2 + hstep, voffA);
            PG8_WAIT_L(8); PG8_BAR; PG8_WAIT_L(0); PG8_MMA(0, 0, At, B0); PG8_BAR; PG8_SCHED;
            PG8_LDB(B1, 1, 1); PG8_STAGE(PG8_SB(1, 0), b3, voffB);
            PG8_BAR; PG8_WAIT_L(0); PG8_MMA(0, 1, At, B1); PG8_BAR;
            PG8_LDA(At, 1, 1); PG8_STAGE(PG8_SA(1, 0), a3, voffA);
            PG8_BAR; PG8_WAIT_L(0); PG8_MMA(1, 0, At, B0); PG8_BAR; PG8_SCHED;
            PG8_STAGE(PG8_SB(1, 1), b3 + hstep, voffB);
            PG8_WAIT_V(6); PG8_BAR; PG8_MMA(1, 1, At, B1); PG8_BAR;
            }
        }
        if constexpr (ALIGN_EPI) { if (wr == 0) PG8_BAR; }
        if constexpr (!Epi::AFTER_DRAIN) { E(acc, cur, wr, wc, fr, fq); S.done(cur); }
        if (!has_next) break;
#pragma unroll
        for (int a = 0; a < 2; ++a)
#pragma unroll
            for (int b = 0; b < 2; ++b)
#pragma unroll
                for (int m = 0; m < 4; ++m)
#pragma unroll
                    for (int n = 0; n < 2; ++n) acc[a][b][m][n] = (f32x4){0.f, 0.f, 0.f, 0.f};
        cur = nxt; cA = nA; cB = nB; ++ui;
        if constexpr (ALIGN_EPI) { if (wr == 1) PG8_BAR; }
    }
    PG8_WAIT_V(0);
    if constexpr (!ALIGN_EPI) { if (wr == 0) PG8_BAR; }
    PG8_BAR;
    if constexpr (Epi::AFTER_DRAIN) { E.fused(acc, cur, wr, wc, fr, fq, lds, wid, lane); S.done(cur); }
#undef PG8_SA
#undef PG8_SB
#undef PG8_STAGE
#undef PG8_LDA
#undef PG8_LDB
#undef PG8_MMA
#undef PG8_WAIT_V
#undef PG8_WAIT_L
#undef PG8_BAR
#undef PG8_SCHED
}
}

namespace att {
using bf16 = __hip_bfloat16;
constexpr int   D = 128, NW = 8, QBLK = 32, KVBLK = 64;
constexpr float SCALE = 0.088388347648318440f;
constexpr float THR = 8.f;
constexpr int SDEPTH = 2;
constexpr int LDQ = 1024, LDK = 256, LDO = 2048;
using bf16x8 = __attribute__((ext_vector_type(8))) short;
using s16x4  = __attribute__((ext_vector_type(4))) short;
using f32x16 = __attribute__((ext_vector_type(16))) float;
using f32x8  = __attribute__((ext_vector_type(8))) float;
using u32x4  = __attribute__((ext_vector_type(4))) unsigned;
constexpr size_t SHM_V = KVBLK * D * 2, SHM_K = KVBLK * D * 2, SHM_ATTN = 2 * SHM_V + 2 * SHM_K + NW * 64 * 4;
#define KSWZ(row, colB) ((row) * 256 + ((colB) ^ (((row) & 7) << 4)))
#define SBAR() __builtin_amdgcn_sched_barrier(0)
__device__ __forceinline__ int crow(int r, int hi) { return (r & 3) + 8 * (r >> 2) + 4 * hi; }
__device__ __forceinline__ unsigned cvtpk(float lo, float hi) {
  unsigned r; asm volatile("v_cvt_pk_bf16_f32 %0, %1, %2" : "=v"(r) : "v"(lo), "v"(hi)); return r;
}
template <typename TIn> struct Stage;
template <> struct Stage<bf16>  { using T = bf16x8;
  __device__ static __forceinline__ T ld8(const bf16* p) { return *reinterpret_cast<const bf16x8*>(p); }
  __device__ static __forceinline__ bf16x8 tobf(T x) { return x; } };
template <> struct Stage<float> { using T = f32x8;
  __device__ static __forceinline__ T ld8(const float* p) { return *reinterpret_cast<const f32x8*>(p); }
  __device__ static __forceinline__ bf16x8 tobf(T x) {
    u32x4 w = {cvtpk(x[0], x[1]), cvtpk(x[2], x[3]), cvtpk(x[4], x[5]), cvtpk(x[6], x[7])}; return *reinterpret_cast<bf16x8*>(&w); } };

__device__ __forceinline__ void partialSM(f32x16& p0, f32x16& p1, float& m_reg, float& mn, float& alpha) {
  constexpr float C = SCALE * 1.4426950408889634f;
  float pmax = p0[0]; for (int r = 1; r < 16; ++r) pmax = fmaxf(pmax, p0[r]); for (int r = 0; r < 16; ++r) pmax = fmaxf(pmax, p1[r]);
  { auto rr = __builtin_amdgcn_permlane32_swap(__float_as_uint(pmax), __float_as_uint(pmax), false, false);
    pmax = fmaxf(__uint_as_float(rr[0]), __uint_as_float(rr[1])); }
  if (__builtin_expect(__all(pmax - m_reg <= THR / SCALE), 1)) { mn = m_reg; alpha = 1.f; }
  else { mn = fmaxf(m_reg, pmax); alpha = __builtin_amdgcn_exp2f((m_reg - mn) * C); m_reg = mn; }
  float mnC = -mn * C;
  for (int r = 0; r < 16; ++r) p0[r] = fmaf(p0[r], C, mnC); for (int r = 0; r < 16; ++r) p1[r] = fmaf(p1[r], C, mnC);
  for (int r = 0; r < 16; ++r) p0[r] = __builtin_amdgcn_exp2f(p0[r]);
}
__device__ __forceinline__ void finishSM(f32x16& p0, f32x16& p1, float alpha, float& l_reg, bf16x8& pa0, bf16x8& pa1, bf16x8& pa2, bf16x8& pa3) {
  for (int r = 0; r < 16; ++r) p1[r] = __builtin_amdgcn_exp2f(p1[r]);
  float ps = 0; for (int r = 0; r < 16; ++r) ps += p0[r]; for (int r = 0; r < 16; ++r) ps += p1[r];
  { auto rr = __builtin_amdgcn_permlane32_swap(__float_as_uint(ps), __float_as_uint(ps), false, false);
    ps = __uint_as_float(rr[0]) + __uint_as_float(rr[1]); }
  l_reg = l_reg * alpha + ps;
#define PK4(P, BASE, OUT) do { unsigned a0 = cvtpk(P[BASE + 0], P[BASE + 1]), a1 = cvtpk(P[BASE + 2], P[BASE + 3]);   \
    unsigned b0 = cvtpk(P[BASE + 4], P[BASE + 5]), b1 = cvtpk(P[BASE + 6], P[BASE + 7]);                              \
    auto r0 = __builtin_amdgcn_permlane32_swap(a0, b0, false, false); auto r1 = __builtin_amdgcn_permlane32_swap(a1, b1, false, false); \
    u32x4 w = {r0[0], r1[0], r0[1], r1[1]}; OUT = *reinterpret_cast<bf16x8*>(&w); } while (0)
  PK4(p0, 0, pa0); PK4(p0, 8, pa1); PK4(p1, 0, pa2); PK4(p1, 8, pa3);
#undef PK4
}
__device__ __forceinline__ void qkt(f32x16& p0, f32x16& p1, const bf16* Ks, const bf16x8* qr, int r32, int hi) {
  p0 = f32x16{}; p1 = f32x16{};
  for (int d0 = 0; d0 < 8; ++d0) { int cb = (d0 * 16 + hi * 8) * 2;
    bf16x8 b0 = *reinterpret_cast<const bf16x8*>((const char*)Ks + KSWZ(r32, cb));
    bf16x8 b1 = *reinterpret_cast<const bf16x8*>((const char*)Ks + KSWZ(32 + r32, cb));
    p0 = __builtin_amdgcn_mfma_f32_32x32x16_bf16(b0, qr[d0], p0, 0, 0, 0);
    p1 = __builtin_amdgcn_mfma_f32_32x32x16_bf16(b1, qr[d0], p1, 0, 0, 0); }
}
__device__ __forceinline__ int v_st(int k, int c) { const int kk = (k & ~0xC) | ((k & 4) << 1) | ((k & 8) >> 1); return ((kk >> 3) * 4 + (c >> 5)) * 512 + ((kk & 7) * 32 + (c & 31)) * 2; }
__device__ __forceinline__ int v_rd_base(int lane) { return ((lane & 3) << 3) | (((lane >> 2) & 3) << 6) | (((lane >> 4) & 1) << 5) | (((lane >> 5) & 1) << 8); }
constexpr int v_rd_off(int d0, int ks, int half) { return d0 * 512 + ks * 4096 + half * 2048; }
template <int OFF> __device__ __forceinline__ s16x4 tr_read(int vb) {
  s16x4 r; asm volatile("ds_read_b64_tr_b16 %0, %1 offset:%2" : "=&v"(r) : "v"(vb), "i"(OFF) : "memory"); return r;
}
template <int D0> __device__ __forceinline__ void pv_one(f32x16& od, int vb, bf16x8 pa0, bf16x8 pa1, bf16x8 pa2, bf16x8 pa3) {
  const s16x4 l0 = tr_read<v_rd_off(D0, 0, 0)>(vb), h0 = tr_read<v_rd_off(D0, 0, 1)>(vb), l1 = tr_read<v_rd_off(D0, 1, 0)>(vb), h1 = tr_read<v_rd_off(D0, 1, 1)>(vb);
  const s16x4 l2 = tr_read<v_rd_off(D0, 2, 0)>(vb), h2 = tr_read<v_rd_off(D0, 2, 1)>(vb), l3 = tr_read<v_rd_off(D0, 3, 0)>(vb), h3 = tr_read<v_rd_off(D0, 3, 1)>(vb);
  asm volatile("s_waitcnt lgkmcnt(0)" ::: "memory"); SBAR();
#define PK(L, H) (bf16x8){L[0], L[1], L[2], L[3], H[0], H[1], H[2], H[3]}
  od = __builtin_amdgcn_mfma_f32_32x32x16_bf16(pa0, PK(l0, h0), od, 0, 0, 0);
  od = __builtin_amdgcn_mfma_f32_32x32x16_bf16(pa1, PK(l1, h1), od, 0, 0, 0);
  od = __builtin_amdgcn_mfma_f32_32x32x16_bf16(pa2, PK(l2, h2), od, 0, 0, 0);
  od = __builtin_amdgcn_mfma_f32_32x32x16_bf16(pa3, PK(l3, h3), od, 0, 0, 0);
#undef PK
}
__device__ __forceinline__ void pv_d0(f32x16* o, int vb, bf16x8 pa0, bf16x8 pa1, bf16x8 pa2, bf16x8 pa3) {
  pv_one<0>(o[0], vb, pa0, pa1, pa2, pa3); pv_one<1>(o[1], vb, pa0, pa1, pa2, pa3); pv_one<2>(o[2], vb, pa0, pa1, pa2, pa3); pv_one<3>(o[3], vb, pa0, pa1, pa2, pa3);
}

template <typename TQ>
__device__ __forceinline__ void attn_dense_body(const TQ* __restrict__ Qb, const bf16* __restrict__ Kh, const bf16* __restrict__ Vh,
                                                bf16* __restrict__ Ob, int seq, char* lds) {
  using St = Stage<bf16>; using SQ = Stage<TQ>;
  int tid_ = threadIdx.x; asm volatile("" : "+v"(tid_)); const int tid = tid_, wid = tid >> 6, lane = tid & 63, r32 = lane & 31, hi = lane >> 5;
  bf16* V_lds = (bf16*)lds; bf16* K_lds = (bf16*)(lds + 2 * SHM_V);
  float* ws = (float*)(lds + 2 * SHM_V + 2 * SHM_K) + wid * 64; float* li_l = ws; float* al_l = ws + 32;
  float m_reg = -1e30f, l_reg = 0; f32x16 o[4] = {}; bf16x8 qr[8];
  const TQ* Qw = Qb + (long)(wid * QBLK + r32) * LDQ + hi * 8;
#pragma unroll
  for (int d0 = 0; d0 < 8; ++d0) qr[d0] = SQ::tobf(SQ::ld8(Qw + d0 * 16));
  const int sr = tid >> 4, sc = (tid & 15) * 8, vst0 = v_st(sr, sc), vst1 = v_st(32 + sr, sc);
  const int vb0 = (int)(uintptr_t)V_lds + v_rd_base(lane);
  struct { typename St::T vs0, vs1, ks0, ks1; } sr_[SDEPTH];
#define SLOAD(i, k0) do { sr_[i].vs0 = St::ld8(&Vh[(long)((k0) + sr) * LDK + sc]); sr_[i].vs1 = St::ld8(&Vh[(long)((k0) + 32 + sr) * LDK + sc]); \
    sr_[i].ks0 = St::ld8(&Kh[(long)((k0) + sr) * LDK + sc]); sr_[i].ks1 = St::ld8(&Kh[(long)((k0) + 32 + sr) * LDK + sc]); } while (0)
#define SWRITE(b, i) do { *(bf16x8*)((char*)V_lds + (b) * SHM_V + vst0) = St::tobf(sr_[i].vs0);          \
    *(bf16x8*)((char*)V_lds + (b) * SHM_V + vst1) = St::tobf(sr_[i].vs1); int kc = sc * 2;               \
    *(bf16x8*)((char*)K_lds + (b) * SHM_K + KSWZ(sr, kc)) = St::tobf(sr_[i].ks0);                       \
    *(bf16x8*)((char*)K_lds + (b) * SHM_K + KSWZ(32 + sr, kc)) = St::tobf(sr_[i].ks1); } while (0)
#define SWAIT() do { if constexpr (SDEPTH == 2) asm volatile("s_waitcnt vmcnt(4)" ::: "memory"); else asm volatile("s_waitcnt vmcnt(0)" ::: "memory"); } while (0)
#define RESC(a) do { if (__any((a) < 1.f)) { if (hi == 0) al_l[r32] = (a); asm volatile("s_waitcnt lgkmcnt(0)" ::: "memory"); \
    for (int d = 0; d < 4; ++d) for (int r = 0; r < 16; ++r) o[d][r] *= al_l[crow(r, hi)]; } } while (0)
  f32x16 pA0, pA1, pB0, pB1; float mnA, mnB, alA, alB; bf16x8 pa0, pa1, pa2, pa3; const int NT = seq / KVBLK;
  constexpr int SE = 0, SO = SDEPTH - 1;
  SLOAD(SE, 0); asm volatile("s_waitcnt vmcnt(0)" ::: "memory"); SWRITE(0, SE); __syncthreads();
  qkt(pA0, pA1, K_lds, qr, r32, hi); partialSM(pA0, pA1, m_reg, mnA, alA);
  SLOAD(SO, KVBLK); if constexpr (SDEPTH == 2) { if (2 < NT) SLOAD(SE, 2 * KVBLK); }
  SWAIT(); SWRITE(1, SO); __syncthreads();
  for (int j = 1; j + 1 < NT; j += 2) {
    SBAR(); qkt(pB0, pB1, (bf16*)((char*)K_lds + SHM_K), qr, r32, hi);
    finishSM(pA0, pA1, alA, l_reg, pa0, pa1, pa2, pa3); SBAR();
    SLOAD(SO, (j + SDEPTH) * KVBLK); SBAR();
    pv_d0(o, vb0, pa0, pa1, pa2, pa3); partialSM(pB0, pB1, m_reg, mnB, alB);
    __syncthreads(); SWAIT(); SWRITE(0, SE);
    RESC(alB); __syncthreads();
    SBAR(); qkt(pA0, pA1, K_lds, qr, r32, hi);
    finishSM(pB0, pB1, alB, l_reg, pa0, pa1, pa2, pa3); SBAR();
    if (SDEPTH == 1 || j + 3 < NT) SLOAD(SE, (j + 1 + SDEPTH) * KVBLK); SBAR();
    pv_d0(o, vb0 + (int)SHM_V, pa0, pa1, pa2, pa3); partialSM(pA0, pA1, m_reg, mnA, alA);
    __syncthreads(); SWAIT(); SWRITE(1, SO);
    RESC(alA); __syncthreads();
  }
  SBAR(); qkt(pB0, pB1, (bf16*)((char*)K_lds + SHM_K), qr, r32, hi);
  finishSM(pA0, pA1, alA, l_reg, pa0, pa1, pa2, pa3); SBAR();
  pv_d0(o, vb0, pa0, pa1, pa2, pa3); partialSM(pB0, pB1, m_reg, mnB, alB);
  __syncthreads(); RESC(alB);
  finishSM(pB0, pB1, alB, l_reg, pa0, pa1, pa2, pa3); SBAR();
  pv_d0(o, vb0 + (int)SHM_V, pa0, pa1, pa2, pa3);
  if (hi == 0) li_l[r32] = l_reg; asm volatile("s_waitcnt lgkmcnt(0)" ::: "memory");
  float rli[16];
#pragma unroll
  for (int r = 0; r < 16; ++r) rli[r] = __builtin_amdgcn_rcpf(li_l[crow(r, hi)]);
  bf16* Ow = Ob + (long)(wid * QBLK) * LDO;
#pragma unroll
  for (int r = 0; r < 16; ++r) { int orow = crow(r, hi);
    for (int d0 = 0; d0 < 4; ++d0) Ow[(long)orow * LDO + d0 * 32 + r32] = __float2bfloat16(o[d0][r] * rli[r]); }
#undef SLOAD
#undef SWRITE
#undef SWAIT
#undef RESC
}

}

#ifndef MK_PER_PHASE
#define MK_PER_PHASE 0
#endif
#ifndef MK_GDN_REC
#define MK_GDN_REC 0
#endif
#ifndef MK_DIAG
#define MK_DIAG 0
#endif
#ifndef MK_DIAG_A
#define MK_DIAG_A 0
#endif
#ifndef MK_DIAG_B
#define MK_DIAG_B 1
#endif
constexpr int NWAVES = 8;

constexpr int DM = 2048, NB_CTX = 32, SEQ = 256, DEPTH = 2, NB_LAT = 2, LSEQ = 1024, PAST = 512;
constexpr int M_CTX = NB_CTX * SEQ, M_LAT = NB_LAT * LSEQ, M = M_CTX + M_LAT;
constexpr int HG = 8, DKV = 128, GDN_W = 1024, NQ = 8, NKV = 2, HD = 128, ATT_W = 1024;
constexpr int QKV_W = 3072, IN_W = 5664, IN_WP = 5888, DFF = 5632, CONVK = 5;
constexpr int C_Z = 3072, C_B = 4096, C_A = 4112, C_AQ = 4128, C_AK = 5152, C_AV = 5408;
constexpr int KROWS = M_CTX + NB_LAT * (LSEQ + PAST);
constexpr float RMS_EPS = 1e-6f, LN_EPS = 1e-5f;
constexpr float DN_ALPHA = 1.4142135623730951f;
constexpr size_t OUT_YP = 0, OUT_YS = 16777216, OUT_CK = 20971520, OUT_CV = 25165824, OUT_ST = 29360128, OUT_TOTAL = 46137344;
enum { I_XP = 0, I_XS, I_CK, I_CV, I_ST, I_C, I_CCTX, I_WADA, I_BADA, I_WIN, I_CONVW, I_ALOG, I_DTB, I_GNW, I_QNW, I_KNW, I_WO, I_LN1G, I_LN1B, I_LN2G, I_LN2B, I_WGU, I_WD, N_IN };

constexpr size_t MiB = 1u << 20;
constexpr size_t WS_CTL = 0, CTL_ZERO_BYTES = 1 * MiB;
constexpr size_t WS_MOD = 1 * MiB;
constexpr size_t WS_WIN = 2 * MiB;
constexpr size_t WS_WO  = WS_WIN + (size_t)DEPTH * IN_WP * DM * 2;
constexpr size_t WS_WGU = WS_WO + (size_t)DEPTH * DM * DM * 2;
constexpr size_t WS_WD  = WS_WGU + (size_t)DEPTH * 2 * DFF * DM * 2;
constexpr size_t WS_H   = WS_WD + (size_t)DEPTH * DM * DFF * 2;
constexpr size_t WS_MIX = WS_H + (size_t)M * DM * 2;
constexpr size_t WS_PROJ = WS_MIX + (size_t)M * DM * 2;
constexpr size_t WS_QG  = WS_PROJ + (size_t)M * IN_WP * 2;
constexpr size_t WS_KG  = WS_QG + (size_t)M * GDN_W * 2;
constexpr size_t WS_VG  = WS_KG + (size_t)M * GDN_W * 2;
constexpr size_t WS_GG  = WS_VG + (size_t)M * GDN_W * 2;
constexpr size_t WS_BB  = WS_GG + (size_t)M * 16 * 4;
constexpr size_t WS_OF  = WS_BB + (size_t)M * 16 * 4;
constexpr size_t WS_OB  = WS_OF + (size_t)M * GDN_W * 4;
constexpr size_t WS_QA  = WS_OB + (size_t)M * GDN_W * 4;
constexpr size_t WS_KA  = WS_QA + (size_t)M * ATT_W * 2;
constexpr size_t WS_VA  = WS_KA + (size_t)KROWS * 256 * 2;
constexpr size_t WS_ROPE = WS_VA + (size_t)KROWS * 256 * 2;
constexpr size_t WS_PART = WS_ROPE + (size_t)LSEQ * 64 * 16;
constexpr size_t WS_END = WS_PART + (size_t)4 * M_LAT * DM * 4;
static_assert(WS_WIN % 256 == 0 && WS_WO % 256 == 0 && WS_WGU % 256 == 0 && WS_WD % 256 == 0 && WS_H % 256 == 0 && WS_MIX % 256 == 0 && WS_PROJ % 256 == 0 && WS_QG % 256 == 0 && WS_GG % 256 == 0 && WS_OF % 256 == 0 && WS_QA % 256 == 0 && WS_KA % 256 == 0 && WS_VA % 256 == 0, "ws alignment");
static_assert(WS_MOD + (size_t)DEPTH * 3 * 12288 * 4 <= WS_WIN, "mod table");
constexpr int CW_TMO = 0, CW_CODE = 1, CW_BAR = 4096;

constexpr int RING_OFF = 0, RING_BYTES = 131072;
constexpr int LDS_BYTES = 163840;
constexpr int LDSCTL_OFF = LDS_BYTES - 512, MISC_OFF = LDSCTL_OFF + 320;

#define GAS __attribute__((address_space(1)))
#define LAS __attribute__((address_space(3)))
typedef unsigned short bf16;
typedef unsigned v4u __attribute__((ext_vector_type(4)));
typedef unsigned v2u __attribute__((ext_vector_type(2)));
typedef float f32x4 __attribute__((ext_vector_type(4)));
typedef float f32x2 __attribute__((ext_vector_type(2)));
typedef GAS unsigned gu32;
#define RLX_AGENT __ATOMIC_RELAXED, __HIP_MEMORY_SCOPE_AGENT
#define LDS_WAIT() asm volatile("s_waitcnt lgkmcnt(0)" ::: "memory")
#define VM_WAIT() asm volatile("s_waitcnt vmcnt(0)" ::: "memory")
__device__ __forceinline__ unsigned f2bf(float f) { unsigned u = __builtin_bit_cast(unsigned, f); return (u + 0x7fffu + ((u >> 16) & 1u)) >> 16; }
__device__ __forceinline__ unsigned pk2(float lo, float hi) { return f2bf(lo) | (f2bf(hi) << 16); }
__device__ __forceinline__ float bf_lo(unsigned w) { return __builtin_bit_cast(float, w << 16); }
__device__ __forceinline__ float bf_hi(unsigned w) { return __builtin_bit_cast(float, w & 0xffff0000u); }
__device__ __forceinline__ float bf1(bf16 h) { return __builtin_bit_cast(float, (unsigned)h << 16); }
template <int CTRL> __device__ __forceinline__ float dppf(float v) { return __builtin_bit_cast(float, __builtin_amdgcn_update_dpp(0, __builtin_bit_cast(int, v), CTRL, 0xF, 0xF, true)); }
__device__ __forceinline__ float wave_sum(float v) {
    v += dppf<0xB1>(v);
    v += dppf<0x4E>(v);
    v += dppf<0x141>(v);
    v += dppf<0x140>(v);
    return ((__builtin_bit_cast(float, __builtin_amdgcn_readlane(__builtin_bit_cast(int, v), 15)) + __builtin_bit_cast(float, __builtin_amdgcn_readlane(__builtin_bit_cast(int, v), 31))) +
            (__builtin_bit_cast(float, __builtin_amdgcn_readlane(__builtin_bit_cast(int, v), 47)) + __builtin_bit_cast(float, __builtin_amdgcn_readlane(__builtin_bit_cast(int, v), 63))));
}
__device__ __forceinline__ float frcp(float x) { return __builtin_amdgcn_rcpf(x); }
__device__ __forceinline__ float frsq(float x) { return __builtin_amdgcn_rsqf(x); }
__device__ __forceinline__ float fexp(float x) { return __builtin_amdgcn_exp2f(1.4426950408889634f * x); }
__device__ __forceinline__ float silu(float x) { return x * frcp(1.0f + fexp(-x)); }
#define XB_TMO      128
#define XB_XCNT(j)  (256  + 64 * (j))
#define XB_XSUB(j)  (1280 + 64 * (j))
#define XB_XGEN(j)  (2304 + 64 * (j))
#define XB_TOP      3328
#define XB_TOPGEN   3392
#define XCD_BAR_WORDS 3456
#define XB_SPIN_CAP (1u << 18)

__device__ __forceinline__ unsigned xb_ld(unsigned* p)              { return __hip_atomic_load(p, __ATOMIC_RELAXED, __HIP_MEMORY_SCOPE_AGENT); }
__device__ __forceinline__ unsigned xb_add(unsigned* p, unsigned v) { return __hip_atomic_fetch_add(p, v, __ATOMIC_RELAXED, __HIP_MEMORY_SCOPE_AGENT); }
__device__ __forceinline__ unsigned xb_xcc_id() { return (unsigned)__builtin_amdgcn_s_getreg((3 << 11) | 20) & 0xFu; }
#define XB_SPIN(cond, bar) do { unsigned _sp = 0; while (cond) { __builtin_amdgcn_s_sleep(1); \
    if ((++_sp & 255u) == 0u) { if (xb_ld(&(bar)[XB_TMO])) break; if (_sp > XB_SPIN_CAP) { atomicAdd(&(bar)[XB_TMO], 1u); break; } } } } while (0)

struct XcdBarrier {
    unsigned* bar; unsigned x;
    volatile LAS unsigned* st;
};

__device__ __forceinline__ XcdBarrier xcd_barrier_post(unsigned* bar, volatile LAS unsigned* st) {
    XcdBarrier b; b.bar = bar; b.x = xb_xcc_id(); b.st = st;
    if (threadIdx.x == 0) (void)xb_add(&bar[XB_XCNT(b.x)], 1u);
    return b;
}
__device__ __forceinline__ void xcd_barrier_complete(unsigned* bar, unsigned x, unsigned& nloc, unsigned& nx) {
    const unsigned G = gridDim.x * gridDim.y * gridDim.z;
    unsigned sum, cnt, mine, sp = 0u;
    for (;;) {
        sum = 0u; cnt = 0u; mine = 0u;
#pragma unroll
        for (unsigned j = 0; j < 16; ++j) { const unsigned c = xb_ld(&bar[XB_XCNT(j)]); sum += c; cnt += (c > 0u) ? 1u : 0u; mine = (j == x) ? c : mine; }
        if (sum == G) break;
        __builtin_amdgcn_s_sleep(1);
        if ((++sp & 255u) == 0u) { if (xb_ld(&bar[XB_TMO])) break; if (sp > XB_SPIN_CAP) { atomicAdd(&bar[XB_TMO], 1u); break; } }
    }
    nloc = mine > 0u ? mine : 1u; nx = cnt > 0u ? cnt : 1u;
}

__device__ __forceinline__ void xcd_barrier(const XcdBarrier& b) {
    asm volatile("s_waitcnt vmcnt(0)" ::: "memory");
    __syncthreads();
    if (threadIdx.x == 0) {
        unsigned* bar = b.bar;
        __builtin_amdgcn_s_waitcnt(0);
        unsigned nloc = b.st[0], nx = b.st[1];
        if (nloc == 0u) { xcd_barrier_complete(bar, b.x, nloc, nx); b.st[0] = nloc; b.st[1] = nx; }
        const unsigned old = xb_add(&bar[XB_XSUB(b.x)], 1u);
        const unsigned gen = old / nloc;
        if (old + 1u == (gen + 1u) * nloc) {
            __builtin_amdgcn_fence(__ATOMIC_RELEASE, "agent");
            asm volatile("s_waitcnt vmcnt(0)" ::: "memory");
            const unsigned og = xb_add(&bar[XB_TOP], 1u);
            const unsigned tg = og / nx;
            if (og + 1u == (tg + 1u) * nx) xb_add(&bar[XB_TOPGEN], 1u);
            else XB_SPIN(xb_ld(&bar[XB_TOPGEN]) == tg, bar);
            __builtin_amdgcn_fence(__ATOMIC_ACQUIRE, "agent");
            xb_add(&bar[XB_XGEN(b.x)], 1u);
            asm volatile("s_waitcnt vmcnt(0)" ::: "memory");
        } else {
            XB_SPIN(xb_ld(&bar[XB_XGEN(b.x)]) == gen, bar);
            __builtin_amdgcn_fence(__ATOMIC_ACQUIRE, "agent");
            asm volatile("s_waitcnt vmcnt(0)" ::: "memory");
        }
    }
    __syncthreads();
}

struct Args { const float* in[N_IN]; float* out; unsigned char* ws; int ph_lo, ph_hi; };
static_assert(sizeof(Args) == 8 * (N_IN + 2) + 8, "Args has no padding");
#define CAS __attribute__((address_space(4)))
#define ARGS_T const CAS Args
__device__ __forceinline__ ARGS_T* fresh_args() { const CAS char* p = (const CAS char*)__builtin_amdgcn_kernarg_segment_ptr(); asm volatile("" : "+s"(p)); return (ARGS_T*)p; }
__device__ __forceinline__ int fresh_tid() { int t = threadIdx.x; asm volatile("" : "+v"(t)); return t; }
__device__ __forceinline__ int fresh_bx() { int b = blockIdx.x; asm volatile("" : "+s"(b)); return b; }

struct Frame {
    LAS unsigned char* lds;
    volatile LAS unsigned* MISC;
    gu32* ctl;
    int tid, lane, wave;
    int vcu, G, bx;
    float* out;
    unsigned char* ws;
};
#define WSP(T, off) ((T*)(F.ws + (off)))

__device__ __forceinline__ void p0_transpose_item(const float* W, int K, int N, bf16* WT, int k0, int n0, int drow0, LAS float* scr, int lane) {
#pragma unroll 8
    for (int i = 0; i < 32; ++i) { const int kk = 2 * i + (lane >> 5); scr[kk * 33 + (lane & 31)] = W[(size_t)(k0 + kk) * N + n0 + (lane & 31)]; }
    LDS_WAIT(); asm volatile("" ::: "memory");
    const int c = lane & 7;
#pragma unroll
    for (int j = 0; j < 4; ++j) { const int n = (lane >> 3) + 8 * j; const LAS float* s = scr + (8 * c) * 33 + n;
        v4u o; o.x = pk2(s[0 * 33], s[1 * 33]); o.y = pk2(s[2 * 33], s[3 * 33]); o.z = pk2(s[4 * 33], s[5 * 33]); o.w = pk2(s[6 * 33], s[7 * 33]);
        *(GAS v4u*)(WT + (size_t)(drow0 + n) * K + k0 + 8 * c) = o; }
    LDS_WAIT(); asm volatile("" ::: "memory");
}
__device__ __forceinline__ void p0a_phase(ARGS_T& A, Frame& F) {
    LAS float* sl = (LAS float*)(F.lds);
    LAS float* red = (LAS float*)(F.lds + 32768);
    for (int i = F.tid; i < 3 * DM; i += NWAVES * 64) { const int ci = i / DM, k = i % DM; const float c = ci == 0 ? A.in[I_CCTX][k] : A.in[I_C][(ci - 1) * DM + k]; sl[i] = silu(c); }
    __syncthreads();
    for (int grp = F.bx; grp < 256; grp += F.G) {
        const int l = grp >> 7, n0 = (grp & 127) * 96;
        const int cg = F.tid % 24, kg = F.tid / 24;
        float a[3][4];
#pragma unroll
        for (int ci = 0; ci < 3; ++ci)
#pragma unroll
            for (int j = 0; j < 4; ++j) a[ci][j] = 0.f;
        if (kg < 21) {
            const float* wp = A.in[I_WADA] + (size_t)l * DM * 12288 + n0 + 4 * cg;
#pragma unroll 4
            for (int k = kg; k < DM; k += 21) { const f32x4 w = *(const f32x4*)(wp + (size_t)k * 12288); const float s0 = sl[k], s1 = sl[DM + k], s2 = sl[2 * DM + k];
#pragma unroll
                for (int j = 0; j < 4; ++j) { a[0][j] += s0 * w[j]; a[1][j] += s1 * w[j]; a[2][j] += s2 * w[j]; } }
#pragma unroll
            for (int ci = 0; ci < 3; ++ci)
#pragma unroll
                for (int j = 0; j < 4; ++j) red[(kg * 24 + cg) * 12 + ci * 4 + j] = a[ci][j];
        }
        __syncthreads();
        if (F.tid < 288) { const int c2 = F.tid / 12, j = F.tid % 12, ci = j >> 2, cc = j & 3; float s = 0.f;
            for (int q = 0; q < 21; ++q) s += red[(q * 24 + c2) * 12 + j];
            const int n = n0 + 4 * c2 + cc;
            WSP(float, WS_MOD)[((size_t)l * 3 + ci) * 12288 + n] = s + A.in[I_BADA][(size_t)l * 12288 + n]; }
        __syncthreads();
    }
    LAS float* scr = (LAS float*)(F.lds + RING_OFF + F.wave * 16384);
    const int gw = F.vcu * NWAVES + F.wave, NGW = F.G * NWAVES;
    constexpr int I_IN = (DM / 64) * (IN_W / 32), I_O = (DM / 64) * (DM / 32), I_GU = (DM / 64) * (2 * DFF / 32), I_D = (DFF / 64) * (DM / 32), I_LAYER = I_IN + I_O + I_GU + I_D;
    for (int it = gw; it < DEPTH * I_LAYER; it += NGW) {
        const int l = it / I_LAYER; int r = it % I_LAYER;
        if (r < I_IN) { const int nblk = IN_W / 32, kb = r / nblk, nb = r % nblk;
            p0_transpose_item(A.in[I_WIN] + (size_t)l * DM * IN_W, DM, IN_W, WSP(bf16, WS_WIN) + (size_t)l * IN_WP * DM, 64 * kb, 32 * nb, 32 * nb, scr, F.lane); continue; } r -= I_IN;
        if (r < I_O) { const int nblk = DM / 32, kb = r / nblk, nb = r % nblk;
            p0_transpose_item(A.in[I_WO] + (size_t)l * DM * DM, DM, DM, WSP(bf16, WS_WO) + (size_t)l * DM * DM, 64 * kb, 32 * nb, 32 * nb, scr, F.lane); continue; } r -= I_O;
        if (r < I_GU) { const int nblk = 2 * DFF / 32, kb = r / nblk, nb = r % nblk, n0 = 32 * nb, s = n0 / DFF, j = n0 % DFF, p = j / 128, rr = j % 128;
            p0_transpose_item(A.in[I_WGU] + (size_t)l * DM * 2 * DFF, DM, 2 * DFF, WSP(bf16, WS_WGU) + (size_t)l * 2 * DFF * DM, 64 * kb, n0, 256 * p + 128 * s + rr, scr, F.lane); continue; } r -= I_GU;
        { const int nblk = DM / 32, kb = r / nblk, nb = r % nblk;
            p0_transpose_item(A.in[I_WD] + (size_t)l * DFF * DM, DFF, DM, WSP(bf16, WS_WD) + (size_t)l * DM * DFF, 64 * kb, 32 * nb, 32 * nb, scr, F.lane); }
    }
    { const int gt = F.vcu * NWAVES * 64 + F.tid, NGT = F.G * NWAVES * 64; constexpr int PADV = (IN_WP - IN_W) * DM * 2 / 16;
        for (int i = gt; i < DEPTH * PADV; i += NGT) { const int l = i / PADV, r = i % PADV; ((GAS v4u*)(WSP(bf16, WS_WIN) + (size_t)l * IN_WP * DM + (size_t)IN_W * DM))[r] = (v4u){0u, 0u, 0u, 0u}; } }
}

__device__ __forceinline__ int cond_of_row(int row) { return row < M_CTX ? 0 : 1 + ((row - M_CTX) >> 10); }
__device__ __forceinline__ void p0b_phase(ARGS_T& A, Frame& F) {
    const int gw = F.vcu * NWAVES + F.wave, NGW = F.G * NWAVES;
    for (int t = gw; t < LSEQ; t += NGW) { const int lane = F.lane; const float pos = (float)(lane < 32 ? (t >> 6) : (t & 63)); const int i0 = 2 * (lane & 15);
        const float f0 = powf(10000.f, -(float)(2 * i0) / 64.f), f1 = powf(10000.f, -(float)(2 * i0 + 2) / 64.f); float s0, c0, s1, c1;
        sincosf(pos * f0, &s0, &c0); sincosf(pos * f1, &s1, &c1);
        *(f32x4*)(WSP(float, WS_ROPE) + ((size_t)t * 64 + lane) * 4) = (f32x4){c0, s0, c1, s1}; }
    for (int row = gw; row < M; row += NGW) {
        const float* xr = row < M_CTX ? A.in[I_XP] + (size_t)row * DM : A.in[I_XS] + (size_t)(row - M_CTX) * DM;
        const float* mod = WSP(float, WS_MOD) + (size_t)cond_of_row(row) * 12288;
        GAS v2u* o8 = (GAS v2u*)(WSP(bf16, WS_H) + (size_t)row * DM) + F.lane;
#pragma unroll
        for (int j = 0; j < 8; ++j) { const int c = 4 * F.lane + 256 * j; const f32x4 x = *(const f32x4*)(xr + c), sh = *(const f32x4*)(mod + c), sc = *(const f32x4*)(mod + DM + c);
            const f32x4 h = x * (sc + 1.0f) + sh; o8[64 * j] = (v2u){pk2(h[0], h[1]), pk2(h[2], h[3])}; }
    }
}
struct LnArgs { const float* lg; const float* lb; const float* modsh; const float* modsc; bool write_h; const float* part; const float* xin_lat; const float* gate; float alpha; };
__device__ __forceinline__ void ln_row(Frame& F, const LnArgs& a, int row) {
    float* xr = F.out + (size_t)row * DM; const bool lat = row >= M_CTX;
    f32x4 v[8]; float s = 0.f;
#pragma unroll
    for (int j = 0; j < 8; ++j) v[j] = *(const f32x4*)((lat ? a.xin_lat + (size_t)(row - M_CTX) * DM : xr) + 4 * F.lane + 256 * j);
    if (lat) { const float* pr = a.part + (size_t)(row - M_CTX) * DM + 4 * F.lane; const float* gr = a.gate + (size_t)cond_of_row(row) * 12288 + 4 * F.lane;
#pragma unroll
        for (int j = 0; j < 8; ++j) { const f32x4 p0 = *(const f32x4*)(pr + 256 * j), p1 = *(const f32x4*)(pr + (size_t)M_LAT * DM + 256 * j), p2 = *(const f32x4*)(pr + (size_t)2 * M_LAT * DM + 256 * j), p3 = *(const f32x4*)(pr + (size_t)3 * M_LAT * DM + 256 * j);
            v[j] = v[j] * a.alpha + *(const f32x4*)(gr + 256 * j) * ((p0 + p1) + (p2 + p3)); } }
#pragma unroll
    for (int j = 0; j < 8; ++j) s += (v[j][0] + v[j][1]) + (v[j][2] + v[j][3]);
    const float mean = wave_sum(s) * (1.f / DM); float s2 = 0.f;
#pragma unroll
    for (int j = 0; j < 8; ++j) { v[j] = v[j] - mean; s2 += (v[j][0] * v[j][0] + v[j][1] * v[j][1]) + (v[j][2] * v[j][2] + v[j][3] * v[j][3]); }
    const float rstd = frsq(wave_sum(s2) * (1.f / DM) + LN_EPS);
    const int ci = cond_of_row(row);
    GAS v2u* o8 = (GAS v2u*)(WSP(bf16, WS_H) + (size_t)row * DM) + F.lane;
#pragma unroll
    for (int j = 0; j < 8; ++j) { const int c = 4 * F.lane + 256 * j; const f32x4 g = *(const f32x4*)(a.lg + c), b = *(const f32x4*)(a.lb + c);
        const f32x4 y = v[j] * rstd * g + b; *(f32x4*)(xr + c) = y;
        if (a.write_h) { const f32x4 sh = *(const f32x4*)(a.modsh + (size_t)ci * 12288 + c), sc = *(const f32x4*)(a.modsc + (size_t)ci * 12288 + c);
            const f32x4 h = y * (sc + 1.0f) + sh; o8[64 * j] = (v2u){pg8::cvt_pk_bf16(h[0], h[1]), pg8::cvt_pk_bf16(h[2], h[3])}; } }
}
constexpr int CW_PANEL = 32768;
__device__ __forceinline__ void panel_wait(Frame& F, gu32* cnt, unsigned want) {
    if (F.wave == 0) { unsigned spins = 0;
        while ((unsigned)__builtin_amdgcn_readfirstlane(__hip_atomic_load(cnt, RLX_AGENT)) < want) { __builtin_amdgcn_s_sleep(2); if (++spins > (1u << 22)) break; }
        __builtin_amdgcn_fence(__ATOMIC_ACQUIRE, "agent"); asm volatile("s_waitcnt vmcnt(0)" ::: "memory"); }
    __syncthreads();
}
__device__ __forceinline__ void ln_fused_tail(Frame& F, const LnArgs& a, int slot) {
    const int xcd = F.bx & 7, idx = F.bx >> 3; const int pmf = 4 * xcd + (idx & 3), pnf = idx >> 2, pms = 32 + xcd, qs = 4 * (idx & 7) + (idx >> 3);
    gu32* cf = F.ctl + CW_PANEL + (40 * slot + pmf) * 64; gu32* cs = F.ctl + CW_PANEL + (40 * slot + pms) * 64;
    asm volatile("s_waitcnt vmcnt(0)" ::: "memory"); __syncthreads();
    if (F.tid == 0) { __builtin_amdgcn_fence(__ATOMIC_RELEASE, "agent"); asm volatile("s_waitcnt vmcnt(0)" ::: "memory");
        __hip_atomic_fetch_add(cf, 1u, RLX_AGENT); __hip_atomic_fetch_add(cs, 1u, RLX_AGENT); }
    panel_wait(F, cf, 8u);
#pragma unroll 1
    for (int r = 0; r < 4; ++r) ln_row(F, a, 256 * pmf + 32 * pnf + 4 * F.wave + r);
    panel_wait(F, cs, 32u);
    ln_row(F, a, 256 * pms + 8 * qs + F.wave);
}
__device__ __forceinline__ void ln_phase(Frame& F, const LnArgs& a) {
    const int gw = F.vcu * NWAVES + F.wave, NGW = F.G * NWAVES;
    for (int row = gw; row < M; row += NGW) ln_row(F, a, row);
}

__device__ __forceinline__ void prep_phase(ARGS_T& A, Frame& F, int l) {
    LAS float* cw = (LAS float*)(F.lds);
    { const float* cwg = A.in[I_CONVW] + (size_t)l * CONVK * QKV_W;
      for (int i = F.tid; i < CONVK * QKV_W / 4; i += NWAVES * 64) ((LAS f32x4*)cw)[i] = ((const f32x4*)cwg)[i]; }
    __syncthreads();
    const int gw = F.vcu * NWAVES + F.wave, NGW = F.G * NWAVES, lane = F.lane;
    const bf16* PROJ = WSP(bf16, WS_PROJ);
    for (int r = gw; r < NB_LAT * PAST; r += NGW) {
        const int b = r / PAST, j = r % PAST; const size_t src = ((size_t)(b * DEPTH + l) * PAST + j) * 256 + 4 * lane; const size_t krow = (size_t)M_CTX + (size_t)b * (LSEQ + PAST) + LSEQ + j;
        const f32x4 kv = *(const f32x4*)(A.in[I_CK] + src), vv = *(const f32x4*)(A.in[I_CV] + src);
        *(GAS v2u*)(WSP(bf16, WS_KA) + krow * 256 + 4 * lane) = (v2u){pk2(kv[0], kv[1]), pk2(kv[2], kv[3])};
        *(GAS v2u*)(WSP(bf16, WS_VA) + krow * 256 + 4 * lane) = (v2u){pk2(vv[0], vv[1]), pk2(vv[2], vv[3])}; }
    constexpr int RUN = 8, NRUN = M / RUN;
    const float sgn = (lane & 16) ? 1.f : -1.f;
    const f32x2 qw = *(const f32x2*)(A.in[I_QNW] + l * HD + 2 * lane), kw = *(const f32x2*)(A.in[I_KNW] + l * HD + 2 * lane);
    const float dtb = A.in[I_DTB][l * 16 + (lane & 15)], nealog = -fexp(A.in[I_ALOG][l * 16 + (lane & 15)]);
#define PREP_LOADROW(dst, tt) do { if ((tt) >= 0 && (tt) < T) { const bf16* pr_ = PROJ + (size_t)(seq0 + (tt)) * IN_WP + 1024 * part + 2 * lane; _Pragma("unroll") for (int i_ = 0; i_ < 8; ++i_) dst[i_] = *(const unsigned*)(pr_ + 128 * i_); } \
        else { _Pragma("unroll") for (int i_ = 0; i_ < 8; ++i_) dst[i_] = 0u; } } while (0)
#define PREP_LOADATT(dst, gb_, ga_, row_) do { const bf16* pr_ = PROJ + (size_t)(row_) * IN_WP; const int c0_ = part == 2 ? C_AK : C_AQ + 512 * part; _Pragma("unroll") for (int h_ = 0; h_ < 4; ++h_) dst[h_] = *(const unsigned*)(pr_ + c0_ + 128 * h_ + 2 * lane); \
        gb_ = pr_[C_B + (lane & 15)]; ga_ = pr_[C_A + (lane & 15)]; } while (0)
    for (int item = gw; item < 3 * NRUN; item += NGW) {
        const int part = item / NRUN, run = item % NRUN;
        const int rowb = run * RUN; const bool lat = rowb >= M_CTX;
        int seq0, tb, T, bidx;
        if (!lat) { seq0 = rowb & ~(SEQ - 1); tb = rowb & (SEQ - 1); T = SEQ; bidx = rowb >> 8; } else { const int r = rowb - M_CTX; seq0 = M_CTX + (r & ~(LSEQ - 1)); tb = r & (LSEQ - 1); T = LSEQ; bidx = r >> 10; }
        unsigned w0[8], w1[8], w2[8], w3[8], w4[8], nx[8], an[4]; bf16 gbn, gan;
        PREP_LOADROW(w0, tb - 2); PREP_LOADROW(w1, tb - 1); PREP_LOADROW(w2, tb); PREP_LOADROW(w3, tb + 1); PREP_LOADROW(w4, tb + 2);
        PREP_LOADATT(an, gbn, gan, rowb);
        bf16* gdst = (part == 0 ? WSP(bf16, WS_QG) : part == 1 ? WSP(bf16, WS_KG) : WSP(bf16, WS_VG)) + 2 * lane;
        const LAS float* cwp = cw + 1024 * part + 2 * lane;
#pragma unroll 1
        for (int tk = 0; tk < RUN; ++tk) {
            const int row = rowb + tk, t = tb + tk;
            unsigned ac[4]; const bf16 gbc = gbn, gac = gan;
#pragma unroll
            for (int h = 0; h < 4; ++h) ac[h] = an[h];
            if (tk + 1 < RUN) { PREP_LOADROW(nx, t + 3); PREP_LOADATT(an, gbn, gan, row + 1); }
#pragma unroll
            for (int i = 0; i < 8; ++i) { const LAS float* c = cwp + 128 * i;
                const f32x2 c0 = *(const LAS f32x2*)(c), c1 = *(const LAS f32x2*)(c + QKV_W), c2 = *(const LAS f32x2*)(c + 2 * QKV_W), c3 = *(const LAS f32x2*)(c + 3 * QKV_W), c4 = *(const LAS f32x2*)(c + 4 * QKV_W);
                float y0 = c0[0] * bf_lo(w0[i]) + c1[0] * bf_lo(w1[i]) + c2[0] * bf_lo(w2[i]) + c3[0] * bf_lo(w3[i]) + c4[0] * bf_lo(w4[i]);
                float y1 = c0[1] * bf_hi(w0[i]) + c1[1] * bf_hi(w1[i]) + c2[1] * bf_hi(w2[i]) + c3[1] * bf_hi(w3[i]) + c4[1] * bf_hi(w4[i]);
                y0 = silu(y0); y1 = silu(y1);
                if (part < 2) { const float ss = wave_sum(y0 * y0 + y1 * y1); float sc = frsq(ss + RMS_EPS); if (part == 0) sc *= 0.08838834764831845f; y0 *= sc; y1 *= sc; }
                *(GAS unsigned*)(gdst + (size_t)row * GDN_W + 128 * i) = pg8::cvt_pk_bf16(y0, y1); if ((i & 3) == 3) __builtin_amdgcn_sched_barrier(0); }
            const size_t krow = lat ? (size_t)M_CTX + (size_t)bidx * (LSEQ + PAST) + t : (size_t)row;
            float rc0 = 1.f, rs0 = 0.f, rc1 = 1.f, rs1 = 0.f;
            if (lat) { const f32x4 rt = *(const f32x4*)(WSP(float, WS_ROPE) + ((size_t)t * 64 + lane) * 4); rc0 = rt[0]; rs0 = rt[1]; rc1 = rt[2]; rs1 = rt[3]; }
            if (part < 2) {
#pragma unroll
                for (int h = 0; h < 4; ++h) { float x0 = bf_lo(ac[h]), x1 = bf_hi(ac[h]);
                    const float r = frsq(wave_sum(x0 * x0 + x1 * x1) * (1.f / HD) + RMS_EPS); x0 = x0 * r * qw[0]; x1 = x1 * r * qw[1];
                    if (lat) { const float o0 = __shfl_xor(x0, 16), o1 = __shfl_xor(x1, 16); x0 = x0 * rc0 + sgn * o0 * rs0; x1 = x1 * rc1 + sgn * o1 * rs1; }
                    *(GAS unsigned*)(WSP(bf16, WS_QA) + (size_t)row * ATT_W + 128 * (4 * part + h) + 2 * lane) = pg8::cvt_pk_bf16(x0, x1); }
            } else {
#pragma unroll
                for (int h = 0; h < 2; ++h) { float x0 = bf_lo(ac[h]), x1 = bf_hi(ac[h]);
                    const float r = frsq(wave_sum(x0 * x0 + x1 * x1) * (1.f / HD) + RMS_EPS); x0 = x0 * r * kw[0]; x1 = x1 * r * kw[1];
                    if (!lat) *(f32x2*)(F.out + OUT_CK + ((size_t)(bidx * DEPTH + l) * SEQ + t) * 256 + 128 * h + 2 * lane) = (f32x2){x0, x1};
                    else { const float o0 = __shfl_xor(x0, 16), o1 = __shfl_xor(x1, 16); x0 = x0 * rc0 + sgn * o0 * rs0; x1 = x1 * rc1 + sgn * o1 * rs1; }
                    *(GAS unsigned*)(WSP(bf16, WS_KA) + krow * 256 + 128 * h + 2 * lane) = pg8::cvt_pk_bf16(x0, x1); }
#pragma unroll
                for (int h = 0; h < 2; ++h) { const unsigned w = ac[2 + h];
                    *(GAS unsigned*)(WSP(bf16, WS_VA) + krow * 256 + 128 * h + 2 * lane) = w;
                    if (!lat) *(f32x2*)(F.out + OUT_CV + ((size_t)(bidx * DEPTH + l) * SEQ + t) * 256 + 128 * h + 2 * lane) = (f32x2){bf_lo(w), bf_hi(w)}; }
                if (lane < 16) { const float bv = bf1(gbc), av = bf1(gac) + dtb;
                    const float sp = fmaxf(av, 0.f) + __logf(1.f + fexp(-fabsf(av)));
                    WSP(float, WS_GG)[(size_t)row * 16 + lane] = nealog * sp;
                    WSP(float, WS_BB)[(size_t)row * 16 + lane] = frcp(1.f + fexp(-bv)); }
            }
#pragma unroll
            for (int i = 0; i < 8; ++i) { w0[i] = w1[i]; w1[i] = w2[i]; w2[i] = w3[i]; w3[i] = w4[i]; w4[i] = nx[i]; }
        }
    }
#undef PREP_LOADROW
#undef PREP_LOADATT
}

constexpr int GDN_ITEMS_CTX = NB_CTX * HG * 2 / 4, GDN_ITEMS = GDN_ITEMS_CTX + NB_LAT * HG * 2 / 4;
__device__ __forceinline__ void gdn_rec_item(ARGS_T& A, Frame& F, int l, int it) {
    const bool lat = it >= GDN_ITEMS_CTX; const int cbase = lat ? (it - GDN_ITEMS_CTX) * 4 : it * 4;
    const int slot = F.tid >> 7, e = F.tid & 127, c = cbase + slot, b = c >> 4, h = (c >> 1) & 7, dir = c & 1;
    const int T = lat ? LSEQ : SEQ, row0 = lat ? M_CTX + b * LSEQ : b * SEQ;
    float S[128];
    if (lat) { const float* s0 = A.in[I_ST] + ((((size_t)b * DEPTH + l) * 2 + dir) * HG + h) * (size_t)(DKV * DKV) + e;
#pragma unroll
        for (int d = 0; d < 128; ++d) S[d] = s0[(size_t)d * DKV]; }
    else {
#pragma unroll
        for (int d = 0; d < 128; ++d) S[d] = 0.f; }
    constexpr int NBS = 16, SLOTF = NBS * 384 + 64;
    LAS float* kq = (LAS float*)(F.lds) + slot * SLOTF;
    const bf16 *KG = WSP(bf16, WS_KG), *QG = WSP(bf16, WS_QG), *VG = WSP(bf16, WS_VG);
    float* OD = dir ? WSP(float, WS_OB) : WSP(float, WS_OF);
    for (int i0 = 0; i0 < T; i0 += NBS) {
        __syncthreads();
#pragma unroll 4
        for (int j = 0; j < NBS; ++j) { const int t = dir ? T - 1 - (i0 + j) : i0 + j; const size_t off = (size_t)(row0 + t) * GDN_W + h * 128 + e;
            kq[j * 384 + e] = bf1(KG[off]); kq[j * 384 + 128 + e] = bf1(QG[off]); kq[j * 384 + 256 + e] = bf1(VG[off]); }
        if (e < NBS) { const int t = dir ? T - 1 - (i0 + e) : i0 + e; const size_t off = (size_t)(row0 + t) * 16 + dir * 8 + h;
            kq[NBS * 384 + e] = WSP(float, WS_GG)[off]; kq[NBS * 384 + 16 + e] = WSP(float, WS_BB)[off]; }
        __syncthreads();
        for (int j = 0; j < NBS; ++j) {
            const LAS float* kp = kq + j * 384; const float decay = __expf(kq[NBS * 384 + j]), beta = kq[NBS * 384 + 16 + j], v = kp[256 + e];
            float kv0 = 0.f, kv1 = 0.f;
#pragma unroll
            for (int dc = 0; dc < 128; dc += 16) {
#pragma unroll
                for (int d = dc; d < dc + 16; d += 4) { const f32x4 k4 = *(const LAS f32x4*)(kp + d); kv0 += k4[0] * S[d] + k4[2] * S[d + 2]; kv1 += k4[1] * S[d + 1] + k4[3] * S[d + 3]; }
                __builtin_amdgcn_sched_barrier(0); }
            const float delta = beta * (v - decay * (kv0 + kv1));
            float o0 = 0.f, o1 = 0.f;
#pragma unroll
            for (int dc = 0; dc < 128; dc += 8) {
#pragma unroll
                for (int d = dc; d < dc + 8; d += 4) { const f32x4 k4 = *(const LAS f32x4*)(kp + d), q4 = *(const LAS f32x4*)(kp + 128 + d);
                    S[d] = decay * S[d] + k4[0] * delta; S[d + 1] = decay * S[d + 1] + k4[1] * delta; S[d + 2] = decay * S[d + 2] + k4[2] * delta; S[d + 3] = decay * S[d + 3] + k4[3] * delta;
                    o0 += q4[0] * S[d] + q4[2] * S[d + 2]; o1 += q4[1] * S[d + 1] + q4[3] * S[d + 3]; }
                __builtin_amdgcn_sched_barrier(0); }
            const int t = dir ? T - 1 - (i0 + j) : i0 + j;
            OD[(size_t)(row0 + t) * GDN_W + h * 128 + e] = o0 + o1;
        }
    }
    if (!lat) { float* so = F.out + OUT_ST + ((((size_t)b * DEPTH + l) * 2 + dir) * HG + h) * (size_t)(DKV * DKV) + e;
#pragma unroll
        for (int d = 0; d < 128; ++d) so[(size_t)d * DKV] = S[d]; }
    __syncthreads();
}
constexpr int ATT_UNITS_LAT = NB_LAT * NQ * (LSEQ / 256), ATT_UNITS = ATT_UNITS_LAT + NB_CTX * NQ;
__device__ __forceinline__ void attn_unit(Frame& F, int u, char* lds) {
    const att::bf16* QA = (const att::bf16*)WSP(bf16, WS_QA); const att::bf16* KA = (const att::bf16*)WSP(bf16, WS_KA); const att::bf16* VA = (const att::bf16*)WSP(bf16, WS_VA);
    att::bf16* MIX = (att::bf16*)WSP(bf16, WS_MIX);
    int qrow0, krow0, h, seq;
    if (u < ATT_UNITS_LAT) { const int b = u / (NQ * 4), r = u % (NQ * 4); h = r >> 2; const int qb = r & 3; qrow0 = M_CTX + b * LSEQ + qb * 256; krow0 = M_CTX + b * (LSEQ + PAST); seq = LSEQ + PAST; }
    else { const int v = u - ATT_UNITS_LAT, b = v >> 3; h = v & 7; qrow0 = b * SEQ; krow0 = b * SEQ; seq = SEQ; }
    const int kvh = h >> 2;
    att::attn_dense_body<att::bf16>(QA + (size_t)qrow0 * ATT_W + h * HD, KA + (size_t)krow0 * 256 + kvh * HD, VA + (size_t)krow0 * 256 + kvh * HD, MIX + (size_t)qrow0 * DM + GDN_W + h * HD, seq, lds);
    __syncthreads();
}
__device__ __forceinline__ void combine_phase(ARGS_T& A, Frame& F, int l) {
    const int gw = F.vcu * NWAVES + F.wave, NGW = F.G * NWAVES, lane = F.lane;
    const f32x2 nw = *(const f32x2*)(A.in[I_GNW] + l * DKV + 2 * lane);
    for (int row = gw; row < M; row += NGW) {
        const float* of = WSP(float, WS_OF) + (size_t)row * GDN_W + 2 * lane; const float* ob = WSP(float, WS_OB) + (size_t)row * GDN_W + 2 * lane;
        const bf16* z = WSP(bf16, WS_PROJ) + (size_t)row * IN_WP + C_Z + 2 * lane; bf16* mx = WSP(bf16, WS_MIX) + (size_t)row * DM + 2 * lane;
#pragma unroll
        for (int h = 0; h < HG; ++h) { const f32x2 a = *(const f32x2*)(of + 128 * h), b = *(const f32x2*)(ob + 128 * h); const float o0 = a[0] + b[0], o1 = a[1] + b[1];
            const float r = frsq(wave_sum(o0 * o0 + o1 * o1) * (1.f / DKV) + RMS_EPS); const unsigned zw = *(const unsigned*)(z + 128 * h);
            *(GAS unsigned*)(mx + 128 * h) = pk2(o0 * r * nw[0] * silu(bf_lo(zw)), o1 * r * nw[1] * silu(bf_hi(zw))); }
    }
}

namespace gdn {
typedef short bf16x8 __attribute__((ext_vector_type(8)));
typedef short s16x4 __attribute__((ext_vector_type(4)));
typedef float f32x16 __attribute__((ext_vector_type(16)));
constexpr int O_QR = 0, O_KR = 17408, O_KT = 34816, O_VT = 53248, O_ST = 71680, O_LR = 106496, O_LT = 115712, O_PR = 124928, O_AT = 134144, O_VEC = 143360, O_VTMP = 145408, O_END = 162816;
constexpr int O_WR = O_KR, O_VNT = O_VT, O_VST = O_LR;
constexpr int SW = 272, SN = 144;
constexpr int V_GC = 0, V_BE = 256, V_EGC = 512, V_BW = 768, V_SF = 1024, V_EG63 = 1280;
constexpr int NCHAIN_LAT = NB_LAT * HG * 2, NCHAIN = NCHAIN_LAT + NB_CTX * HG * 2;
static_assert(O_END + 512 <= LDS_BYTES && O_END <= LDSCTL_OFF, "gdn LDS map");

__device__ __forceinline__ int crow(int r, int hi) { return (r & 3) + 8 * (r >> 2) + 4 * hi; }
__device__ __forceinline__ unsigned cvt2(float lo, float hi) { return pg8::cvt_pk_bf16(lo, hi); }
template <int KS> __device__ __forceinline__ void mma(f32x16& acc, LAS const unsigned char* A, int sa, LAS const unsigned char* B, int sb, int lane) {
    LAS const unsigned char* pa = A + (lane & 31) * sa + (lane >> 5) * 16; LAS const unsigned char* pb = B + (lane & 31) * sb + (lane >> 5) * 16;
#pragma unroll
    for (int ks = 0; ks < KS; ++ks) { const bf16x8 a = *(LAS const bf16x8*)(pa + ks * 32), b = *(LAS const bf16x8*)(pb + ks * 32); acc = __builtin_amdgcn_mfma_f32_32x32x16_bf16(a, b, acc, 0, 0, 0);
        if ((ks & 3) == 3) __builtin_amdgcn_sched_barrier(0); }
}
template <int KS> __device__ __forceinline__ void ldfrag(bf16x8 (&f)[KS], LAS const unsigned char* A, int sa, int lane) {
    LAS const unsigned char* pa = A + (lane & 31) * sa + (lane >> 5) * 16;
#pragma unroll
    for (int ks = 0; ks < KS; ++ks) f[ks] = *(LAS const bf16x8*)(pa + ks * 32);
}
__device__ __forceinline__ void st_T(LAS unsigned char* dst, int sd, const f32x16& v, int lane) {
    LAS unsigned char* p = dst + (lane & 31) * sd + (lane >> 5) * 8;
#pragma unroll
    for (int rg = 0; rg < 4; ++rg) *(LAS v2u*)(p + rg * 16) = (v2u){cvt2(v[4 * rg], v[4 * rg + 1]), cvt2(v[4 * rg + 2], v[4 * rg + 3])};
}
__device__ __forceinline__ void st_R(LAS unsigned char* dst, int sd, const f32x16& v, int lane) {
    const int hi = lane >> 5; LAS unsigned char* p = dst + (lane & 31) * 2;
#pragma unroll
    for (int r = 0; r < 16; r += 2) { const unsigned w = cvt2(v[r], v[r + 1]);
        *(LAS unsigned short*)(p + crow(r, hi) * sd) = (unsigned short)(w & 0xffffu); *(LAS unsigned short*)(p + crow(r + 1, hi) * sd) = (unsigned short)(w >> 16); }
}
__device__ __forceinline__ void ldrow16(float (&o)[16], LAS const unsigned char* vec, int m0, int hi) {
#pragma unroll
    for (int rg = 0; rg < 4; ++rg) { const f32x4 t = *(LAS const f32x4*)(vec + 4 * (m0 + 8 * rg + 4 * hi)); o[4 * rg] = t[0]; o[4 * rg + 1] = t[1]; o[4 * rg + 2] = t[2]; o[4 * rg + 3] = t[3]; }
}

__device__ __forceinline__ void chain(ARGS_T& A, Frame& F, int l, int cid) {
    const bool lat = cid < NCHAIN_LAT; const int c2 = lat ? cid : cid - NCHAIN_LAT; const int b = c2 >> 4, h = (c2 >> 1) & 7, dir = c2 & 1;
    const int T = lat ? LSEQ : SEQ, NC = T / 64, row0 = lat ? M_CTX + b * LSEQ : b * SEQ;
    LAS unsigned char* L = F.lds; LAS unsigned char* VEC = L + O_VEC;
    const int tid0 = F.tid, w0 = F.wave;
    const bf16* QG = WSP(bf16, WS_QG) + h * 128; const bf16* KG = WSP(bf16, WS_KG) + h * 128; const bf16* VG = WSP(bf16, WS_VG) + h * 128;
    const float* GGp = WSP(float, WS_GG) + dir * 8 + h; const float* BBp = WSP(float, WS_BB) + dir * 8 + h;
    float* OD = (dir ? WSP(float, WS_OB) : WSP(float, WS_OF)) + h * 128;
    f32x16 S0t, S1t;
    { const int w = w0, lane = tid0 & 63, hi = lane >> 5, c31 = lane & 31, te_s = w & 3, td0 = w >> 2, td1 = 2 + (w >> 2);
    if (lat) { const float* s0 = A.in[I_ST] + ((((size_t)b * DEPTH + l) * 2 + dir) * HG + h) * (size_t)(DKV * DKV);
        const float* p0 = s0 + (32 * td0 + 4 * hi) * DKV + 32 * te_s + c31; const float* p1 = s0 + (32 * td1 + 4 * hi) * DKV + 32 * te_s + c31;
#pragma unroll
        for (int rg = 0; rg < 4; ++rg) {
#pragma unroll
            for (int x = 0; x < 4; ++x) { S0t[4 * rg + x] = p0[(8 * rg + x) * DKV]; S1t[4 * rg + x] = p1[(8 * rg + x) * DKV]; }
            asm volatile("" ::: "memory"); } }
    else {
#pragma unroll
        for (int r = 0; r < 16; ++r) { S0t[r] = 0.f; S1t[r] = 0.f; } }
    st_T(L + O_ST + 32 * te_s * SW + 32 * td0 * 2, SW, S0t, lane); st_T(L + O_ST + 32 * te_s * SW + 32 * td1 * 2, SW, S1t, lane); }
    v4u pq[2], pk[2], pv[2]; float pg = 0.f, pb = 0.f;
#define GDN_LOAD(c) do { _Pragma("unroll") for (int i_ = 0; i_ < 2; ++i_) { const int p_ = tid + 512 * i_, tl_ = 64 * (c) + (p_ >> 4), t_ = dir ? T - 1 - tl_ : tl_; const size_t off_ = (size_t)(row0 + t_) * GDN_W + 8 * (p_ & 15); \
        pq[i_] = *(const v4u*)(QG + off_); pk[i_] = *(const v4u*)(KG + off_); pv[i_] = *(const v4u*)(VG + off_); } \
        if (w == 0) { const int tl_ = 64 * (c) + lane, t_ = dir ? T - 1 - tl_ : tl_; pg = GGp[(size_t)(row0 + t_) * 16]; pb = BBp[(size_t)(row0 + t_) * 16]; } } while (0)
    { const int tid = tid0, w = w0, lane = tid0 & 63; GDN_LOAD(0); }
#if MK_DIAG
#define GSTAMP(k) do { if (blockIdx.x == 0 && threadIdx.x == 0) { const unsigned long long t_ = __builtin_amdgcn_s_memrealtime(); ((volatile LAS unsigned long long*)(F.lds + LDSCTL_OFF))[24 + (k)] += t_ - gt_; gt_ = t_; } } while (0)
    unsigned long long gt_ = __builtin_amdgcn_s_memrealtime();
#else
#define GSTAMP(k) do { } while (0)
#endif
    for (int c = 0; c < NC; ++c) {
        GSTAMP(7);
        int tid = tid0, w = w0; asm volatile("" : "+v"(tid)); asm volatile("" : "+s"(w));
        const int lane = tid & 63, hi = lane >> 5, c31 = lane & 31, te_s = w & 3, td0 = w >> 2, td1 = 2 + (w >> 2);
#pragma unroll
        for (int i = 0; i < 2; ++i) { const int p = tid + 512 * i, row = p >> 4, cb = p & 15;
            *(LAS v4u*)(L + O_QR + row * SW + cb * 16) = pq[i]; *(LAS v4u*)(L + O_KR + row * SW + cb * 16) = pk[i]; *(LAS v4u*)(L + O_VTMP + row * SW + cb * 16) = pv[i]; }
        if (w == 0) { float s = pg;
#pragma unroll
            for (int o = 1; o < 64; o <<= 1) { const float t = __shfl_up(s, o); if (lane >= o) s += t; }
            const float g63 = __shfl(s, 63), eg = __expf(s);
            *(LAS float*)(VEC + V_GC + 4 * lane) = s; *(LAS float*)(VEC + V_BE + 4 * lane) = pb; *(LAS float*)(VEC + V_EGC + 4 * lane) = eg; *(LAS float*)(VEC + V_BW + 4 * lane) = pb * eg;
            *(LAS float*)(VEC + V_SF + 4 * lane) = __expf(g63 - s); if (lane == 0) *(LAS float*)(VEC + V_EG63) = __expf(g63); }
        __syncthreads();
        GSTAMP(0);
        if (c + 1 < NC) GDN_LOAD(c + 1);
#pragma unroll
        for (int n = 0; n < 4; ++n) { const int idx = 4 * n + (lane >> 4), rb = 2 * w + (idx >> 3), cbk = idx & 7, i16 = lane & 15, q = i16 >> 2, p = i16 & 3;
            const int so = (4 * rb + q) * SW + (16 * cbk + 4 * p) * 2, dof = (16 * cbk + i16) * SN + (4 * rb) * 2;
            const s16x4 kx = __builtin_bit_cast(s16x4, __builtin_amdgcn_ds_read_tr16_b64_v4i16((LAS s16x4*)(L + O_KR + so)));
            const s16x4 vx = __builtin_bit_cast(s16x4, __builtin_amdgcn_ds_read_tr16_b64_v4i16((LAS s16x4*)(L + O_VTMP + so)));
            *(LAS s16x4*)(L + O_KT + dof) = kx; *(LAS s16x4*)(L + O_VT + dof) = vx; }
        f32x16 Tt;
        constexpr int SB = 80;
        LAS unsigned char* W = L + O_LR + (w & 1) * 10240;
        LAS unsigned char* CRb = L + O_LR + 20480; LAS unsigned char* A32T = L + O_LR + 23040;
#pragma unroll
        for (int r = 0; r < 16; ++r) Tt[r] = 0.f;
        if (w < 3) {
            const int ti = (w == 0) ? 0 : 1, tj = (w == 1) ? 1 : 0; f32x16 acc;
#pragma unroll
            for (int r = 0; r < 16; ++r) acc[r] = 0.f;
            mma<8>(acc, L + O_KR + 32 * ti * SW, SW, L + O_KR + 32 * tj * SW, SW, lane);
            float gi[16], bi[16]; ldrow16(gi, VEC + V_GC, 32 * ti, hi); ldrow16(bi, VEC + V_BE, 32 * ti, hi);
            const float gj = *(LAS const float*)(VEC + V_GC + 4 * (32 * tj + c31)); const int j = 32 * tj + c31; f32x16 lv;
#pragma unroll
            for (int r = 0; r < 16; ++r) { const int i = 32 * ti + crow(r, hi); lv[r] = (i > j) ? bi[r] * acc[r] * __expf(gi[r] - gj) : 0.f; }
            if (w == 2) st_R(CRb, SB, lv, lane);
            else { const int jb = (lane >> 4) & 1; f32x16 ld, lo, z;
#pragma unroll
                for (int r = 0; r < 16; ++r) { const int ib = r >> 3; ld[r] = (ib == jb) ? lv[r] : 0.f; lo[r] = (ib == 1 && jb == 0) ? lv[r] : 0.f; Tt[r] = ((crow(r, hi) == c31) ? 1.f : 0.f) - ld[r]; }
                st_R(W, SB, ld, lane); st_T(W + 2560, SB, ld, lane); st_R(W + 5120, SB, Tt, lane); st_R(W + 7680, SB, lo, lane); LDS_WAIT();
#pragma unroll
                for (int r = 0; r < 16; ++r) z[r] = 0.f;
                mma<2>(z, W, SB, W + 2560, SB, lane); st_R(W, SB, z, lane); st_T(W + 2560, SB, z, lane); LDS_WAIT();
#pragma unroll
                for (int s2 = 0; s2 < 2; ++s2) { f32x16 z2;
#pragma unroll
                    for (int r = 0; r < 16; ++r) z2[r] = 0.f;
                    mma<2>(Tt, W + 5120, SB, W + 2560, SB, lane); mma<2>(z2, W, SB, W + 2560, SB, lane);
                    st_R(W + 5120, SB, Tt, lane); st_R(W, SB, z2, lane); st_T(W + 2560, SB, z2, lane); LDS_WAIT(); }
                mma<2>(Tt, W + 5120, SB, W + 2560, SB, lane); st_R(W + 5120, SB, Tt, lane); st_T(W + 2560, SB, Tt, lane); LDS_WAIT();
#pragma unroll
                for (int r = 0; r < 16; ++r) z[r] = 0.f;
                mma<2>(z, W + 7680, SB, W + 2560, SB, lane);
#pragma unroll
                for (int r = 0; r < 16; ++r) z[r] = -z[r];
                st_T(W, SB, z, lane); LDS_WAIT();
                mma<2>(Tt, W + 5120, SB, W, SB, lane);
                if (w == 0) st_T(A32T, SB, Tt, lane); else st_R(W + 5120, SB, Tt, lane); }
        } else if (w >= 4) { const int ti = (w >> 1) & 1, tj = w & 1; f32x16 acc;
#pragma unroll
            for (int r = 0; r < 16; ++r) acc[r] = 0.f;
            mma<8>(acc, L + O_QR + 32 * ti * SW, SW, L + O_KR + 32 * tj * SW, SW, lane);
            float gi[16]; ldrow16(gi, VEC + V_GC, 32 * ti, hi); const float gj = *(LAS const float*)(VEC + V_GC + 4 * (32 * tj + c31)); const int j = 32 * tj + c31; f32x16 av;
#pragma unroll
            for (int r = 0; r < 16; ++r) { const int i = 32 * ti + crow(r, hi); av[r] = (i >= j) ? acc[r] * __expf(gi[r] - gj) : 0.f; }
            st_R(L + O_AT + 32 * ti * SN + 32 * tj * 2, SN, av, lane); }
        __syncthreads();
        GSTAMP(1);
        if (w == 2) { f32x16 y;
#pragma unroll
            for (int r = 0; r < 16; ++r) y[r] = 0.f;
            mma<2>(y, CRb, SB, A32T, SB, lane);
#pragma unroll
            for (int r = 0; r < 16; ++r) y[r] = -y[r];
            st_T(CRb, SB, y, lane); LDS_WAIT();
            mma<2>(Tt, L + O_LR + 10240 + 5120, SB, CRb, SB, lane); }
        __syncthreads();
        GSTAMP(2);
        if (w < 4) { const int ti = (w == 0 || w == 3) ? 0 : 1, tj = (w == 1 || w == 3) ? 1 : 0;
            const float bj = *(LAS const float*)(VEC + V_BE + 4 * (32 * tj + c31)), bwj = *(LAS const float*)(VEC + V_BW + 4 * (32 * tj + c31)); f32x16 tu, tw;
#pragma unroll
            for (int r = 0; r < 16; ++r) { tu[r] = Tt[r] * bj; tw[r] = Tt[r] * bwj; }
            st_R(L + O_LR + 32 * ti * SN + 32 * tj * 2, SN, tu, lane); st_R(L + O_LR + 10240 + 32 * ti * SN + 32 * tj * 2, SN, tw, lane); }
        __syncthreads();
        GSTAMP(3);
        const int ti = w >> 2, te = w & 3;
        f32x16 au, aw;
#pragma unroll
        for (int r = 0; r < 16; ++r) { au[r] = 0.f; aw[r] = 0.f; }
        mma<4>(au, L + O_LR + 32 * ti * SN, SN, L + O_VT + 32 * te * SN, SN, lane);
        mma<4>(aw, L + O_LR + 10240 + 32 * ti * SN, SN, L + O_KT + 32 * te * SN, SN, lane);
#pragma unroll
        for (int r = 0; r < 16; ++r) aw[r] = -aw[r];
        st_R(L + O_WR + 32 * ti * SW + 32 * te * 2, SW, aw, lane);
        __syncthreads();
        GSTAMP(4);
        f32x16 aq;
#pragma unroll
        for (int r = 0; r < 16; ++r) aq[r] = 0.f;
        mma<8>(au, L + O_WR + 32 * ti * SW, SW, L + O_ST + 32 * te * SW, SW, lane);
        mma<8>(aq, L + O_QR + 32 * ti * SW, SW, L + O_ST + 32 * te * SW, SW, lane);
        { float sf[16]; ldrow16(sf, VEC + V_SF, 32 * ti, hi); f32x16 vs;
#pragma unroll
            for (int r = 0; r < 16; ++r) vs[r] = au[r] * sf[r];
            st_T(L + O_VNT + 32 * te * SN + 32 * ti * 2, SN, au, lane); st_T(L + O_VST + 32 * te * SN + 32 * ti * 2, SN, vs, lane); }
        __syncthreads();
        GSTAMP(5);
        { float eg[16]; ldrow16(eg, VEC + V_EGC, 32 * ti, hi);
#pragma unroll
            for (int r = 0; r < 16; ++r) aq[r] *= eg[r];
            mma<4>(aq, L + O_AT + 32 * ti * SN, SN, L + O_VNT + 32 * te * SN, SN, lane);
#pragma unroll
            for (int r = 0; r < 16; ++r) { const int tl = 64 * c + 32 * ti + crow(r, hi), t = dir ? T - 1 - tl : tl; OD[(size_t)(row0 + t) * GDN_W + 32 * te + c31] = aq[r]; } }
        { const float e63 = *(LAS const float*)(VEC + V_EG63);
#pragma unroll
            for (int r = 0; r < 16; ++r) { S0t[r] *= e63; S1t[r] *= e63; }
            mma<4>(S0t, L + O_KT + 32 * td0 * SN, SN, L + O_VST + 32 * te_s * SN, SN, lane);
            mma<4>(S1t, L + O_KT + 32 * td1 * SN, SN, L + O_VST + 32 * te_s * SN, SN, lane);
            st_T(L + O_ST + 32 * te_s * SW + 32 * td0 * 2, SW, S0t, lane); st_T(L + O_ST + 32 * te_s * SW + 32 * td1 * 2, SW, S1t, lane); }
        __syncthreads();
        GSTAMP(6);
    }
#undef GDN_LOAD
    int tid2 = tid0, w = w0; asm volatile("" : "+v"(tid2)); asm volatile("" : "+s"(w));
    const int lane = tid2 & 63, hi = lane >> 5, c31 = lane & 31, te_s = w & 3, td0 = w >> 2, td1 = 2 + (w >> 2);
    if (!lat) { float* so = F.out + OUT_ST + ((((size_t)b * DEPTH + l) * 2 + dir) * HG + h) * (size_t)(DKV * DKV);
        float* p0 = so + (32 * td0 + 4 * hi) * DKV + 32 * te_s + c31; float* p1 = so + (32 * td1 + 4 * hi) * DKV + 32 * te_s + c31;
#pragma unroll
        for (int rg = 0; rg < 4; ++rg) {
#pragma unroll
            for (int x = 0; x < 4; ++x) { p0[(8 * rg + x) * DKV] = S0t[4 * rg + x]; p1[(8 * rg + x) * DKV] = S1t[4 * rg + x]; }
            asm volatile("" ::: "memory"); } }
}
}
__device__ __forceinline__ void mixer_phase(ARGS_T& A, Frame& F, int l, char* lds_generic) {
    using namespace gdn;
    if (F.G == 256) {
        if (F.bx < NCHAIN_LAT) { chain(A, F, l, F.bx); return; }
        for (int c = NCHAIN_LAT + (F.bx - NCHAIN_LAT); c < NCHAIN; c += 256 - NCHAIN_LAT) chain(A, F, l, c);
        if (F.bx >= 96 && F.bx < 160) attn_unit(F, F.bx - 96, lds_generic);
        else if (F.bx >= 160) for (int u = ATT_UNITS_LAT + (F.bx - 160); u < ATT_UNITS; u += 96) attn_unit(F, u, lds_generic);
    } else {
        for (int c = F.bx; c < NCHAIN; c += F.G) chain(A, F, l, c);
        for (int u = F.bx; u < ATT_UNITS; u += F.G) attn_unit(F, u, lds_generic);
    }
}

constexpr int PH_PER_LAYER = 7, N_PHASES = 2 + DEPTH * PH_PER_LAYER;
extern __shared__ __attribute__((aligned(16))) unsigned char lds[];
__device__ __forceinline__ void frame_init(Frame& F, ARGS_T& A) {
    F.lds = (LAS unsigned char*)lds; F.MISC = (volatile LAS unsigned*)(F.lds + MISC_OFF);
    F.tid = fresh_tid(); F.lane = F.tid & 63; F.wave = __builtin_amdgcn_readfirstlane(F.tid >> 6);
    F.G = gridDim.x; F.bx = fresh_bx(); F.vcu = (F.G % 8 == 0) ? (F.bx % 8) * (F.G / 8) + F.bx / 8 : F.bx;
    F.out = A.out; F.ws = A.ws; F.ctl = (gu32*)(A.ws + WS_CTL);
}
template <int LO, int HI>
__global__ void __launch_bounds__(NWAVES * 64, 2) trunk_fwd(Args args_unused) {
    { const int t0 = fresh_tid(); for (int u = t0; u < (LDS_BYTES - LDSCTL_OFF) / 4; u += NWAVES * 64) ((LAS unsigned*)((LAS unsigned char*)lds + LDSCTL_OFF))[u] = 0u; }
    __syncthreads();
    if (HI - LO > 1) { ARGS_T& A = *fresh_args(); (void)xcd_barrier_post((unsigned*)(A.ws + WS_CTL) + CW_BAR, (volatile LAS unsigned*)((LAS unsigned char*)lds + MISC_OFF) + 8); }
#define IN(k) (LO <= (k) && (k) < HI)
#define SEAM(k) do { if (IN(k) && IN((k) + 1)) { ARGS_T& A_ = *fresh_args(); XcdBarrier bar_; bar_.bar = (unsigned*)(A_.ws + WS_CTL) + CW_BAR; bar_.x = xb_xcc_id(); bar_.st = (volatile LAS unsigned*)((LAS unsigned char*)lds + MISC_OFF) + 8; xcd_barrier(bar_); } } while (0)
#define PHASE_BEGIN ARGS_T& A = *fresh_args(); Frame F; frame_init(F, A);
#define GRIDBAR() do { ARGS_T& A_ = *fresh_args(); XcdBarrier bar_; bar_.bar = (unsigned*)(A_.ws + WS_CTL) + CW_BAR; bar_.x = xb_xcc_id(); bar_.st = (volatile LAS unsigned*)((LAS unsigned char*)lds + MISC_OFF) + 8; xcd_barrier(bar_); } while (0)
#if MK_DIAG
#define STAMP(k) do { if (blockIdx.x == 0 && threadIdx.x == 0) ((volatile LAS unsigned long long*)((LAS unsigned char*)lds + LDSCTL_OFF))[(k) + 1] = __builtin_amdgcn_s_memrealtime(); } while (0)
    if (blockIdx.x == 0 && threadIdx.x == 0) ((volatile LAS unsigned long long*)((LAS unsigned char*)lds + LDSCTL_OFF))[0] = __builtin_amdgcn_s_memrealtime();
#else
#define STAMP(k) do { } while (0)
#endif

    if (IN(0)) { PHASE_BEGIN p0a_phase(A, F); } SEAM(0); STAMP(0);
    if (IN(1)) { PHASE_BEGIN p0b_phase(A, F); } SEAM(1); STAMP(1);
#pragma unroll
    for (int l = 0; l < DEPTH; ++l) {
        const int pb = 2 + l * PH_PER_LAYER;
        constexpr size_t MODL = 3 * 12288;
        if (IN(pb + 0)) { PHASE_BEGIN pg8::Gemm g{WSP(bf16, WS_H), WSP(bf16, WS_WIN) + (size_t)l * IN_WP * DM, M, IN_WP, DM}; pg8::StaticOrder S; S.init(M, IN_WP, F.G, F.bx, DM);
            pg8::EpiBf16 E{WSP(bf16, WS_PROJ), IN_WP};
            pg8::gemm_phase<DM, pg8::EpiBf16, pg8::StaticOrder, true, true>(F.lds + RING_OFF, g, S, E); }
        SEAM(pb + 0); STAMP(pb + 0);
        if (IN(pb + 1)) { PHASE_BEGIN prep_phase(A, F, l); } SEAM(pb + 1); STAMP(pb + 1);
        if (IN(pb + 2)) { PHASE_BEGIN mixer_phase(A, F, l, (char*)lds + RING_OFF); }
        SEAM(pb + 2); STAMP(pb + 2);
        if (IN(pb + 3)) { PHASE_BEGIN combine_phase(A, F, l); } SEAM(pb + 3); STAMP(pb + 3);
        if (IN(pb + 4)) { PHASE_BEGIN pg8::Gemm g{WSP(bf16, WS_MIX), WSP(bf16, WS_WO) + (size_t)l * DM * DM, M, DM, DM}; pg8::TailOrder S; S.init(F.G, F.bx, DM);
            const float* mod = WSP(float, WS_MOD) + (size_t)l * MODL;
            pg8::EpiResid E{l == 0 ? A.in[I_XP] : F.out, F.out, mod + 2 * DM, DN_ALPHA, WSP(float, WS_PART)};
            pg8::gemm_phase<DM, pg8::EpiResid, pg8::TailOrder, true, true>(F.lds + RING_OFF, g, S, E);
            const LnArgs la{A.in[I_LN1G] + l * DM, A.in[I_LN1B] + l * DM, mod + 3 * DM, mod + 4 * DM, true, WSP(float, WS_PART), l == 0 ? A.in[I_XS] : F.out + (size_t)M_CTX * DM, mod + 2 * DM, DN_ALPHA};
            if (F.G == 256) ln_fused_tail(F, la, 2 * l); else { if (HI - LO > 1) GRIDBAR(); ln_phase(F, la); } }
        SEAM(pb + 4); STAMP(pb + 4);
        if (IN(pb + 5)) { PHASE_BEGIN pg8::Gemm g{WSP(bf16, WS_H), WSP(bf16, WS_WGU) + (size_t)l * 2 * DFF * DM, M, 2 * DFF, DM}; pg8::StaticOrder S; S.init(M, 2 * DFF, F.G, F.bx, DM);
            pg8::EpiSwiGLU E{WSP(bf16, WS_PROJ), DFF};
            pg8::gemm_phase<DM, pg8::EpiSwiGLU, pg8::StaticOrder, true, true>(F.lds + RING_OFF, g, S, E); }
        SEAM(pb + 5); STAMP(pb + 5);
        if (IN(pb + 6)) { PHASE_BEGIN pg8::Gemm g{WSP(bf16, WS_PROJ), WSP(bf16, WS_WD) + (size_t)l * DM * DFF, M, DM, DFF}; pg8::TailOrder S; S.init(F.G, F.bx, DFF);
            const float* mod = WSP(float, WS_MOD) + (size_t)l * MODL;
            pg8::EpiResid E{F.out, F.out, mod + 5 * DM, DN_ALPHA, WSP(float, WS_PART)};
            pg8::gemm_phase<DFF, pg8::EpiResid, pg8::TailOrder, true, true>(F.lds + RING_OFF, g, S, E);
            const float* modn = WSP(float, WS_MOD) + (size_t)(l + 1) * MODL;
            const LnArgs la{A.in[I_LN2G] + l * DM, A.in[I_LN2B] + l * DM, modn, modn + DM, l + 1 < DEPTH, WSP(float, WS_PART), F.out + (size_t)M_CTX * DM, mod + 5 * DM, DN_ALPHA};
            if (F.G == 256) ln_fused_tail(F, la, 2 * l + 1); else { if (HI - LO > 1) GRIDBAR(); ln_phase(F, la); } }
        if (l + 1 < DEPTH) SEAM(pb + 6);
        STAMP(pb + 6);
    }
#if MK_DIAG
    if (blockIdx.x == 0 && threadIdx.x == 0) {
        volatile LAS unsigned long long* st = (volatile LAS unsigned long long*)((LAS unsigned char*)lds + LDSCTL_OFF);
        unsigned long long tot = 0;
        for (int k = 0; k < N_PHASES; ++k) { const int ty = k < 2 ? k : 2 + (k - 2) % PH_PER_LAYER; if (ty == MK_DIAG_A || MK_DIAG_A == 99) tot += st[k + 1] - st[k]; }
        if (MK_DIAG_A >= 100) tot = st[24 + (MK_DIAG_A - 100)];
        const unsigned long long t0 = __builtin_amdgcn_s_memrealtime();
        while (__builtin_amdgcn_s_memrealtime() - t0 < 4 * tot) __builtin_amdgcn_s_sleep(8);
    }
#endif
#undef IN
#undef SEAM
#undef PHASE_BEGIN
}

typedef void (*kfn_t)(Args);
template <int... P> static void fill_fns(kfn_t* f, std::integer_sequence<int, P...>) { ((f[P] = trunk_fwd<P, P + 1>), ...); }
extern "C" void kernel_launch(void* const* d_in, const int* in_sizes, int n_in, void* d_out, int out_size, void* d_ws, size_t ws_size, hipStream_t stream) {
    static int grid = 0; static kfn_t fns[N_PHASES + 1];
    if (grid == 0) {
        if (n_in != N_IN || in_sizes[I_XP] != M_CTX * DM || in_sizes[I_XS] != M_LAT * DM || (size_t)out_size != OUT_TOTAL || ws_size < WS_END) {
            fprintf(stderr, "kernel_launch: shape mismatch n_in %d out %d ws %zu (need %zu)\n", n_in, out_size, ws_size, (size_t)WS_END); grid = -1; return; }
        int dev = 0, cus = 0;
        if (hipGetDevice(&dev) != hipSuccess || hipDeviceGetAttribute(&cus, hipDeviceAttributeMultiprocessorCount, dev) != hipSuccess) { grid = -1; return; }
#if MK_PER_PHASE
        fill_fns(fns, std::make_integer_sequence<int, N_PHASES>{});
        for (int p = 0; p < N_PHASES; ++p)
            if (hipFuncSetAttribute((const void*)fns[p], hipFuncAttributeMaxDynamicSharedMemorySize, LDS_BYTES) != hipSuccess) { fprintf(stderr, "kernel_launch: hipFuncSetAttribute failed (phase %d)\n", p); grid = -1; return; }
#else
        fns[N_PHASES] = trunk_fwd<0, N_PHASES>;
        if (hipFuncSetAttribute((const void*)fns[N_PHASES], hipFuncAttributeMaxDynamicSharedMemorySize, LDS_BYTES) != hipSuccess) { fprintf(stderr, "kernel_launch: hipFuncSetAttribute failed\n"); grid = -1; return; }
#endif
        (void)hipGetLastError();
        grid = cus;
    }
    if (grid < 0) return;
    if (hipMemsetAsync((char*)d_ws + WS_CTL, 0, CTL_ZERO_BYTES, stream) != hipSuccess) { fprintf(stderr, "kernel_launch: hipMemsetAsync failed\n"); return; }
    Args a{};
    for (int i = 0; i < N_IN; ++i) a.in[i] = (const float*)d_in[i];
    a.out = (float*)d_out; a.ws = (unsigned char*)d_ws;
#if MK_PER_PHASE
    for (int p = 0; p < N_PHASES; ++p) {
        hipLaunchKernelGGL(fns[p], dim3(grid), dim3(NWAVES * 64), LDS_BYTES, stream, a);
        const hipError_t le = hipPeekAtLastError(); if (le != hipSuccess) { fprintf(stderr, "kernel_launch: launch %d failed: %s\n", p, hipGetErrorName(le)); break; } }
#else
    hipLaunchKernelGGL(fns[N_PHASES], dim3(grid), dim3(NWAVES * 64), LDS_BYTES, stream, a);
    { const hipError_t le = hipPeekAtLastError(); if (le != hipSuccess) fprintf(stderr, "kernel_launch: launch failed: %s\n", hipGetErrorName(le)); }
#endif
}
```
